# Optimizing an MI355X kernel written in HIP

```python
import jax, jax.numpy as jnp
from jax import lax
import numpy as np

D_MODEL = 1024
BATCH = 8
SEQ = 2048
DEPTH = 1

PLE_DIM = 256
ROPE_THETA = 10000.0
EPS = 1e-6
NEG_INF = -1e30

MLA_HEADS = 8
MLA_Q_RANK = 384
MLA_KV_RANK = 256
MLA_NOPE = 64
MLA_ROPE = 32
MLA_QK = MLA_NOPE + MLA_ROPE
MLA_V = 64
Q_BLOCK = 128

SWA_HEADS = 8
SWA_KV_HEADS = 2
SWA_GROUP = SWA_HEADS // SWA_KV_HEADS
SWA_HD = 64
WINDOW = 128
BAND_BLOCK = 128

OFF_CQ = MLA_Q_RANK
OFF_CKV = OFF_CQ + MLA_KV_RANK
OFF_KR = OFF_CKV + MLA_ROPE
OFF_QS = OFF_KR + SWA_HEADS * SWA_HD
OFF_KS = OFF_QS + SWA_KV_HEADS * SWA_HD
OFF_VS = OFF_KS + SWA_KV_HEADS * SWA_HD
OFF_GA = OFF_VS + D_MODEL
IN_WIDTH = OFF_GA + D_MODEL

N_EXPERTS = 64
TOP_K = 8
N_GROUPS = 8
TOPK_GROUPS = 4
EXPERTS_PER_GROUP = N_EXPERTS // N_GROUPS
EXPERT_FF = 256
SHARED_FF = 256
ROUTED_SCALE = 2.5
MOE_CHUNK = 128

kernel_name = "hybrid_mla_swa_moe_ple_block"


def rmsnorm(x, g):
    xf = x.astype(jnp.float32)
    y = xf * lax.rsqrt(jnp.mean(xf * xf, axis=-1, keepdims=True) + EPS)
    return (y * g.astype(jnp.float32)).astype(x.dtype)


def rope_cos_sin(positions, dim):
    inv = 1.0 / (ROPE_THETA ** (jnp.arange(0, dim, 2, dtype=jnp.float32) / dim))
    ang = positions.astype(jnp.float32)[..., None] * inv
    return jnp.cos(ang), jnp.sin(ang)


def apply_rope(x, cos, sin):
    x1, x2 = jnp.split(x, 2, axis=-1)
    c = cos[:, :, None, :].astype(x.dtype)
    s = sin[:, :, None, :].astype(x.dtype)
    return jnp.concatenate([x1 * c - x2 * s, x2 * c + x1 * s], axis=-1)


def dense_attention(q, k, v, scale):
    B, S, H, dk = q.shape
    nb = S // Q_BLOCK
    qb = q.reshape(B, nb, Q_BLOCK, H, dk).transpose(1, 0, 2, 3, 4)

    def one_block(qblk):
        s = jnp.einsum('bqhd,bkhd->bhqk', qblk, k).astype(jnp.float32) * scale
        pr = jax.nn.softmax(s, axis=-1).astype(v.dtype)
        return jnp.einsum('bhqk,bkhd->bqhd', pr, v)

    o = lax.map(one_block, qb)
    return o.transpose(1, 0, 2, 3, 4).reshape(B, S, H, v.shape[-1])


def banded_gqa_attention(q, k, v, sink, scale):
    B, S, Hq, d = q.shape
    nb = S // BAND_BLOCK
    pad = ((0, 0), (BAND_BLOCK, BAND_BLOCK), (0, 0), (0, 0))
    kp = jnp.pad(k, pad).reshape(B, nb + 2, BAND_BLOCK, SWA_KV_HEADS, d)
    vp = jnp.pad(v, pad).reshape(B, nb + 2, BAND_BLOCK, SWA_KV_HEADS, d)
    kband = jnp.concatenate([kp[:, :-2], kp[:, 1:-1], kp[:, 2:]], axis=2)
    vband = jnp.concatenate([vp[:, :-2], vp[:, 1:-1], vp[:, 2:]], axis=2)
    qb = q.reshape(B, nb, BAND_BLOCK, SWA_KV_HEADS, SWA_GROUP, d)
    s = jnp.einsum('bnqhgd,bnkhd->bnhgqk', qb, kband).astype(jnp.float32) * scale
    qi = jnp.arange(BAND_BLOCK)[:, None]
    kj = jnp.arange(3 * BAND_BLOCK)[None, :]
    rel = kj - BAND_BLOCK - qi
    kpos = jnp.arange(nb)[:, None, None] * BAND_BLOCK - BAND_BLOCK + kj[None]
    valid = (jnp.abs(rel)[None] <= WINDOW) & (kpos >= 0) & (kpos < S)
    s = jnp.where(valid[None, :, None, None], s, NEG_INF)
    sk = sink.astype(jnp.float32).reshape(SWA_KV_HEADS, SWA_GROUP)[None, None, :, :, None, None]
    m = jnp.maximum(jnp.max(s, axis=-1, keepdims=True), sk)
    e = jnp.exp(s - m)
    denom = jnp.sum(e, axis=-1, keepdims=True) + jnp.exp(sk - m)
    pr = (e / denom).astype(v.dtype)
    o = jnp.einsum('bnhgqk,bnkhd->bnqhgd', pr, vband)
    return o.reshape(B, S, Hq * d)


def token_mixers(x, cos_s, sin_s, cos_m, sin_m, g_mix, w_in, b_gate, g_cq, w_uq, g_ckv, w_ukv,
                 g_qn_mla, g_kn_mla, g_qn_swa, g_kn_swa, sink, w_br_mla, w_br_swa, w_out):
    B, S, _ = x.shape
    h = rmsnorm(x, g_mix)
    z = h @ w_in
    c_q, c_kv, k_r, q_s, k_s, v_s, a_mla, a_swa = jnp.split(
        z, [OFF_CQ, OFF_CKV, OFF_KR, OFF_QS, OFF_KS, OFF_VS, OFF_GA], axis=-1)

    q_m = (rmsnorm(c_q, g_cq) @ w_uq).reshape(B, S, MLA_HEADS, MLA_QK)
    kv_m = (rmsnorm(c_kv, g_ckv) @ w_ukv).reshape(B, S, MLA_HEADS, MLA_NOPE + MLA_V)
    k_nope, v_m = jnp.split(kv_m, [MLA_NOPE], axis=-1)
    k_rope = jnp.broadcast_to(k_r[:, :, None, :], (B, S, MLA_HEADS, MLA_ROPE))
    q_m = rmsnorm(q_m, g_qn_mla)
    k_m = rmsnorm(jnp.concatenate([k_nope, k_rope], axis=-1), g_kn_mla)
    q_m = jnp.concatenate([q_m[..., :MLA_NOPE], apply_rope(q_m[..., MLA_NOPE:], cos_m, sin_m)], axis=-1)
    k_m = jnp.concatenate([k_m[..., :MLA_NOPE], apply_rope(k_m[..., MLA_NOPE:], cos_m, sin_m)], axis=-1)
    o_m = dense_attention(q_m, k_m, v_m, MLA_QK ** -0.5).reshape(B, S, MLA_HEADS * MLA_V)

    q_w = apply_rope(rmsnorm(q_s.reshape(B, S, SWA_HEADS, SWA_HD), g_qn_swa), cos_s, sin_s)
    k_w = apply_rope(rmsnorm(k_s.reshape(B, S, SWA_KV_HEADS, SWA_HD), g_kn_swa), cos_s, sin_s)
    v_w = v_s.reshape(B, S, SWA_KV_HEADS, SWA_HD)
    o_w = banded_gqa_attention(q_w, k_w, v_w, sink, SWA_HD ** -0.5)

    gate_m = jax.nn.sigmoid(a_mla + b_gate[:D_MODEL])
    gate_w = jax.nn.sigmoid(a_swa + b_gate[D_MODEL:])
    merged = gate_m * (o_m @ w_br_mla) + gate_w * (o_w @ w_br_swa)
    return x + merged @ w_out


def moe_ffn(x, g_moe, w_router, router_bias, w_exp_gu, w_exp_down, w_sh_gu, w_sh_down):
    B, S, D = x.shape
    h = rmsnorm(x, g_moe).reshape(B * S, D)
    T = h.shape[0]
    scores = jax.nn.sigmoid((h @ w_router).astype(jnp.float32))
    sel = scores + router_bias.astype(jnp.float32)
    grp = sel.reshape(T, N_GROUPS, EXPERTS_PER_GROUP)
    gscore = jnp.sum(lax.top_k(grp, 2)[0], axis=-1)
    _, gidx = lax.top_k(gscore, TOPK_GROUPS)
    gmask = jnp.sum(jax.nn.one_hot(gidx, N_GROUPS, dtype=jnp.float32), axis=-2) > 0
    emask = jnp.repeat(gmask, EXPERTS_PER_GROUP, axis=-1)
    _, eidx = lax.top_k(jnp.where(emask, sel, NEG_INF), TOP_K)
    w = jnp.take_along_axis(scores, eidx, axis=-1)
    w = w / jnp.sum(w, axis=-1, keepdims=True) * ROUTED_SCALE
    combine = jnp.einsum('tk,tke->te', w, jax.nn.one_hot(eidx, N_EXPERTS, dtype=jnp.float32)).astype(h.dtype)

    xc = h.reshape(T // MOE_CHUNK, MOE_CHUNK, D)
    cc = combine.reshape(T // MOE_CHUNK, MOE_CHUNK, N_EXPERTS)

    def chunk(args):
        xt, ct = args
        gu = jnp.einsum('td,edf->tef', xt, w_exp_gu)
        g, u = jnp.split(gu, 2, axis=-1)
        hid = jax.nn.silu(g) * u * ct[..., None]
        return jnp.einsum('tef,efd->td', hid, w_exp_down)

    routed = lax.map(chunk, (xc, cc)).reshape(T, D)
    sg, su = jnp.split(h @ w_sh_gu, 2, axis=-1)
    shared = (jax.nn.silu(sg) * su) @ w_sh_down
    return x + (routed + shared).reshape(B, S, D)


def per_layer_embedding(x, p_i, g_ple, w_ple_gate, b_ple, w_ple_proj):
    gate = jax.nn.sigmoid(rmsnorm(x, g_ple) @ w_ple_gate + b_ple)
    return x + gate * (p_i @ w_ple_proj)


def setup_inputs(seed: int = 0) -> dict:
    key = jax.random.key(seed)
    ks = iter(jax.random.split(key, 40))
    L = DEPTH

    def dense(shape, fan_in):
        return jax.random.normal(next(ks), shape, jnp.float32) * (fan_in ** -0.5)

    def gain(n):
        return 1.0 + 0.05 * jax.random.normal(next(ks), (L, n), jnp.float32)

    x = jax.random.normal(next(ks), (BATCH, SEQ, D_MODEL), jnp.float32)
    p = jax.random.normal(next(ks), (DEPTH, BATCH, SEQ, PLE_DIM), jnp.float32)
    offset = jax.random.randint(next(ks), (BATCH, 1), 0, 1024, dtype=jnp.int32)
    positions = offset + jnp.arange(SEQ, dtype=jnp.int32)[None, :]
    return {
        "x": x,
        "p": p,
        "positions": positions,
        "g_mix": gain(D_MODEL),
        "w_in": dense((L, D_MODEL, IN_WIDTH), D_MODEL),
        "b_gate": 0.1 * jax.random.normal(next(ks), (L, 2 * D_MODEL), jnp.float32),
        "g_cq": gain(MLA_Q_RANK),
        "w_uq": dense((L, MLA_Q_RANK, MLA_HEADS * MLA_QK), MLA_Q_RANK),
        "g_ckv": gain(MLA_KV_RANK),
        "w_ukv": dense((L, MLA_KV_RANK, MLA_HEADS * (MLA_NOPE + MLA_V)), MLA_KV_RANK),
        "g_qn_mla": gain(MLA_QK),
        "g_kn_mla": gain(MLA_QK),
        "g_qn_swa": gain(SWA_HD),
        "g_kn_swa": gain(SWA_HD),
        "sink": 0.5 * jax.random.normal(next(ks), (L, SWA_HEADS), jnp.float32),
        "w_br_mla": dense((L, MLA_HEADS * MLA_V, D_MODEL), MLA_HEADS * MLA_V),
        "w_br_swa": dense((L, SWA_HEADS * SWA_HD, D_MODEL), SWA_HEADS * SWA_HD),
        "w_out": dense((L, D_MODEL, D_MODEL), D_MODEL),
        "g_moe": gain(D_MODEL),
        "w_router": dense((L, D_MODEL, N_EXPERTS), D_MODEL),
        "router_bias": 0.01 * jax.random.normal(next(ks), (L, N_EXPERTS), jnp.float32),
        "w_exp_gu": dense((L, N_EXPERTS, D_MODEL, 2 * EXPERT_FF), D_MODEL),
        "w_exp_down": dense((L, N_EXPERTS, EXPERT_FF, D_MODEL), EXPERT_FF),
        "w_sh_gu": dense((L, D_MODEL, 2 * SHARED_FF), D_MODEL),
        "w_sh_down": dense((L, SHARED_FF, D_MODEL), SHARED_FF),
        "g_ple": gain(D_MODEL),
        "w_ple_gate": dense((L, D_MODEL, D_MODEL), D_MODEL),
        "b_ple": 0.1 * jax.random.normal(next(ks), (L, D_MODEL), jnp.float32),
        "w_ple_proj": dense((L, PLE_DIM, D_MODEL), PLE_DIM),
    }


def reference(x, p, positions, g_mix, w_in, b_gate, g_cq, w_uq, g_ckv, w_ukv, g_qn_mla, g_kn_mla,
              g_qn_swa, g_kn_swa, sink, w_br_mla, w_br_swa, w_out, g_moe, w_router, router_bias,
              w_exp_gu, w_exp_down, w_sh_gu, w_sh_down, g_ple, w_ple_gate, b_ple, w_ple_proj):
    cos_s, sin_s = rope_cos_sin(positions, SWA_HD)
    cos_m, sin_m = rope_cos_sin(positions, MLA_ROPE)
    for i in range(DEPTH):
        x = token_mixers(x, cos_s, sin_s, cos_m, sin_m, g_mix[i], w_in[i], b_gate[i], g_cq[i], w_uq[i],
                         g_ckv[i], w_ukv[i], g_qn_mla[i], g_kn_mla[i], g_qn_swa[i], g_kn_swa[i], sink[i],
                         w_br_mla[i], w_br_swa[i], w_out[i])
        x = moe_ffn(x, g_moe[i], w_router[i], router_bias[i], w_exp_gu[i], w_exp_down[i],
                    w_sh_gu[i], w_sh_down[i])
        x = per_layer_embedding(x, p[i], g_ple[i], w_ple_gate[i], b_ple[i], w_ple_proj[i])
    return x
```

```cpp
#include <hip/hip_runtime.h>
#include <stdint.h>
#include <cstdio>

constexpr int B_ = 8, S_ = 2048, D_ = 1024, M_ = B_ * S_;
constexpr int NZ = 3584;
constexpr int INW = 3488;
constexpr int ZQ = 0, ZKR = 384, ZCKV = 512, ZQS = 768, ZKS = 1280, ZVS = 1408, ZGA = 1536, ZGB = 2560;
constexpr int NE = 64, TOPK = 8, EFF = 256;
constexpr int NSLOT = M_ * TOPK + NE * 256;
constexpr float EPS = 1e-6f;
constexpr float LOG2E = 1.4426950408889634f;

typedef unsigned short bf16_t;
__device__ __forceinline__ float bf2f(bf16_t v) { return __uint_as_float((unsigned)v << 16); }
__device__ __forceinline__ bf16_t f2bf(float f) { unsigned u = __float_as_uint(f); return (bf16_t)((u + 0x7fffu + ((u >> 16) & 1u)) >> 16); }
__device__ __forceinline__ float sigmoidf_(float v) { return 1.f / (1.f + __expf(-v)); }
__device__ __forceinline__ float wave_sum(float v) {
#pragma unroll
    for (int o = 1; o < 64; o <<= 1) v += __shfl_xor(v, o);
    return v;
}
__device__ __forceinline__ float wave_max(float v) {
#pragma unroll
    for (int o = 1; o < 64; o <<= 1) v = fmaxf(v, __shfl_xor(v, o));
    return v;
}

constexpr size_t MiB = 1u << 20;
constexpr size_t WS_CTL = 0, CTL_BYTES = 64 * 1024;
constexpr size_t WS_TOPE = 1 * MiB, WS_TOPW = WS_TOPE + 512 * 1024, WS_TOPLS = WS_TOPW + 512 * 1024, WS_POS = WS_TOPLS + 512 * 1024;
constexpr size_t WS_LTOK = 3 * MiB, WS_LW = WS_LTOK + 640 * 1024;
constexpr size_t WS_PB = 6 * MiB, WS_WDN = 14 * MiB, WS_WPG = 48 * MiB, WS_WPP = 50 * MiB, WS_WSHDN = 50 * MiB + 512 * 1024;
constexpr size_t WS_HID = 51 * MiB, WS_HSH = 123 * MiB, WS_R = 131 * MiB;
constexpr size_t WS_WGU = 131 * MiB, WS_WSHGU = 195 * MiB, WS_WIN = 196 * MiB, WS_WUQ = 203 * MiB, WS_WUKV = 204 * MiB, WS_WBRM = 205 * MiB, WS_WBRS = 206 * MiB, WS_WOUT = 207 * MiB;
constexpr size_t WS_Z = 210 * MiB, WS_HB = 322 * MiB, WS_MG = 322 * MiB, WS_QMR = 354 * MiB, WS_OM = 354 * MiB, WS_OW = 370 * MiB, WS_KVR = 378 * MiB;
constexpr size_t WS_QM = 410 * MiB, WS_KM = 434 * MiB, WS_VTM = 458 * MiB, WS_QS = 474 * MiB, WS_KS = 490 * MiB, WS_VTS = 494 * MiB;
constexpr size_t WS_H2 = 210 * MiB, WS_Y = 131 * MiB, WS_H3 = 419 * MiB, WS_PP = 451 * MiB, WS_END = 498 * MiB;
constexpr int CW_CNT = 0;
constexpr int CW_BASE = 64;

struct P {
    const float *x, *p; const int* pos;
    const float *g_mix, *w_in, *b_gate, *g_cq, *w_uq, *g_ckv, *w_ukv, *g_qn_mla, *g_kn_mla, *g_qn_swa, *g_kn_swa, *sink;
    const float *w_br_mla, *w_br_swa, *w_out, *g_moe, *w_router, *router_bias, *w_exp_gu, *w_exp_down, *w_sh_gu, *w_sh_down;
    const float *g_ple, *w_ple_gate, *b_ple, *w_ple_proj;
    float* out; unsigned char* ws; int stage; int pad;
};
#define WSP(T, off) ((T*)(p.ws + (off)))

__device__ __forceinline__ void ndot4(float (&acc)[4], const bf16_t* a0, const bf16_t* a1, const bf16_t* a2, const bf16_t* a3, const float* g, const float* W, int ldw, int K) {
    float c0 = 0.f, c1 = 0.f, c2 = 0.f, c3 = 0.f;
    for (int k = 0; k < K; ++k) {
        const float w = W[(size_t)k * ldw] * (g ? g[k] : 1.f);
        c0 += bf2f(a0[k]) * w; c1 += bf2f(a1[k]) * w; c2 += bf2f(a2[k]) * w; c3 += bf2f(a3[k]) * w;
    }
    acc[0] = c0; acc[1] = c1; acc[2] = c2; acc[3] = c3;
}
__device__ __forceinline__ int zsrc(int n) {
    if (n < 384) return n;
    if (n < 416) return 640 + (n - 384);
    if (n < 512) return -1;
    if (n < 768) return 384 + (n - 512);
    if (n < 1280) return 672 + (n - 768);
    if (n < 1408) return 1184 + (n - 1280);
    if (n < 1536) return 1312 + (n - 1408);
    if (n < 2560) return 1440 + (n - 1536);
    return 2464 + (n - 2560);
}

__device__ void st_prep(const P& p, int gw, int ngw, int lane) {
    bf16_t* hb = WSP(bf16_t, WS_HB); bf16_t* pb = WSP(bf16_t, WS_PB);
    for (int m = gw; m < M_; m += ngw) {
        const float* xr = p.x + (size_t)m * D_; float v[16]; float s = 0.f;
#pragma unroll
        for (int j = 0; j < 16; ++j) { v[j] = xr[lane + 64 * j]; s += v[j] * v[j]; }
        s = wave_sum(s); const float r = 1.f / sqrtf(s * (1.f / D_) + EPS);
#pragma unroll
        for (int j = 0; j < 16; ++j) hb[(size_t)m * D_ + lane + 64 * j] = f2bf(v[j] * r);
#pragma unroll
        for (int j = 0; j < 4; ++j) pb[(size_t)m * 256 + lane + 64 * j] = f2bf(p.p[(size_t)m * 256 + lane + 64 * j]);
    }
}
__device__ void nv_g1(const P& p, size_t gt, size_t ngt) {
    const bf16_t* hb = WSP(bf16_t, WS_HB); bf16_t* z = WSP(bf16_t, WS_Z);
    const size_t total = (size_t)(M_ / 4) * NZ;
    for (size_t i = gt; i < total; i += ngt) {
        const int n = (int)(i % NZ); const int m = (int)(i / NZ) * 4; const int src = zsrc(n);
        float acc[4] = {0.f, 0.f, 0.f, 0.f};
        if (src >= 0) { const bf16_t* a = hb + (size_t)m * D_; ndot4(acc, a, a + D_, a + 2 * D_, a + 3 * D_, p.g_mix, p.w_in + src, INW, D_); }
#pragma unroll
        for (int r = 0; r < 4; ++r) { float v = acc[r]; if (n >= ZGA) v = sigmoidf_(v + p.b_gate[n - ZGA]); z[(size_t)(m + r) * NZ + n] = f2bf(v); }
    }
}
__device__ void nv_g23(const P& p, size_t gt, size_t ngt) {
    const bf16_t* z = WSP(bf16_t, WS_Z); bf16_t* qmr = WSP(bf16_t, WS_QMR); bf16_t* kvr = WSP(bf16_t, WS_KVR);
    const size_t t1 = (size_t)(M_ / 4) * 768, t2 = (size_t)(M_ / 4) * 1024;
    for (size_t i = gt; i < t1 + t2; i += ngt) {
        float acc[4];
        if (i < t1) { const int n = (int)(i % 768), m = (int)(i / 768) * 4; const bf16_t* a = z + (size_t)m * NZ + ZQ;
            ndot4(acc, a, a + NZ, a + 2 * NZ, a + 3 * NZ, p.g_cq, p.w_uq + n, 768, 384);
#pragma unroll
            for (int r = 0; r < 4; ++r) qmr[(size_t)(m + r) * 768 + n] = f2bf(acc[r]);
        } else { const size_t j = i - t1; const int n = (int)(j % 1024), m = (int)(j / 1024) * 4; const bf16_t* a = z + (size_t)m * NZ + ZCKV;
            ndot4(acc, a, a + NZ, a + 2 * NZ, a + 3 * NZ, p.g_ckv, p.w_ukv + n, 1024, 256);
#pragma unroll
            for (int r = 0; r < 4; ++r) kvr[(size_t)(m + r) * 1024 + n] = f2bf(acc[r]);
        }
    }
}

constexpr int VT_PITCH = 66;
__device__ void st_attn_prep(const P& p, int wg, int nwg, int wave, int lane, bf16_t* lds) {
    const bf16_t* z = WSP(bf16_t, WS_Z); const bf16_t* qmr = WSP(bf16_t, WS_QMR); const bf16_t* kvr = WSP(bf16_t, WS_KVR);
    bf16_t* QM = WSP(bf16_t, WS_QM); bf16_t* KM = WSP(bf16_t, WS_KM); bf16_t* VTM = WSP(bf16_t, WS_VTM);
    bf16_t* QS = WSP(bf16_t, WS_QS); bf16_t* KS = WSP(bf16_t, WS_KS); bf16_t* VTS = WSP(bf16_t, WS_VTS);
    const float sc_m = 0.10206207261596575f * LOG2E;
    const float sc_s = 0.125f * LOG2E;
    for (int tile = wg; tile < M_ / 64; tile += nwg) {
        __syncthreads();
        for (int tt = 0; tt < 8; ++tt) {
            const int tl = wave * 8 + tt, m = tile * 64 + tl, b = m / S_, s = m % S_;
            const bf16_t* zr = z + (size_t)m * NZ;
            const float posf = (float)p.pos[m];
            float sq = 0.f, skv = 0.f;
#pragma unroll
            for (int j = 0; j < 6; ++j) { const float v = bf2f(zr[ZQ + lane + 64 * j]); sq += v * v; }
#pragma unroll
            for (int j = 0; j < 4; ++j) { const float v = bf2f(zr[ZCKV + lane + 64 * j]); skv += v * v; }
            sq = wave_sum(sq); skv = wave_sum(skv);
            const float rq = 1.f / sqrtf(sq * (1.f / 384.f) + EPS), rkv = 1.f / sqrtf(skv * (1.f / 256.f) + EPS);
            const float inv_m = exp2f(-13.287712379549449f * (float)(lane & 15) * (1.f / 16.f));
            const float inv_s = exp2f(-13.287712379549449f * (float)(lane & 31) * (1.f / 32.f));
            float cm, sm, cs, ss; sincosf(posf * inv_m, &sm, &cm); sincosf(posf * inv_s, &ss, &cs);
            const float krope = bf2f(zr[ZKR + (lane & 31)]);
            for (int h = 0; h < 8; ++h) {
                { float v0 = bf2f(qmr[(size_t)m * 768 + h * 96 + lane]) * rq;
                  float v1 = (lane < 32) ? bf2f(qmr[(size_t)m * 768 + h * 96 + 64 + lane]) * rq : 0.f;
                  const float ssum = wave_sum(v0 * v0 + v1 * v1); const float r = 1.f / sqrtf(ssum * (1.f / 96.f) + EPS);
                  v0 *= r * p.g_qn_mla[lane]; v1 *= (lane < 32) ? r * p.g_qn_mla[64 + lane] : 0.f;
                  const float o = __shfl_xor(v1, 16);
                  const float rot = (lane < 16) ? (v1 * cm - o * sm) : (v1 * cm + o * sm);
                  bf16_t* dst = QM + ((size_t)(b * 8 + h) * S_ + s) * 96;
                  dst[lane] = f2bf(v0 * sc_m); if (lane < 32) dst[64 + lane] = f2bf(rot * sc_m); }
                { float v0 = bf2f(kvr[(size_t)m * 1024 + h * 128 + lane]) * rkv;
                  float v1 = (lane < 32) ? krope : 0.f;
                  const float ssum = wave_sum(v0 * v0 + v1 * v1); const float r = 1.f / sqrtf(ssum * (1.f / 96.f) + EPS);
                  v0 *= r * p.g_kn_mla[lane]; v1 *= (lane < 32) ? r * p.g_kn_mla[64 + lane] : 0.f;
                  const float o = __shfl_xor(v1, 16);
                  const float rot = (lane < 16) ? (v1 * cm - o * sm) : (v1 * cm + o * sm);
                  bf16_t* dst = KM + ((size_t)(b * 8 + h) * S_ + s) * 96;
                  dst[lane] = f2bf(v0); if (lane < 32) dst[64 + lane] = f2bf(rot);
                  const float vv = bf2f(kvr[(size_t)m * 1024 + h * 128 + 64 + lane]) * rkv;
                  lds[(h * 64 + lane) * VT_PITCH + tl] = f2bf(vv); }
                { float v = bf2f(zr[ZQS + h * 64 + lane]);
                  const float ssum = wave_sum(v * v); const float r = 1.f / sqrtf(ssum * (1.f / 64.f) + EPS);
                  v *= r * p.g_qn_swa[lane];
                  const float o = __shfl_xor(v, 32);
                  const float rot = (lane < 32) ? (v * cs - o * ss) : (v * cs + o * ss);
                  QS[((size_t)(b * 8 + h) * S_ + s) * 64 + lane] = f2bf(rot * sc_s); }
                if (h < 2) {
                  float v = bf2f(zr[ZKS + h * 64 + lane]);
                  const float ssum = wave_sum(v * v); const float r = 1.f / sqrtf(ssum * (1.f / 64.f) + EPS);
                  v *= r * p.g_kn_swa[lane];
                  const float o = __shfl_xor(v, 32);
                  const float rot = (lane < 32) ? (v * cs - o * ss) : (v * cs + o * ss);
                  KS[((size_t)(b * 2 + h) * S_ + s) * 64 + lane] = f2bf(rot);
                  lds[(512 + h * 64 + lane) * VT_PITCH + tl] = zr[ZVS + h * 64 + lane]; }
            }
        }
        __syncthreads();
        const int b = (tile * 64) / S_, s0 = (tile * 64) % S_;
        for (int r = wave; r < 640; r += 8) {
            const bf16_t v = lds[r * VT_PITCH + lane];
            if (r < 512) VTM[((size_t)(b * 8 + (r >> 6)) * 64 + (r & 63)) * S_ + s0 + lane] = v;
            else { const int rr = r - 512; VTS[((size_t)(b * 2 + (rr >> 6)) * 64 + (rr & 63)) * S_ + s0 + lane] = v; }
        }
    }
}

template <int DK, bool SWA>
__device__ void nv_attn(const P& p, size_t gt, size_t ngt) {
    const bf16_t* Q = SWA ? WSP(bf16_t, WS_QS) : WSP(bf16_t, WS_QM);
    const bf16_t* K = SWA ? WSP(bf16_t, WS_KS) : WSP(bf16_t, WS_KM);
    const bf16_t* VT = SWA ? WSP(bf16_t, WS_VTS) : WSP(bf16_t, WS_VTM);
    bf16_t* O = SWA ? WSP(bf16_t, WS_OW) : WSP(bf16_t, WS_OM);
    const size_t total = (size_t)B_ * 8 * S_;
    for (size_t i = gt; i < total; i += ngt) {
        const int q = (int)(i % S_), h = (int)((i / S_) % 8), b = (int)(i / ((size_t)S_ * 8));
        const int kvh = SWA ? (b * 2 + h / 4) : (b * 8 + h);
        const bf16_t* qp = Q + ((size_t)(b * 8 + h) * S_ + q) * DK;
        const bf16_t* kb = K + (size_t)kvh * S_ * DK; const bf16_t* vb = VT + (size_t)kvh * 64 * S_;
        float m, l; float o[64]; float qf[DK];
#pragma unroll
        for (int d = 0; d < 64; ++d) o[d] = 0.f;
#pragma unroll
        for (int d = 0; d < DK; ++d) qf[d] = bf2f(qp[d]);
        if (SWA) { m = p.sink[h] * LOG2E; l = 1.f; } else { m = -1e30f; l = 0.f; }
        const int k0 = SWA ? max(0, q - 128) : 0, k1 = SWA ? min(S_ - 1, q + 128) : S_ - 1;
        for (int k = k0; k <= k1; ++k) {
            float s = 0.f; const bf16_t* kp = kb + (size_t)k * DK;
#pragma unroll
            for (int d = 0; d < DK; ++d) s += qf[d] * bf2f(kp[d]);
            const float mn = fmaxf(m, s), al = exp2f(m - mn), pr = exp2f(s - mn);
            l = l * al + pr; m = mn;
#pragma unroll
            for (int d = 0; d < 64; ++d) o[d] = o[d] * al + pr * bf2f(vb[(size_t)d * S_ + k]);
        }
        const float il = 1.f / l;
        bf16_t* op = O + ((size_t)(b * S_ + q)) * 512 + h * 64;
#pragma unroll
        for (int d = 0; d < 64; ++d) op[d] = f2bf(o[d] * il);
    }
}
__device__ void nv_merge(const P& p, size_t gt, size_t ngt) {
    const bf16_t* z = WSP(bf16_t, WS_Z); const bf16_t* om = WSP(bf16_t, WS_OM); const bf16_t* ow = WSP(bf16_t, WS_OW); bf16_t* mg = WSP(bf16_t, WS_MG);
    const size_t total = (size_t)(M_ / 4) * D_;
    for (size_t i = gt; i < total; i += ngt) {
        const int n = (int)(i % D_), m = (int)(i / D_) * 4; float a[4], c[4];
        const bf16_t* r0 = om + (size_t)m * 512; ndot4(a, r0, r0 + 512, r0 + 1024, r0 + 1536, nullptr, p.w_br_mla + n, D_, 512);
        const bf16_t* r1 = ow + (size_t)m * 512; ndot4(c, r1, r1 + 512, r1 + 1024, r1 + 1536, nullptr, p.w_br_swa + n, D_, 512);
#pragma unroll
        for (int r = 0; r < 4; ++r) { const bf16_t* zr = z + (size_t)(m + r) * NZ; mg[(size_t)(m + r) * D_ + n] = f2bf(bf2f(zr[ZGA + n]) * a[r] + bf2f(zr[ZGB + n]) * c[r]); }
    }
}
__device__ void nv_out(const P& p, size_t gt, size_t ngt) {
    const bf16_t* mg = WSP(bf16_t, WS_MG);
    const size_t total = (size_t)(M_ / 4) * D_;
    for (size_t i = gt; i < total; i += ngt) {
        const int n = (int)(i % D_), m = (int)(i / D_) * 4; float a[4];
        const bf16_t* r0 = mg + (size_t)m * D_; ndot4(a, r0, r0 + D_, r0 + 2 * D_, r0 + 3 * D_, nullptr, p.w_out + n, D_, D_);
#pragma unroll
        for (int r = 0; r < 4; ++r) p.out[(size_t)(m + r) * D_ + n] = p.x[(size_t)(m + r) * D_ + n] + a[r];
    }
}
__device__ void st_route(const P& p, int gw, int ngw, int lane, float* xs) {
    bf16_t* h2 = WSP(bf16_t, WS_H2); int* tope = WSP(int, WS_TOPE); float* topw = WSP(float, WS_TOPW); int* topls = WSP(int, WS_TOPLS);
    unsigned* cnt = WSP(unsigned, WS_CTL) + CW_CNT;
    for (int m = gw; m < M_; m += ngw) {
        const float* xr = p.out + (size_t)m * D_; float v[16]; float s = 0.f;
#pragma unroll
        for (int j = 0; j < 16; ++j) { v[j] = xr[lane + 64 * j]; s += v[j] * v[j]; }
        s = wave_sum(s); const float r = 1.f / sqrtf(s * (1.f / D_) + EPS);
#pragma unroll
        for (int j = 0; j < 16; ++j) { const float xn = v[j] * r; h2[(size_t)m * D_ + lane + 64 * j] = f2bf(xn); xs[lane + 64 * j] = xn * p.g_moe[lane + 64 * j]; }
        __builtin_amdgcn_s_waitcnt(0xc07f);
        float logit = 0.f;
        for (int k = 0; k < D_; ++k) logit += xs[k] * p.w_router[(size_t)k * NE + lane];
        const float score = sigmoidf_(logit); const float sel = score + p.router_bias[lane];
        float m1 = sel;
        m1 = fmaxf(m1, __shfl_xor(m1, 1)); m1 = fmaxf(m1, __shfl_xor(m1, 2)); m1 = fmaxf(m1, __shfl_xor(m1, 4));
        const unsigned long long eqm = __ballot(sel == m1);
        const int g = lane >> 3; const unsigned gm = (unsigned)((eqm >> (g * 8)) & 0xffull);
        const int first = __ffs((int)gm) - 1;
        float v2 = ((lane & 7) == first) ? -3.0e38f : sel;
        v2 = fmaxf(v2, __shfl_xor(v2, 1)); v2 = fmaxf(v2, __shfl_xor(v2, 2)); v2 = fmaxf(v2, __shfl_xor(v2, 4));
        const float gs = m1 + v2;
        int grank = 0;
#pragma unroll
        for (int j = 0; j < 8; ++j) { const float o = __shfl(gs, j * 8); grank += (o > gs || (o == gs && j < g)) ? 1 : 0; }
        const float msel = (grank < 4) ? sel : -1e30f;
        int rank = 0;
        for (int j = 0; j < 64; ++j) { const float o = __shfl(msel, j); rank += (o > msel || (o == msel && j < lane)) ? 1 : 0; }
        const bool chosen = rank < TOPK;
        const float wsum = wave_sum(chosen ? score : 0.f);
        if (chosen) {
            const unsigned ls = atomicAdd(&cnt[lane], 1u);
            tope[m * TOPK + rank] = lane; topw[m * TOPK + rank] = score / wsum * 2.5f; topls[m * TOPK + rank] = (int)ls;
        }
    }
}
__device__ void st_lists(const P& p, size_t gt, size_t ngt) {
    const unsigned* cnt = WSP(unsigned, WS_CTL) + CW_CNT; unsigned* basew = WSP(unsigned, WS_CTL) + CW_BASE;
    const int* tope = WSP(int, WS_TOPE); const float* topw = WSP(float, WS_TOPW); const int* topls = WSP(int, WS_TOPLS);
    int* pos = WSP(int, WS_POS); int* ltok = WSP(int, WS_LTOK); float* lw = WSP(float, WS_LW);
    for (size_t i = gt; i < (size_t)M_ * TOPK; i += ngt) {
        const int e = tope[i]; unsigned base = 0;
        for (int j = 0; j < e; ++j) base += (cnt[j] + 255u) & ~255u;
        const int slot = (int)base + topls[i];
        pos[i] = slot; ltok[slot] = (int)(i / TOPK); lw[slot] = topw[i];
    }
    for (size_t i = gt; i < (size_t)NE * 256; i += ngt) {
        const int e = (int)(i / 256), j = (int)(i % 256); unsigned base = 0;
        for (int q = 0; q < e; ++q) base += (cnt[q] + 255u) & ~255u;
        const unsigned n = cnt[e], np = (n + 255u) & ~255u;
        if (n + j < np) { ltok[base + n + j] = 0; lw[base + n + j] = 0.f; }
    }
    if (gt == 0) { unsigned base = 0; for (int e = 0; e < NE; ++e) { basew[e] = base; base += (cnt[e] + 255u) & ~255u; } basew[NE] = base; }
}
__device__ __forceinline__ int slot_expert(const unsigned* basew, int slot) { int e = 0; while (e < NE - 1 && (unsigned)slot >= basew[e + 1]) ++e; return e; }
__device__ void nv_gu(const P& p, size_t gt, size_t ngt) {
    const unsigned* basew = WSP(unsigned, WS_CTL) + CW_BASE; const int* ltok = WSP(int, WS_LTOK); const float* lw = WSP(float, WS_LW);
    const bf16_t* h2 = WSP(bf16_t, WS_H2); bf16_t* hid = WSP(bf16_t, WS_HID); bf16_t* hsh = WSP(bf16_t, WS_HSH);
    const int nslot = (int)basew[NE];
    const size_t t1 = (size_t)(nslot / 4) * EFF, t2 = (size_t)(M_ / 4) * 256;
    for (size_t i = gt; i < t1 + t2; i += ngt) {
        float g[4], u[4];
        if (i < t1) { const int j = (int)(i % EFF), sl = (int)(i / EFF) * 4; const int e = slot_expert(basew, sl);
            const bf16_t* a0 = h2 + (size_t)ltok[sl] * D_; const bf16_t* a1 = h2 + (size_t)ltok[sl + 1] * D_; const bf16_t* a2 = h2 + (size_t)ltok[sl + 2] * D_; const bf16_t* a3 = h2 + (size_t)ltok[sl + 3] * D_;
            const float* W = p.w_exp_gu + (size_t)e * D_ * 512;
            ndot4(g, a0, a1, a2, a3, p.g_moe, W + j, 512, D_); ndot4(u, a0, a1, a2, a3, p.g_moe, W + 256 + j, 512, D_);
#pragma unroll
            for (int r = 0; r < 4; ++r) hid[(size_t)(sl + r) * EFF + j] = f2bf(g[r] * sigmoidf_(g[r]) * u[r] * lw[sl + r]);
        } else { const size_t q = i - t1; const int j = (int)(q % 256), m = (int)(q / 256) * 4; const bf16_t* a = h2 + (size_t)m * D_;
            ndot4(g, a, a + D_, a + 2 * D_, a + 3 * D_, p.g_moe, p.w_sh_gu + j, 512, D_); ndot4(u, a, a + D_, a + 2 * D_, a + 3 * D_, p.g_moe, p.w_sh_gu + 256 + j, 512, D_);
#pragma unroll
            for (int r = 0; r < 4; ++r) hsh[(size_t)(m + r) * 256 + j] = f2bf(g[r] * sigmoidf_(g[r]) * u[r]);
        }
    }
}
__device__ void nv_down(const P& p, size_t gt, size_t ngt) {
    const unsigned* basew = WSP(unsigned, WS_CTL) + CW_BASE;
    const bf16_t* hid = WSP(bf16_t, WS_HID); const bf16_t* hsh = WSP(bf16_t, WS_HSH); bf16_t* Y = WSP(bf16_t, WS_Y);
    const int nslot = (int)basew[NE];
    const size_t t1 = (size_t)(nslot / 4) * D_, t2 = (size_t)(M_ / 4) * D_;
    for (size_t i = gt; i < t1 + t2; i += ngt) {
        float a[4];
        if (i < t1) { const int n = (int)(i % D_), sl = (int)(i / D_) * 4; const int e = slot_expert(basew, sl); const bf16_t* r0 = hid + (size_t)sl * EFF;
            ndot4(a, r0, r0 + EFF, r0 + 2 * EFF, r0 + 3 * EFF, nullptr, p.w_exp_down + (size_t)e * EFF * D_ + n, D_, EFF);
#pragma unroll
            for (int r = 0; r < 4; ++r) Y[(size_t)(sl + r) * D_ + n] = f2bf(a[r]);
        } else { const size_t q = i - t1; const int n = (int)(q % D_), m = (int)(q / D_) * 4; const bf16_t* r0 = hsh + (size_t)m * 256;
            ndot4(a, r0, r0 + 256, r0 + 512, r0 + 768, nullptr, p.w_sh_down + n, D_, 256);
#pragma unroll
            for (int r = 0; r < 4; ++r) p.out[(size_t)(m + r) * D_ + n] += a[r];
        }
    }
}
__device__ void st_combine(const P& p, int gw, int ngw, int lane) {
    const int* pos = WSP(int, WS_POS); const bf16_t* Y = WSP(bf16_t, WS_Y); bf16_t* h3 = WSP(bf16_t, WS_H3);
    for (int m = gw; m < M_; m += ngw) {
        float* xr = p.out + (size_t)m * D_; float v[16]; float s = 0.f;
#pragma unroll
        for (int j = 0; j < 16; ++j) v[j] = xr[lane + 64 * j];
        for (int k = 0; k < TOPK; ++k) { const bf16_t* yr = Y + (size_t)pos[m * TOPK + k] * D_;
#pragma unroll
            for (int j = 0; j < 16; ++j) v[j] += bf2f(yr[lane + 64 * j]); }
#pragma unroll
        for (int j = 0; j < 16; ++j) { s += v[j] * v[j]; xr[lane + 64 * j] = v[j]; }
        s = wave_sum(s); const float r = 1.f / sqrtf(s * (1.f / D_) + EPS);
#pragma unroll
        for (int j = 0; j < 16; ++j) h3[(size_t)m * D_ + lane + 64 * j] = f2bf(v[j] * r);
    }
}
__device__ void nv_ple(const P& p, size_t gt, size_t ngt) {
    const bf16_t* h3 = WSP(bf16_t, WS_H3); const bf16_t* pb = WSP(bf16_t, WS_PB);
    const size_t total = (size_t)(M_ / 4) * D_;
    for (size_t i = gt; i < total; i += ngt) {
        const int n = (int)(i % D_), m = (int)(i / D_) * 4; float a[4], c[4];
        const bf16_t* r0 = h3 + (size_t)m * D_; ndot4(a, r0, r0 + D_, r0 + 2 * D_, r0 + 3 * D_, p.g_ple, p.w_ple_gate + n, D_, D_);
        const bf16_t* r1 = pb + (size_t)m * 256; ndot4(c, r1, r1 + 256, r1 + 512, r1 + 768, nullptr, p.w_ple_proj + n, D_, 256);
#pragma unroll
        for (int r = 0; r < 4; ++r) p.out[(size_t)(m + r) * D_ + n] += sigmoidf_(a[r] + p.b_ple[n]) * c[r];
    }
}

constexpr int NT = 512;
constexpr int LDS_DYN = 96 * 1024;
__global__ void __launch_bounds__(NT) k_stage(P p) {
    extern __shared__ __attribute__((aligned(16))) unsigned char lds[];
    const int tid = threadIdx.x, lane = tid & 63, wave = tid >> 6;
    const int wg = blockIdx.x, nwg = gridDim.x;
    const int gw = wg * (NT / 64) + wave, ngw = nwg * (NT / 64);
    const size_t gt = (size_t)wg * NT + tid, ngt = (size_t)nwg * NT;
    switch (p.stage) {
        case 0: st_prep(p, gw, ngw, lane); break;
        case 1: nv_g1(p, gt, ngt); break;
        case 2: nv_g23(p, gt, ngt); break;
        case 3: st_attn_prep(p, wg, nwg, wave, lane, (bf16_t*)lds); break;
        case 4: nv_attn<96, false>(p, gt, ngt); break;
        case 5: nv_attn<64, true>(p, gt, ngt); break;
        case 6: nv_merge(p, gt, ngt); break;
        case 7: nv_out(p, gt, ngt); break;
        case 8: st_route(p, gw, ngw, lane, (float*)lds + wave * 1024); break;
        case 9: st_lists(p, gt, ngt); break;
        case 10: nv_gu(p, gt, ngt); break;
        case 11: nv_down(p, gt, ngt); break;
        case 12: st_combine(p, gw, ngw, lane); break;
        case 13: nv_ple(p, gt, ngt); break;
        default: break;
    }
}

extern "C" void kernel_launch(void* const* d_in, const int* in_sizes, int n_in, void* d_out, int out_size, void* d_ws, size_t ws_size, hipStream_t stream) {
    if (n_in != 29 || ws_size < WS_END) { fprintf(stderr, "kernel_launch: unexpected n_in %d or ws_size %zu\n", n_in, ws_size); return; }
    P p{};
    p.x = (const float*)d_in[0]; p.p = (const float*)d_in[1]; p.pos = (const int*)d_in[2];
#define IN_(name, i) p.name = (const float*)d_in[i]
    IN_(g_mix, 3); IN_(w_in, 4); IN_(b_gate, 5); IN_(g_cq, 6); IN_(w_uq, 7); IN_(g_ckv, 8); IN_(w_ukv, 9); IN_(g_qn_mla, 10); IN_(g_kn_mla, 11);
    IN_(g_qn_swa, 12); IN_(g_kn_swa, 13); IN_(sink, 14); IN_(w_br_mla, 15); IN_(w_br_swa, 16); IN_(w_out, 17); IN_(g_moe, 18); IN_(w_router, 19);
    IN_(router_bias, 20); IN_(w_exp_gu, 21); IN_(w_exp_down, 22); IN_(w_sh_gu, 23); IN_(w_sh_down, 24); IN_(g_ple, 25); IN_(w_ple_gate, 26); IN_(b_ple, 27); IN_(w_ple_proj, 28);
#undef IN_
    p.out = (float*)d_out; p.ws = (unsigned char*)d_ws;
    static bool attr_set = false;
    if (!attr_set) { hipFuncSetAttribute((const void*)k_stage, hipFuncAttributeMaxDynamicSharedMemorySize, LDS_DYN); attr_set = true; }
    hipMemsetAsync((char*)d_ws + WS_CTL, 0, CTL_BYTES, stream);
    for (int st = 0; st < 14; ++st) {
        p.stage = st;
        hipLaunchKernelGGL(k_stage, dim3(2048), dim3(NT), LDS_DYN, stream, p);
    }
}
```

```cpp
#include <hip/hip_runtime.h>
#include <stdint.h>
#include <cstdio>

constexpr int B_ = 8, S_ = 2048, D_ = 1024, M_ = B_ * S_;
constexpr int NZ = 3584;
constexpr int INW = 3488;
constexpr int ZQ = 0, ZKR = 384, ZCKV = 512, ZQS = 768, ZKS = 1280, ZVS = 1408, ZGA = 1536, ZGB = 2560;
constexpr int NE = 64, TOPK = 8, EFF = 256;
constexpr int NSLOT = M_ * TOPK + NE * 256;
constexpr float EPS = 1e-6f;
constexpr float LOG2E = 1.4426950408889634f;

typedef unsigned short bf16_t;
__device__ __forceinline__ float bf2f(bf16_t v) { return __uint_as_float((unsigned)v << 16); }
__device__ __forceinline__ bf16_t f2bf(float f) { unsigned u = __float_as_uint(f); return (bf16_t)((u + 0x7fffu + ((u >> 16) & 1u)) >> 16); }
__device__ __forceinline__ float sigmoidf_(float v) { return 1.f / (1.f + __expf(-v)); }
__device__ __forceinline__ float wave_sum(float v) {
#pragma unroll
    for (int o = 1; o < 64; o <<= 1) v += __shfl_xor(v, o);
    return v;
}
__device__ __forceinline__ float wave_max(float v) {
#pragma unroll
    for (int o = 1; o < 64; o <<= 1) v = fmaxf(v, __shfl_xor(v, o));
    return v;
}

constexpr size_t MiB = 1u << 20;
constexpr size_t WS_CTL = 0, CTL_BYTES = 64 * 1024;
constexpr size_t WS_TOPE = 1 * MiB, WS_TOPW = WS_TOPE + 512 * 1024, WS_TOPLS = WS_TOPW + 512 * 1024, WS_POS = WS_TOPLS + 512 * 1024;
constexpr size_t WS_LTOK = 3 * MiB, WS_LW = WS_LTOK + 640 * 1024;
constexpr size_t WS_PB = 6 * MiB, WS_WDN = 14 * MiB, WS_WPG = 48 * MiB, WS_WPP = 50 * MiB, WS_WSHDN = 50 * MiB + 512 * 1024;
constexpr size_t WS_HID = 51 * MiB, WS_HSH = 123 * MiB, WS_R = 131 * MiB;
constexpr size_t WS_WGU = 131 * MiB, WS_WSHGU = 195 * MiB, WS_WIN = 196 * MiB, WS_WUQ = 203 * MiB, WS_WUKV = 204 * MiB, WS_WBRM = 205 * MiB, WS_WBRS = 206 * MiB, WS_WOUT = 207 * MiB;
constexpr size_t WS_Z = 210 * MiB, WS_HB = 322 * MiB, WS_MG = 322 * MiB, WS_QMR = 354 * MiB, WS_OM = 354 * MiB, WS_OW = 370 * MiB, WS_KVR = 378 * MiB;
constexpr size_t WS_QM = 410 * MiB, WS_KM = 434 * MiB, WS_VTM = 458 * MiB, WS_QS = 474 * MiB, WS_KS = 490 * MiB, WS_VTS = 494 * MiB;
constexpr size_t WS_H2 = 210 * MiB, WS_Y = 131 * MiB, WS_H3 = 419 * MiB, WS_PP = 451 * MiB, WS_END = 498 * MiB;
constexpr int CW_CNT = 0;
constexpr int CW_BASE = 64;

struct P {
    const float *x, *p; const int* pos;
    const float *g_mix, *w_in, *b_gate, *g_cq, *w_uq, *g_ckv, *w_ukv, *g_qn_mla, *g_kn_mla, *g_qn_swa, *g_kn_swa, *sink;
    const float *w_br_mla, *w_br_swa, *w_out, *g_moe, *w_router, *router_bias, *w_exp_gu, *w_exp_down, *w_sh_gu, *w_sh_down;
    const float *g_ple, *w_ple_gate, *b_ple, *w_ple_proj;
    float* out; unsigned char* ws; int st_lo; int st_hi;
};
#define WSP(T, off) ((T*)(p.ws + (off)))

__device__ __forceinline__ void ndot4(float (&acc)[4], const bf16_t* a0, const bf16_t* a1, const bf16_t* a2, const bf16_t* a3, const float* g, const float* W, int ldw, int K) {
    float c0 = 0.f, c1 = 0.f, c2 = 0.f, c3 = 0.f;
    for (int k = 0; k < K; ++k) {
        const float w = W[(size_t)k * ldw] * (g ? g[k] : 1.f);
        c0 += bf2f(a0[k]) * w; c1 += bf2f(a1[k]) * w; c2 += bf2f(a2[k]) * w; c3 += bf2f(a3[k]) * w;
    }
    acc[0] = c0; acc[1] = c1; acc[2] = c2; acc[3] = c3;
}
__device__ __forceinline__ int zsrc(int n) {
    if (n < 384) return n;
    if (n < 416) return 640 + (n - 384);
    if (n < 512) return -1;
    if (n < 768) return 384 + (n - 512);
    if (n < 1280) return 672 + (n - 768);
    if (n < 1408) return 1184 + (n - 1280);
    if (n < 1536) return 1312 + (n - 1408);
    if (n < 2560) return 1440 + (n - 1536);
    return 2464 + (n - 2560);
}

__device__ __forceinline__ void st_prep(const P& p, int gw, int ngw, int lane) {
    bf16_t* hb = WSP(bf16_t, WS_HB); bf16_t* pb = WSP(bf16_t, WS_PB);
    for (int m = gw; m < M_; m += ngw) {
        const float* xr = p.x + (size_t)m * D_; float v[16]; float s = 0.f;
#pragma unroll
        for (int j = 0; j < 16; ++j) { v[j] = xr[lane + 64 * j]; s += v[j] * v[j]; }
        s = wave_sum(s); const float r = 1.f / sqrtf(s * (1.f / D_) + EPS);
#pragma unroll
        for (int j = 0; j < 16; ++j) hb[(size_t)m * D_ + lane + 64 * j] = f2bf(v[j] * r);
#pragma unroll
        for (int j = 0; j < 4; ++j) pb[(size_t)m * 256 + lane + 64 * j] = f2bf(p.p[(size_t)m * 256 + lane + 64 * j]);
    }
}
__device__ __forceinline__ void nv_g1(const P& p, size_t gt, size_t ngt) {
    const bf16_t* hb = WSP(bf16_t, WS_HB); bf16_t* z = WSP(bf16_t, WS_Z);
    const size_t total = (size_t)(M_ / 4) * NZ;
    for (size_t i = gt; i < total; i += ngt) {
        const int n = (int)(i % NZ); const int m = (int)(i / NZ) * 4; const int src = zsrc(n);
        float acc[4] = {0.f, 0.f, 0.f, 0.f};
        if (src >= 0) { const bf16_t* a = hb + (size_t)m * D_; ndot4(acc, a, a + D_, a + 2 * D_, a + 3 * D_, p.g_mix, p.w_in + src, INW, D_); }
#pragma unroll
        for (int r = 0; r < 4; ++r) { float v = acc[r]; if (n >= ZGA) v = sigmoidf_(v + p.b_gate[n - ZGA]); z[(size_t)(m + r) * NZ + n] = f2bf(v); }
    }
}
__device__ __forceinline__ void nv_g23(const P& p, size_t gt, size_t ngt) {
    const bf16_t* z = WSP(bf16_t, WS_Z); bf16_t* qmr = WSP(bf16_t, WS_QMR); bf16_t* kvr = WSP(bf16_t, WS_KVR);
    const size_t t1 = (size_t)(M_ / 4) * 768, t2 = (size_t)(M_ / 4) * 1024;
    for (size_t i = gt; i < t1 + t2; i += ngt) {
        float acc[4];
        if (i < t1) { const int n = (int)(i % 768), m = (int)(i / 768) * 4; const bf16_t* a = z + (size_t)m * NZ + ZQ;
            ndot4(acc, a, a + NZ, a + 2 * NZ, a + 3 * NZ, p.g_cq, p.w_uq + n, 768, 384);
#pragma unroll
            for (int r = 0; r < 4; ++r) qmr[(size_t)(m + r) * 768 + n] = f2bf(acc[r]);
        } else { const size_t j = i - t1; const int n = (int)(j % 1024), m = (int)(j / 1024) * 4; const bf16_t* a = z + (size_t)m * NZ + ZCKV;
            ndot4(acc, a, a + NZ, a + 2 * NZ, a + 3 * NZ, p.g_ckv, p.w_ukv + n, 1024, 256);
#pragma unroll
            for (int r = 0; r < 4; ++r) kvr[(size_t)(m + r) * 1024 + n] = f2bf(acc[r]);
        }
    }
}

constexpr int VT_PITCH = 66;
__device__ __forceinline__ void st_attn_prep(const P& p, int wg, int nwg, int wave, int lane, bf16_t* lds) {
    const bf16_t* z = WSP(bf16_t, WS_Z); const bf16_t* qmr = WSP(bf16_t, WS_QMR); const bf16_t* kvr = WSP(bf16_t, WS_KVR);
    bf16_t* QM = WSP(bf16_t, WS_QM); bf16_t* KM = WSP(bf16_t, WS_KM); bf16_t* VTM = WSP(bf16_t, WS_VTM);
    bf16_t* QS = WSP(bf16_t, WS_QS); bf16_t* KS = WSP(bf16_t, WS_KS); bf16_t* VTS = WSP(bf16_t, WS_VTS);
    const float sc_m = 0.10206207261596575f * LOG2E;
    const float sc_s = 0.125f * LOG2E;
    for (int tile = wg; tile < M_ / 64; tile += nwg) {
        __syncthreads();
        for (int tt = 0; tt < 8; ++tt) {
            const int tl = wave * 8 + tt, m = tile * 64 + tl, b = m / S_, s = m % S_;
            const bf16_t* zr = z + (size_t)m * NZ;
            const float posf = (float)p.pos[m];
            float sq = 0.f, skv = 0.f;
#pragma unroll
            for (int j = 0; j < 6; ++j) { const float v = bf2f(zr[ZQ + lane + 64 * j]); sq += v * v; }
#pragma unroll
            for (int j = 0; j < 4; ++j) { const float v = bf2f(zr[ZCKV + lane + 64 * j]); skv += v * v; }
            sq = wave_sum(sq); skv = wave_sum(skv);
            const float rq = 1.f / sqrtf(sq * (1.f / 384.f) + EPS), rkv = 1.f / sqrtf(skv * (1.f / 256.f) + EPS);
            const float inv_m = exp2f(-13.287712379549449f * (float)(lane & 15) * (1.f / 16.f));
            const float inv_s = exp2f(-13.287712379549449f * (float)(lane & 31) * (1.f / 32.f));
            float cm, sm, cs, ss; sincosf(posf * inv_m, &sm, &cm); sincosf(posf * inv_s, &ss, &cs);
            const float krope = bf2f(zr[ZKR + (lane & 31)]);
            for (int h = 0; h < 8; ++h) {
                { float v0 = bf2f(qmr[(size_t)m * 768 + h * 96 + lane]) * rq;
                  float v1 = (lane < 32) ? bf2f(qmr[(size_t)m * 768 + h * 96 + 64 + lane]) * rq : 0.f;
                  const float ssum = wave_sum(v0 * v0 + v1 * v1); const float r = 1.f / sqrtf(ssum * (1.f / 96.f) + EPS);
                  v0 *= r * p.g_qn_mla[lane]; v1 *= (lane < 32) ? r * p.g_qn_mla[64 + lane] : 0.f;
                  const float o = __shfl_xor(v1, 16);
                  const float rot = (lane < 16) ? (v1 * cm - o * sm) : (v1 * cm + o * sm);
                  bf16_t* dst = QM + ((size_t)(b * 8 + h) * S_ + s) * 96;
                  dst[lane] = f2bf(v0 * sc_m); if (lane < 32) dst[64 + lane] = f2bf(rot * sc_m); }
                { float v0 = bf2f(kvr[(size_t)m * 1024 + h * 128 + lane]) * rkv;
                  float v1 = (lane < 32) ? krope : 0.f;
                  const float ssum = wave_sum(v0 * v0 + v1 * v1); const float r = 1.f / sqrtf(ssum * (1.f / 96.f) + EPS);
                  v0 *= r * p.g_kn_mla[lane]; v1 *= (lane < 32) ? r * p.g_kn_mla[64 + lane] : 0.f;
                  const float o = __shfl_xor(v1, 16);
                  const float rot = (lane < 16) ? (v1 * cm - o * sm) : (v1 * cm + o * sm);
                  bf16_t* dst = KM + ((size_t)(b * 8 + h) * S_ + s) * 96;
                  dst[lane] = f2bf(v0); if (lane < 32) dst[64 + lane] = f2bf(rot);
                  const float vv = bf2f(kvr[(size_t)m * 1024 + h * 128 + 64 + lane]) * rkv;
                  lds[(h * 64 + lane) * VT_PITCH + tl] = f2bf(vv); }
                { float v = bf2f(zr[ZQS + h * 64 + lane]);
                  const float ssum = wave_sum(v * v); const float r = 1.f / sqrtf(ssum * (1.f / 64.f) + EPS);
                  v *= r * p.g_qn_swa[lane];
                  const float o = __shfl_xor(v, 32);
                  const float rot = (lane < 32) ? (v * cs - o * ss) : (v * cs + o * ss);
                  QS[((size_t)(b * 8 + h) * S_ + s) * 64 + lane] = f2bf(rot * sc_s); }
                if (h < 2) {
                  float v = bf2f(zr[ZKS + h * 64 + lane]);
                  const float ssum = wave_sum(v * v); const float r = 1.f / sqrtf(ssum * (1.f / 64.f) + EPS);
                  v *= r * p.g_kn_swa[lane];
                  const float o = __shfl_xor(v, 32);
                  const float rot = (lane < 32) ? (v * cs - o * ss) : (v * cs + o * ss);
                  KS[((size_t)(b * 2 + h) * S_ + s) * 64 + lane] = f2bf(rot);
                  lds[(512 + h * 64 + lane) * VT_PITCH + tl] = zr[ZVS + h * 64 + lane]; }
            }
        }
        __syncthreads();
        const int b = (tile * 64) / S_, s0 = (tile * 64) % S_;
        for (int r = wave; r < 640; r += 8) {
            const bf16_t v = lds[r * VT_PITCH + lane];
            if (r < 512) VTM[((size_t)(b * 8 + (r >> 6)) * 64 + (r & 63)) * S_ + s0 + lane] = v;
            else { const int rr = r - 512; VTS[((size_t)(b * 2 + (rr >> 6)) * 64 + (rr & 63)) * S_ + s0 + lane] = v; }
        }
    }
}

template <int DK, bool SWA>
__device__ __forceinline__ void nv_attn(const P& p, size_t gt, size_t ngt) {
    const bf16_t* Q = SWA ? WSP(bf16_t, WS_QS) : WSP(bf16_t, WS_QM);
    const bf16_t* K = SWA ? WSP(bf16_t, WS_KS) : WSP(bf16_t, WS_KM);
    const bf16_t* VT = SWA ? WSP(bf16_t, WS_VTS) : WSP(bf16_t, WS_VTM);
    bf16_t* O = SWA ? WSP(bf16_t, WS_OW) : WSP(bf16_t, WS_OM);
    const size_t total = (size_t)B_ * 8 * S_;
    for (size_t i = gt; i < total; i += ngt) {
        const int q = (int)(i % S_), h = (int)((i / S_) % 8), b = (int)(i / ((size_t)S_ * 8));
        const int kvh = SWA ? (b * 2 + h / 4) : (b * 8 + h);
        const bf16_t* qp = Q + ((size_t)(b * 8 + h) * S_ + q) * DK;
        const bf16_t* kb = K + (size_t)kvh * S_ * DK; const bf16_t* vb = VT + (size_t)kvh * 64 * S_;
        float m, l; float o[64]; unsigned qf[DK / 2];
#pragma unroll
        for (int d = 0; d < 64; ++d) o[d] = 0.f;
#pragma unroll
        for (int d = 0; d < DK / 2; ++d) qf[d] = ((const unsigned*)qp)[d];
        if (SWA) { m = p.sink[h] * LOG2E; l = 1.f; } else { m = -1e30f; l = 0.f; }
        const int k0 = SWA ? max(0, q - 128) : 0, k1 = SWA ? min(S_ - 1, q + 128) : S_ - 1;
        for (int k = k0; k <= k1; ++k) {
            float s = 0.f; const bf16_t* kp = kb + (size_t)k * DK;
#pragma unroll
            for (int d = 0; d < DK / 2; ++d) { const unsigned kk = ((const unsigned*)kp)[d];
                s += __uint_as_float(qf[d] << 16) * __uint_as_float(kk << 16) + __uint_as_float(qf[d] & 0xffff0000u) * __uint_as_float(kk & 0xffff0000u); }
            const float mn = fmaxf(m, s), al = exp2f(m - mn), pr = exp2f(s - mn);
            l = l * al + pr; m = mn;
#pragma unroll
            for (int d = 0; d < 64; ++d) o[d] = o[d] * al + pr * bf2f(vb[(size_t)d * S_ + k]);
        }
        const float il = 1.f / l;
        bf16_t* op = O + ((size_t)(b * S_ + q)) * 512 + h * 64;
#pragma unroll
        for (int d = 0; d < 64; ++d) op[d] = f2bf(o[d] * il);
    }
}
__device__ __forceinline__ void nv_merge(const P& p, size_t gt, size_t ngt) {
    const bf16_t* z = WSP(bf16_t, WS_Z); const bf16_t* om = WSP(bf16_t, WS_OM); const bf16_t* ow = WSP(bf16_t, WS_OW); bf16_t* mg = WSP(bf16_t, WS_MG);
    const size_t total = (size_t)(M_ / 4) * D_;
    for (size_t i = gt; i < total; i += ngt) {
        const int n = (int)(i % D_), m = (int)(i / D_) * 4; float a[4], c[4];
        const bf16_t* r0 = om + (size_t)m * 512; ndot4(a, r0, r0 + 512, r0 + 1024, r0 + 1536, nullptr, p.w_br_mla + n, D_, 512);
        const bf16_t* r1 = ow + (size_t)m * 512; ndot4(c, r1, r1 + 512, r1 + 1024, r1 + 1536, nullptr, p.w_br_swa + n, D_, 512);
#pragma unroll
        for (int r = 0; r < 4; ++r) { const bf16_t* zr = z + (size_t)(m + r) * NZ; mg[(size_t)(m + r) * D_ + n] = f2bf(bf2f(zr[ZGA + n]) * a[r] + bf2f(zr[ZGB + n]) * c[r]); }
    }
}
__device__ __forceinline__ void nv_out(const P& p, size_t gt, size_t ngt) {
    const bf16_t* mg = WSP(bf16_t, WS_MG);
    const size_t total = (size_t)(M_ / 4) * D_;
    for (size_t i = gt; i < total; i += ngt) {
        const int n = (int)(i % D_), m = (int)(i / D_) * 4; float a[4];
        const bf16_t* r0 = mg + (size_t)m * D_; ndot4(a, r0, r0 + D_, r0 + 2 * D_, r0 + 3 * D_, nullptr, p.w_out + n, D_, D_);
#pragma unroll
        for (int r = 0; r < 4; ++r) p.out[(size_t)(m + r) * D_ + n] = p.x[(size_t)(m + r) * D_ + n] + a[r];
    }
}
__device__ __forceinline__ void st_route(const P& p, int gw, int ngw, int lane, float* xs) {
    bf16_t* h2 = WSP(bf16_t, WS_H2); int* tope = WSP(int, WS_TOPE); float* topw = WSP(float, WS_TOPW); int* topls = WSP(int, WS_TOPLS);
    unsigned* cnt = WSP(unsigned, WS_CTL) + CW_CNT;
    for (int m = gw; m < M_; m += ngw) {
        const float* xr = p.out + (size_t)m * D_; float v[16]; float s = 0.f;
#pragma unroll
        for (int j = 0; j < 16; ++j) { v[j] = xr[lane + 64 * j]; s += v[j] * v[j]; }
        s = wave_sum(s); const float r = 1.f / sqrtf(s * (1.f / D_) + EPS);
#pragma unroll
        for (int j = 0; j < 16; ++j) { const float xn = v[j] * r; h2[(size_t)m * D_ + lane + 64 * j] = f2bf(xn); xs[lane + 64 * j] = xn * p.g_moe[lane + 64 * j]; }
        __builtin_amdgcn_s_waitcnt(0xc07f);
        float logit = 0.f;
        for (int k = 0; k < D_; ++k) logit += xs[k] * p.w_router[(size_t)k * NE + lane];
        const float score = sigmoidf_(logit); const float sel = score + p.router_bias[lane];
        float m1 = sel;
        m1 = fmaxf(m1, __shfl_xor(m1, 1)); m1 = fmaxf(m1, __shfl_xor(m1, 2)); m1 = fmaxf(m1, __shfl_xor(m1, 4));
        const unsigned long long eqm = __ballot(sel == m1);
        const int g = lane >> 3; const unsigned gm = (unsigned)((eqm >> (g * 8)) & 0xffull);
        const int first = __ffs((int)gm) - 1;
        float v2 = ((lane & 7) == first) ? -3.0e38f : sel;
        v2 = fmaxf(v2, __shfl_xor(v2, 1)); v2 = fmaxf(v2, __shfl_xor(v2, 2)); v2 = fmaxf(v2, __shfl_xor(v2, 4));
        const float gs = m1 + v2;
        int grank = 0;
#pragma unroll
        for (int j = 0; j < 8; ++j) { const float o = __shfl(gs, j * 8); grank += (o > gs || (o == gs && j < g)) ? 1 : 0; }
        const float msel = (grank < 4) ? sel : -1e30f;
        int rank = 0;
        for (int j = 0; j < 64; ++j) { const float o = __shfl(msel, j); rank += (o > msel || (o == msel && j < lane)) ? 1 : 0; }
        const bool chosen = rank < TOPK;
        const float wsum = wave_sum(chosen ? score : 0.f);
        if (chosen) {
            const unsigned ls = atomicAdd(&cnt[lane], 1u);
            tope[m * TOPK + rank] = lane; topw[m * TOPK + rank] = score / wsum * 2.5f; topls[m * TOPK + rank] = (int)ls;
        }
    }
}
__device__ __forceinline__ void st_lists(const P& p, size_t gt, size_t ngt) {
    const unsigned* cnt = WSP(unsigned, WS_CTL) + CW_CNT; unsigned* basew = WSP(unsigned, WS_CTL) + CW_BASE;
    const int* tope = WSP(int, WS_TOPE); const float* topw = WSP(float, WS_TOPW); const int* topls = WSP(int, WS_TOPLS);
    int* pos = WSP(int, WS_POS); int* ltok = WSP(int, WS_LTOK); float* lw = WSP(float, WS_LW);
    for (size_t i = gt; i < (size_t)M_ * TOPK; i += ngt) {
        const int e = tope[i]; unsigned base = 0;
        for (int j = 0; j < e; ++j) base += (cnt[j] + 255u) & ~255u;
        const int slot = (int)base + topls[i];
        pos[i] = slot; ltok[slot] = (int)(i / TOPK); lw[slot] = topw[i];
    }
    for (size_t i = gt; i < (size_t)NE * 256; i += ngt) {
        const int e = (int)(i / 256), j = (int)(i % 256); unsigned base = 0;
        for (int q = 0; q < e; ++q) base += (cnt[q] + 255u) & ~255u;
        const unsigned n = cnt[e], np = (n + 255u) & ~255u;
        if (n + j < np) { ltok[base + n + j] = 0; lw[base + n + j] = 0.f; }
    }
    if (gt == 0) { unsigned base = 0; for (int e = 0; e < NE; ++e) { basew[e] = base; base += (cnt[e] + 255u) & ~255u; } basew[NE] = base; }
}
__device__ __forceinline__ int slot_expert(const unsigned* basew, int slot) { int e = 0; while (e < NE - 1 && (unsigned)slot >= basew[e + 1]) ++e; return e; }
__device__ __forceinline__ void nv_gu(const P& p, size_t gt, size_t ngt) {
    const unsigned* basew = WSP(unsigned, WS_CTL) + CW_BASE; const int* ltok = WSP(int, WS_LTOK); const float* lw = WSP(float, WS_LW);
    const bf16_t* h2 = WSP(bf16_t, WS_H2); bf16_t* hid = WSP(bf16_t, WS_HID); bf16_t* hsh = WSP(bf16_t, WS_HSH);
    const int nslot = (int)basew[NE];
    const size_t t1 = (size_t)(nslot / 4) * EFF, t2 = (size_t)(M_ / 4) * 256;
    for (size_t i = gt; i < t1 + t2; i += ngt) {
        float g[4], u[4];
        if (i < t1) { const int j = (int)(i % EFF), sl = (int)(i / EFF) * 4; const int e = slot_expert(basew, sl);
            const bf16_t* a0 = h2 + (size_t)ltok[sl] * D_; const bf16_t* a1 = h2 + (size_t)ltok[sl + 1] * D_; const bf16_t* a2 = h2 + (size_t)ltok[sl + 2] * D_; const bf16_t* a3 = h2 + (size_t)ltok[sl + 3] * D_;
            const float* W = p.w_exp_gu + (size_t)e * D_ * 512;
            ndot4(g, a0, a1, a2, a3, p.g_moe, W + j, 512, D_); ndot4(u, a0, a1, a2, a3, p.g_moe, W + 256 + j, 512, D_);
#pragma unroll
            for (int r = 0; r < 4; ++r) hid[(size_t)(sl + r) * EFF + j] = f2bf(g[r] * sigmoidf_(g[r]) * u[r] * lw[sl + r]);
        } else { const size_t q = i - t1; const int j = (int)(q % 256), m = (int)(q / 256) * 4; const bf16_t* a = h2 + (size_t)m * D_;
            ndot4(g, a, a + D_, a + 2 * D_, a + 3 * D_, p.g_moe, p.w_sh_gu + j, 512, D_); ndot4(u, a, a + D_, a + 2 * D_, a + 3 * D_, p.g_moe, p.w_sh_gu + 256 + j, 512, D_);
#pragma unroll
            for (int r = 0; r < 4; ++r) hsh[(size_t)(m + r) * 256 + j] = f2bf(g[r] * sigmoidf_(g[r]) * u[r]);
        }
    }
}
__device__ __forceinline__ void nv_down(const P& p, size_t gt, size_t ngt) {
    const unsigned* basew = WSP(unsigned, WS_CTL) + CW_BASE;
    const bf16_t* hid = WSP(bf16_t, WS_HID); const bf16_t* hsh = WSP(bf16_t, WS_HSH); bf16_t* Y = WSP(bf16_t, WS_Y);
    const int nslot = (int)basew[NE];
    const size_t t1 = (size_t)(nslot / 4) * D_, t2 = (size_t)(M_ / 4) * D_;
    for (size_t i = gt; i < t1 + t2; i += ngt) {
        float a[4];
        if (i < t1) { const int n = (int)(i % D_), sl = (int)(i / D_) * 4; const int e = slot_expert(basew, sl); const bf16_t* r0 = hid + (size_t)sl * EFF;
            ndot4(a, r0, r0 + EFF, r0 + 2 * EFF, r0 + 3 * EFF, nullptr, p.w_exp_down + (size_t)e * EFF * D_ + n, D_, EFF);
#pragma unroll
            for (int r = 0; r < 4; ++r) Y[(size_t)(sl + r) * D_ + n] = f2bf(a[r]);
        } else { const size_t q = i - t1; const int n = (int)(q % D_), m = (int)(q / D_) * 4; const bf16_t* r0 = hsh + (size_t)m * 256;
            ndot4(a, r0, r0 + 256, r0 + 512, r0 + 768, nullptr, p.w_sh_down + n, D_, 256);
#pragma unroll
            for (int r = 0; r < 4; ++r) p.out[(size_t)(m + r) * D_ + n] += a[r];
        }
    }
}
__device__ __forceinline__ void st_combine(const P& p, int gw, int ngw, int lane) {
    const int* pos = WSP(int, WS_POS); const bf16_t* Y = WSP(bf16_t, WS_Y); bf16_t* h3 = WSP(bf16_t, WS_H3);
    for (int m = gw; m < M_; m += ngw) {
        float* xr = p.out + (size_t)m * D_; float v[16]; float s = 0.f;
#pragma unroll
        for (int j = 0; j < 16; ++j) v[j] = xr[lane + 64 * j];
        for (int k = 0; k < TOPK; ++k) { const bf16_t* yr = Y + (size_t)pos[m * TOPK + k] * D_;
#pragma unroll
            for (int j = 0; j < 16; ++j) v[j] += bf2f(yr[lane + 64 * j]); }
#pragma unroll
        for (int j = 0; j < 16; ++j) { s += v[j] * v[j]; xr[lane + 64 * j] = v[j]; }
        s = wave_sum(s); const float r = 1.f / sqrtf(s * (1.f / D_) + EPS);
#pragma unroll
        for (int j = 0; j < 16; ++j) h3[(size_t)m * D_ + lane + 64 * j] = f2bf(v[j] * r);
    }
}
__device__ __forceinline__ void nv_ple(const P& p, size_t gt, size_t ngt) {
    const bf16_t* h3 = WSP(bf16_t, WS_H3); const bf16_t* pb = WSP(bf16_t, WS_PB);
    const size_t total = (size_t)(M_ / 4) * D_;
    for (size_t i = gt; i < total; i += ngt) {
        const int n = (int)(i % D_), m = (int)(i / D_) * 4; float a[4], c[4];
        const bf16_t* r0 = h3 + (size_t)m * D_; ndot4(a, r0, r0 + D_, r0 + 2 * D_, r0 + 3 * D_, p.g_ple, p.w_ple_gate + n, D_, D_);
        const bf16_t* r1 = pb + (size_t)m * 256; ndot4(c, r1, r1 + 256, r1 + 512, r1 + 768, nullptr, p.w_ple_proj + n, D_, 256);
#pragma unroll
        for (int r = 0; r < 4; ++r) p.out[(size_t)(m + r) * D_ + n] += sigmoidf_(a[r] + p.b_ple[n]) * c[r];
    }
}


#define LAS __attribute__((address_space(3)))
#define XB_TMO      128
#define XB_XCNT(j)  (256  + 64 * (j))
#define XB_XSUB(j)  (1280 + 64 * (j))
#define XB_XGEN(j)  (2304 + 64 * (j))
#define XB_TOP      3328
#define XB_TOPGEN   3392
#define XCD_BAR_WORDS 3456
#define XB_SPIN_CAP (1u << 18)
__device__ __forceinline__ unsigned xb_ld(unsigned* p)              { return __hip_atomic_load(p, __ATOMIC_RELAXED, __HIP_MEMORY_SCOPE_AGENT); }
__device__ __forceinline__ unsigned xb_add(unsigned* p, unsigned v) { return __hip_atomic_fetch_add(p, v, __ATOMIC_RELAXED, __HIP_MEMORY_SCOPE_AGENT); }
__device__ __forceinline__ unsigned xb_xcc_id() { return (unsigned)__builtin_amdgcn_s_getreg((3 << 11) | 20) & 0xFu; }
#define XB_SPIN(cond, bar) do { unsigned _sp = 0; while (cond) { __builtin_amdgcn_s_sleep(1); \
    if ((++_sp & 255u) == 0u) { if (xb_ld(&(bar)[XB_TMO])) break; if (_sp > XB_SPIN_CAP) { atomicAdd(&(bar)[XB_TMO], 1u); break; } } } } while (0)
struct XcdBarrier { unsigned* bar; unsigned x; volatile LAS unsigned* st; };
__device__ __forceinline__ XcdBarrier xcd_barrier_post(unsigned* bar, volatile LAS unsigned* st) {
    XcdBarrier b; b.bar = bar; b.x = xb_xcc_id(); b.st = st;
    if (threadIdx.x == 0) (void)xb_add(&bar[XB_XCNT(b.x)], 1u);
    return b;
}
__device__ __forceinline__ void xcd_barrier_complete(unsigned* bar, unsigned x, unsigned& nloc, unsigned& nx) {
    const unsigned G = gridDim.x * gridDim.y * gridDim.z;
    unsigned sum, cnt, mine, sp = 0u;
    for (;;) {
        sum = 0u; cnt = 0u; mine = 0u;
#pragma unroll
        for (unsigned j = 0; j < 16; ++j) { const unsigned c = xb_ld(&bar[XB_XCNT(j)]); sum += c; cnt += (c > 0u) ? 1u : 0u; mine = (j == x) ? c : mine; }
        if (sum == G) break;
        __builtin_amdgcn_s_sleep(1);
        if ((++sp & 255u) == 0u) { if (xb_ld(&bar[XB_TMO])) break; if (sp > XB_SPIN_CAP) { atomicAdd(&bar[XB_TMO], 1u); break; } }
    }
    nloc = mine > 0u ? mine : 1u; nx = cnt > 0u ? cnt : 1u;
}
__device__ __forceinline__ void xcd_barrier(const XcdBarrier& b) {
    asm volatile("s_waitcnt vmcnt(0)" ::: "memory");
    __syncthreads();
    if (threadIdx.x == 0) {
        unsigned* bar = b.bar;
        __builtin_amdgcn_s_waitcnt(0);
        unsigned nloc = b.st[0], nx = b.st[1];
        if (nloc == 0u) { xcd_barrier_complete(bar, b.x, nloc, nx); b.st[0] = nloc; b.st[1] = nx; }
        const unsigned old = xb_add(&bar[XB_XSUB(b.x)], 1u);
        const unsigned gen = old / nloc;
        if (old + 1u == (gen + 1u) * nloc) {
            __builtin_amdgcn_fence(__ATOMIC_RELEASE, "agent");
            asm volatile("s_waitcnt vmcnt(0)" ::: "memory");
            const unsigned og = xb_add(&bar[XB_TOP], 1u);
            const unsigned tg = og / nx;
            if (og + 1u == (tg + 1u) * nx) xb_add(&bar[XB_TOPGEN], 1u);
            else XB_SPIN(xb_ld(&bar[XB_TOPGEN]) == tg, bar);
            __builtin_amdgcn_fence(__ATOMIC_ACQUIRE, "agent");
            xb_add(&bar[XB_XGEN(b.x)], 1u);
            asm volatile("s_waitcnt vmcnt(0)" ::: "memory");
        } else {
            XB_SPIN(xb_ld(&bar[XB_XGEN(b.x)]) == gen, bar);
            __builtin_amdgcn_fence(__ATOMIC_ACQUIRE, "agent");
            asm volatile("s_waitcnt vmcnt(0)" ::: "memory");
        }
    }
    __syncthreads();
}
constexpr int CW_BAR = 4096;

constexpr int NT = 512;
constexpr int LDS_DYN = 96 * 1024;
constexpr int MISC_OFF = LDS_DYN - 64;
constexpr int N_STAGES = 14;
__global__ void __launch_bounds__(NT) k_fwd(P p) {
    extern __shared__ __attribute__((aligned(16))) unsigned char lds[];
    const int tid = threadIdx.x, lane = tid & 63, wave = tid >> 6;
    const int wg = blockIdx.x, nwg = gridDim.x;
    const int gw = wg * (NT / 64) + wave, ngw = nwg * (NT / 64);
    const size_t gt = (size_t)wg * NT + tid, ngt = (size_t)nwg * NT;
    volatile LAS unsigned* misc = (volatile LAS unsigned*)((LAS unsigned char*)lds + MISC_OFF);
    if (tid < 16) misc[tid] = 0u;
    __syncthreads();
    XcdBarrier bar = xcd_barrier_post(WSP(unsigned, WS_CTL) + CW_BAR, misc);
    const int lo = p.st_lo, hi = p.st_hi;
#define RUN(k, call) if (lo <= (k) && (k) < hi) { call; if ((k) + 1 < hi) xcd_barrier(bar); }
    RUN(0, st_prep(p, gw, ngw, lane))
    RUN(1, nv_g1(p, gt, ngt))
    RUN(2, nv_g23(p, gt, ngt))
    RUN(3, st_attn_prep(p, wg, nwg, wave, lane, (bf16_t*)lds))
    RUN(4, (nv_attn<96, false>(p, gt, ngt)))
    RUN(5, (nv_attn<64, true>(p, gt, ngt)))
    RUN(6, nv_merge(p, gt, ngt))
    RUN(7, nv_out(p, gt, ngt))
    RUN(8, st_route(p, gw, ngw, lane, (float*)lds + wave * 1024))
    RUN(9, st_lists(p, gt, ngt))
    RUN(10, nv_gu(p, gt, ngt))
    RUN(11, nv_down(p, gt, ngt))
    RUN(12, st_combine(p, gw, ngw, lane))
    RUN(13, nv_ple(p, gt, ngt))
#undef RUN
}

extern "C" void kernel_launch(void* const* d_in, const int* in_sizes, int n_in, void* d_out, int out_size, void* d_ws, size_t ws_size, hipStream_t stream) {
    if (n_in != 29 || ws_size < WS_END) { fprintf(stderr, "kernel_launch: unexpected n_in %d or ws_size %zu\n", n_in, ws_size); return; }
    P p{};
    p.x = (const float*)d_in[0]; p.p = (const float*)d_in[1]; p.pos = (const int*)d_in[2];
#define IN_(name, i) p.name = (const float*)d_in[i]
    IN_(g_mix, 3); IN_(w_in, 4); IN_(b_gate, 5); IN_(g_cq, 6); IN_(w_uq, 7); IN_(g_ckv, 8); IN_(w_ukv, 9); IN_(g_qn_mla, 10); IN_(g_kn_mla, 11);
    IN_(g_qn_swa, 12); IN_(g_kn_swa, 13); IN_(sink, 14); IN_(w_br_mla, 15); IN_(w_br_swa, 16); IN_(w_out, 17); IN_(g_moe, 18); IN_(w_router, 19);
    IN_(router_bias, 20); IN_(w_exp_gu, 21); IN_(w_exp_down, 22); IN_(w_sh_gu, 23); IN_(w_sh_down, 24); IN_(g_ple, 25); IN_(w_ple_gate, 26); IN_(b_ple, 27); IN_(w_ple_proj, 28);
#undef IN_
    p.out = (float*)d_out; p.ws = (unsigned char*)d_ws;
    static int grid = 0;
    if (grid == 0) {
        int dev = 0, cus = 0, per_cu = 0;
        (void)hipGetDevice(&dev); (void)hipDeviceGetAttribute(&cus, hipDeviceAttributeMultiprocessorCount, dev);
        (void)hipFuncSetAttribute((const void*)k_fwd, hipFuncAttributeMaxDynamicSharedMemorySize, LDS_DYN);
        (void)hipOccupancyMaxActiveBlocksPerMultiprocessor(&per_cu, (const void*)k_fwd, NT, LDS_DYN);
        (void)hipGetLastError();
        if (per_cu < 1) { fprintf(stderr, "kernel_launch: occupancy query says %d blocks per CU\n", per_cu); grid = -1; return; }
        grid = cus;
    }
    if (grid < 0) return;
    (void)hipMemsetAsync((char*)d_ws + WS_CTL, 0, CTL_BYTES, stream);
    p.st_lo = 0; p.st_hi = N_STAGES;
    void* args[] = {&p};
    hipError_t e = hipLaunchCooperativeKernel((const void*)k_fwd, dim3(grid), dim3(NT), args, LDS_DYN, stream);
    if (e != hipSuccess) fprintf(stderr, "cooperative launch failed: %s (grid %d)\n", hipGetErrorString(e), grid);
}
```

```cpp
#include <hip/hip_runtime.h>
#include <stdint.h>
#include <cstdio>

constexpr int B_ = 8, S_ = 2048, D_ = 1024, M_ = B_ * S_;
constexpr int NZ = 3584;
constexpr int INW = 3488;
constexpr int ZQ = 0, ZKR = 384, ZCKV = 512, ZQS = 768, ZKS = 1280, ZVS = 1408, ZGA = 1536, ZGB = 2560;
constexpr int NE = 64, TOPK = 8, EFF = 256;
constexpr int NSLOT = M_ * TOPK + NE * 256;
constexpr float EPS = 1e-6f;
constexpr float LOG2E = 1.4426950408889634f;

typedef unsigned short bf16_t;
__device__ __forceinline__ float bf2f(bf16_t v) { return __uint_as_float((unsigned)v << 16); }
__device__ __forceinline__ bf16_t f2bf(float f) { unsigned u = __float_as_uint(f); return (bf16_t)((u + 0x7fffu + ((u >> 16) & 1u)) >> 16); }
__device__ __forceinline__ float sigmoidf_(float v) { return 1.f / (1.f + __expf(-v)); }
__device__ __forceinline__ float wave_sum(float v) {
#pragma unroll
    for (int o = 1; o < 64; o <<= 1) v += __shfl_xor(v, o);
    return v;
}
__device__ __forceinline__ float wave_max(float v) {
#pragma unroll
    for (int o = 1; o < 64; o <<= 1) v = fmaxf(v, __shfl_xor(v, o));
    return v;
}

constexpr size_t MiB = 1u << 20;
constexpr size_t WS_CTL = 0, CTL_BYTES = 64 * 1024;
constexpr size_t WS_TOPE = 1 * MiB, WS_TOPW = WS_TOPE + 512 * 1024, WS_TOPLS = WS_TOPW + 512 * 1024, WS_POS = WS_TOPLS + 512 * 1024;
constexpr size_t WS_LTOK = 3 * MiB, WS_LW = WS_LTOK + 640 * 1024;
constexpr size_t WS_PB = 6 * MiB, WS_WDN = 14 * MiB, WS_WPG = 48 * MiB, WS_WPP = 50 * MiB, WS_WSHDN = 46 * MiB;
constexpr size_t WS_HID = 51 * MiB, WS_HSH = 123 * MiB, WS_R = 131 * MiB;
constexpr size_t WS_WGU = 131 * MiB, WS_WSHGU = 195 * MiB, WS_WIN = 196 * MiB, WS_WUQ = 203 * MiB, WS_WUKV = 204 * MiB, WS_WBRM = 205 * MiB, WS_WBRS = 206 * MiB, WS_WOUT = 207 * MiB;
constexpr size_t WS_Z = 210 * MiB, WS_HB = 322 * MiB, WS_MG = 322 * MiB, WS_QMR = 354 * MiB, WS_OM = 354 * MiB, WS_OW = 370 * MiB, WS_KVR = 378 * MiB;
constexpr size_t WS_QM = 410 * MiB, WS_KM = 434 * MiB, WS_VTM = 458 * MiB, WS_QS = 474 * MiB, WS_KS = 490 * MiB, WS_VTS = 494 * MiB;
constexpr size_t WS_H2 = 210 * MiB, WS_Y = 131 * MiB, WS_H3 = 419 * MiB, WS_PP = 451 * MiB, WS_END = 498 * MiB;
constexpr int CW_CNT = 0;
constexpr int CW_BASE = 64;

struct P {
    const float *x, *p; const int* pos;
    const float *g_mix, *w_in, *b_gate, *g_cq, *w_uq, *g_ckv, *w_ukv, *g_qn_mla, *g_kn_mla, *g_qn_swa, *g_kn_swa, *sink;
    const float *w_br_mla, *w_br_swa, *w_out, *g_moe, *w_router, *router_bias, *w_exp_gu, *w_exp_down, *w_sh_gu, *w_sh_down;
    const float *g_ple, *w_ple_gate, *b_ple, *w_ple_proj;
    float* out; unsigned char* ws; int st_lo; int st_hi;
};
#define WSP(T, off) ((T*)(p.ws + (off)))

__device__ __forceinline__ void ndot4(float (&acc)[4], const bf16_t* a0, const bf16_t* a1, const bf16_t* a2, const bf16_t* a3, const float* g, const float* W, int ldw, int K) {
    float c0 = 0.f, c1 = 0.f, c2 = 0.f, c3 = 0.f;
    for (int k = 0; k < K; ++k) {
        const float w = W[(size_t)k * ldw] * (g ? g[k] : 1.f);
        c0 += bf2f(a0[k]) * w; c1 += bf2f(a1[k]) * w; c2 += bf2f(a2[k]) * w; c3 += bf2f(a3[k]) * w;
    }
    acc[0] = c0; acc[1] = c1; acc[2] = c2; acc[3] = c3;
}
__device__ __forceinline__ int zsrc(int n) {
    if (n < 384) return n;
    if (n < 416) return 640 + (n - 384);
    if (n < 512) return -1;
    if (n < 768) return 384 + (n - 512);
    if (n < 1280) return 672 + (n - 768);
    if (n < 1408) return 1184 + (n - 1280);
    if (n < 1536) return 1312 + (n - 1408);
    if (n < 2560) return 1440 + (n - 1536);
    return 2464 + (n - 2560);
}

__device__ __forceinline__ void st_prep(const P& p, int gw, int ngw, int lane) {
    bf16_t* hb = WSP(bf16_t, WS_HB); bf16_t* pb = WSP(bf16_t, WS_PB);
    for (int m = gw; m < M_; m += ngw) {
        const float* xr = p.x + (size_t)m * D_; float v[16]; float s = 0.f;
#pragma unroll
        for (int j = 0; j < 16; ++j) { v[j] = xr[lane + 64 * j]; s += v[j] * v[j]; }
        s = wave_sum(s); const float r = 1.f / sqrtf(s * (1.f / D_) + EPS);
#pragma unroll
        for (int j = 0; j < 16; ++j) hb[(size_t)m * D_ + lane + 64 * j] = f2bf(v[j] * r);
#pragma unroll
        for (int j = 0; j < 4; ++j) pb[(size_t)m * 256 + lane + 64 * j] = f2bf(p.p[(size_t)m * 256 + lane + 64 * j]);
    }
}
__device__ __forceinline__ void nv_g1(const P& p, size_t gt, size_t ngt) {
    const bf16_t* hb = WSP(bf16_t, WS_HB); bf16_t* z = WSP(bf16_t, WS_Z);
    const size_t total = (size_t)(M_ / 4) * NZ;
    for (size_t i = gt; i < total; i += ngt) {
        const int n = (int)(i % NZ); const int m = (int)(i / NZ) * 4; const int src = zsrc(n);
        float acc[4] = {0.f, 0.f, 0.f, 0.f};
        if (src >= 0) { const bf16_t* a = hb + (size_t)m * D_; ndot4(acc, a, a + D_, a + 2 * D_, a + 3 * D_, p.g_mix, p.w_in + src, INW, D_); }
#pragma unroll
        for (int r = 0; r < 4; ++r) { float v = acc[r]; if (n >= ZGA) v = sigmoidf_(v + p.b_gate[n - ZGA]); z[(size_t)(m + r) * NZ + n] = f2bf(v); }
    }
}
__device__ __forceinline__ void nv_g23(const P& p, size_t gt, size_t ngt) {
    const bf16_t* z = WSP(bf16_t, WS_Z); bf16_t* qmr = WSP(bf16_t, WS_QMR); bf16_t* kvr = WSP(bf16_t, WS_KVR);
    const size_t t1 = (size_t)(M_ / 4) * 768, t2 = (size_t)(M_ / 4) * 1024;
    for (size_t i = gt; i < t1 + t2; i += ngt) {
        float acc[4];
        if (i < t1) { const int n = (int)(i % 768), m = (int)(i / 768) * 4; const bf16_t* a = z + (size_t)m * NZ + ZQ;
            ndot4(acc, a, a + NZ, a + 2 * NZ, a + 3 * NZ, p.g_cq, p.w_uq + n, 768, 384);
#pragma unroll
            for (int r = 0; r < 4; ++r) qmr[(size_t)(m + r) * 768 + n] = f2bf(acc[r]);
        } else { const size_t j = i - t1; const int n = (int)(j % 1024), m = (int)(j / 1024) * 4; const bf16_t* a = z + (size_t)m * NZ + ZCKV;
            ndot4(acc, a, a + NZ, a + 2 * NZ, a + 3 * NZ, p.g_ckv, p.w_ukv + n, 1024, 256);
#pragma unroll
            for (int r = 0; r < 4; ++r) kvr[(size_t)(m + r) * 1024 + n] = f2bf(acc[r]);
        }
    }
}

constexpr int VT_PITCH = 66;
__device__ __forceinline__ void st_attn_prep(const P& p, int wg, int nwg, int wave, int lane, bf16_t* lds) {
    const bf16_t* z = WSP(bf16_t, WS_Z); const bf16_t* qmr = WSP(bf16_t, WS_QMR); const bf16_t* kvr = WSP(bf16_t, WS_KVR);
    bf16_t* QM = WSP(bf16_t, WS_QM); bf16_t* KM = WSP(bf16_t, WS_KM); bf16_t* VTM = WSP(bf16_t, WS_VTM);
    bf16_t* QS = WSP(bf16_t, WS_QS); bf16_t* KS = WSP(bf16_t, WS_KS); bf16_t* VTS = WSP(bf16_t, WS_VTS);
    const float sc_m = 0.10206207261596575f * LOG2E;
    const float sc_s = 0.125f * LOG2E;
    for (int tile = wg; tile < M_ / 64; tile += nwg) {
        __syncthreads();
        for (int tt = 0; tt < 8; ++tt) {
            const int tl = wave * 8 + tt, m = tile * 64 + tl, b = m / S_, s = m % S_;
            const bf16_t* zr = z + (size_t)m * NZ;
            const float posf = (float)p.pos[m];
            float sq = 0.f, skv = 0.f;
#pragma unroll
            for (int j = 0; j < 6; ++j) { const float v = bf2f(zr[ZQ + lane + 64 * j]); sq += v * v; }
#pragma unroll
            for (int j = 0; j < 4; ++j) { const float v = bf2f(zr[ZCKV + lane + 64 * j]); skv += v * v; }
            sq = wave_sum(sq); skv = wave_sum(skv);
            const float rq = 1.f / sqrtf(sq * (1.f / 384.f) + EPS), rkv = 1.f / sqrtf(skv * (1.f / 256.f) + EPS);
            const float inv_m = exp2f(-13.287712379549449f * (float)(lane & 15) * (1.f / 16.f));
            const float inv_s = exp2f(-13.287712379549449f * (float)(lane & 31) * (1.f / 32.f));
            float cm, sm, cs, ss; sincosf(posf * inv_m, &sm, &cm); sincosf(posf * inv_s, &ss, &cs);
            const float krope = bf2f(zr[ZKR + (lane & 31)]);
            for (int h = 0; h < 8; ++h) {
                { float v0 = bf2f(qmr[(size_t)m * 768 + h * 96 + lane]) * rq;
                  float v1 = (lane < 32) ? bf2f(qmr[(size_t)m * 768 + h * 96 + 64 + lane]) * rq : 0.f;
                  const float ssum = wave_sum(v0 * v0 + v1 * v1); const float r = 1.f / sqrtf(ssum * (1.f / 96.f) + EPS);
                  v0 *= r * p.g_qn_mla[lane]; v1 *= (lane < 32) ? r * p.g_qn_mla[64 + lane] : 0.f;
                  const float o = __shfl_xor(v1, 16);
                  const float rot = (lane < 16) ? (v1 * cm - o * sm) : (v1 * cm + o * sm);
                  bf16_t* dst = QM + ((size_t)(b * 8 + h) * S_ + s) * 96;
                  dst[lane] = f2bf(v0 * sc_m); if (lane < 32) dst[64 + lane] = f2bf(rot * sc_m); }
                { float v0 = bf2f(kvr[(size_t)m * 1024 + h * 128 + lane]) * rkv;
                  float v1 = (lane < 32) ? krope : 0.f;
                  const float ssum = wave_sum(v0 * v0 + v1 * v1); const float r = 1.f / sqrtf(ssum * (1.f / 96.f) + EPS);
                  v0 *= r * p.g_kn_mla[lane]; v1 *= (lane < 32) ? r * p.g_kn_mla[64 + lane] : 0.f;
                  const float o = __shfl_xor(v1, 16);
                  const float rot = (lane < 16) ? (v1 * cm - o * sm) : (v1 * cm + o * sm);
                  bf16_t* dst = KM + ((size_t)(b * 8 + h) * S_ + s) * 96;
                  dst[lane] = f2bf(v0); if (lane < 32) dst[64 + lane] = f2bf(rot);
                  const float vv = bf2f(kvr[(size_t)m * 1024 + h * 128 + 64 + lane]) * rkv;
                  lds[(h * 64 + lane) * VT_PITCH + tl] = f2bf(vv); }
                { float v = bf2f(zr[ZQS + h * 64 + lane]);
                  const float ssum = wave_sum(v * v); const float r = 1.f / sqrtf(ssum * (1.f / 64.f) + EPS);
                  v *= r * p.g_qn_swa[lane];
                  const float o = __shfl_xor(v, 32);
                  const float rot = (lane < 32) ? (v * cs - o * ss) : (v * cs + o * ss);
                  QS[((size_t)(b * 8 + h) * S_ + s) * 64 + lane] = f2bf(rot * sc_s); }
                if (h < 2) {
                  float v = bf2f(zr[ZKS + h * 64 + lane]);
                  const float ssum = wave_sum(v * v); const float r = 1.f / sqrtf(ssum * (1.f / 64.f) + EPS);
                  v *= r * p.g_kn_swa[lane];
                  const float o = __shfl_xor(v, 32);
                  const float rot = (lane < 32) ? (v * cs - o * ss) : (v * cs + o * ss);
                  KS[((size_t)(b * 2 + h) * S_ + s) * 64 + lane] = f2bf(rot);
                  lds[(512 + h * 64 + lane) * VT_PITCH + tl] = zr[ZVS + h * 64 + lane]; }
            }
        }
        __syncthreads();
        const int b = (tile * 64) / S_, s0 = (tile * 64) % S_;
        for (int r = wave; r < 640; r += 8) {
            const bf16_t v = lds[r * VT_PITCH + lane];
            if (r < 512) VTM[((size_t)(b * 8 + (r >> 6)) * 64 + (r & 63)) * S_ + s0 + lane] = v;
            else { const int rr = r - 512; VTS[((size_t)(b * 2 + (rr >> 6)) * 64 + (rr & 63)) * S_ + s0 + lane] = v; }
        }
    }
}

template <int DK, bool SWA>
__device__ __forceinline__ void nv_attn(const P& p, size_t gt, size_t ngt) {
    const bf16_t* Q = SWA ? WSP(bf16_t, WS_QS) : WSP(bf16_t, WS_QM);
    const bf16_t* K = SWA ? WSP(bf16_t, WS_KS) : WSP(bf16_t, WS_KM);
    const bf16_t* VT = SWA ? WSP(bf16_t, WS_VTS) : WSP(bf16_t, WS_VTM);
    bf16_t* O = SWA ? WSP(bf16_t, WS_OW) : WSP(bf16_t, WS_OM);
    const size_t total = (size_t)B_ * 8 * S_;
    for (size_t i = gt; i < total; i += ngt) {
        const int q = (int)(i % S_), h = (int)((i / S_) % 8), b = (int)(i / ((size_t)S_ * 8));
        const int kvh = SWA ? (b * 2 + h / 4) : (b * 8 + h);
        const bf16_t* qp = Q + ((size_t)(b * 8 + h) * S_ + q) * DK;
        const bf16_t* kb = K + (size_t)kvh * S_ * DK; const bf16_t* vb = VT + (size_t)kvh * 64 * S_;
        float m, l; float o[64]; unsigned qf[DK / 2];
#pragma unroll
        for (int d = 0; d < 64; ++d) o[d] = 0.f;
#pragma unroll
        for (int d = 0; d < DK / 2; ++d) qf[d] = ((const unsigned*)qp)[d];
        if (SWA) { m = p.sink[h] * LOG2E; l = 1.f; } else { m = -1e30f; l = 0.f; }
        const int k0 = SWA ? max(0, q - 128) : 0, k1 = SWA ? min(S_ - 1, q + 128) : S_ - 1;
        for (int k = k0; k <= k1; ++k) {
            float s = 0.f; const bf16_t* kp = kb + (size_t)k * DK;
#pragma unroll
            for (int d = 0; d < DK / 2; ++d) { const unsigned kk = ((const unsigned*)kp)[d];
                s += __uint_as_float(qf[d] << 16) * __uint_as_float(kk << 16) + __uint_as_float(qf[d] & 0xffff0000u) * __uint_as_float(kk & 0xffff0000u); }
            const float mn = fmaxf(m, s), al = exp2f(m - mn), pr = exp2f(s - mn);
            l = l * al + pr; m = mn;
#pragma unroll
            for (int d = 0; d < 64; ++d) o[d] = o[d] * al + pr * bf2f(vb[(size_t)d * S_ + k]);
        }
        const float il = 1.f / l;
        bf16_t* op = O + ((size_t)(b * S_ + q)) * 512 + h * 64;
#pragma unroll
        for (int d = 0; d < 64; ++d) op[d] = f2bf(o[d] * il);
    }
}
__device__ __forceinline__ void nv_merge(const P& p, size_t gt, size_t ngt) {
    const bf16_t* z = WSP(bf16_t, WS_Z); const bf16_t* om = WSP(bf16_t, WS_OM); const bf16_t* ow = WSP(bf16_t, WS_OW); bf16_t* mg = WSP(bf16_t, WS_MG);
    const size_t total = (size_t)(M_ / 4) * D_;
    for (size_t i = gt; i < total; i += ngt) {
        const int n = (int)(i % D_), m = (int)(i / D_) * 4; float a[4], c[4];
        const bf16_t* r0 = om + (size_t)m * 512; ndot4(a, r0, r0 + 512, r0 + 1024, r0 + 1536, nullptr, p.w_br_mla + n, D_, 512);
        const bf16_t* r1 = ow + (size_t)m * 512; ndot4(c, r1, r1 + 512, r1 + 1024, r1 + 1536, nullptr, p.w_br_swa + n, D_, 512);
#pragma unroll
        for (int r = 0; r < 4; ++r) { const bf16_t* zr = z + (size_t)(m + r) * NZ; mg[(size_t)(m + r) * D_ + n] = f2bf(bf2f(zr[ZGA + n]) * a[r] + bf2f(zr[ZGB + n]) * c[r]); }
    }
}
__device__ __forceinline__ void nv_out(const P& p, size_t gt, size_t ngt) {
    const bf16_t* mg = WSP(bf16_t, WS_MG);
    const size_t total = (size_t)(M_ / 4) * D_;
    for (size_t i = gt; i < total; i += ngt) {
        const int n = (int)(i % D_), m = (int)(i / D_) * 4; float a[4];
        const bf16_t* r0 = mg + (size_t)m * D_; ndot4(a, r0, r0 + D_, r0 + 2 * D_, r0 + 3 * D_, nullptr, p.w_out + n, D_, D_);
#pragma unroll
        for (int r = 0; r < 4; ++r) p.out[(size_t)(m + r) * D_ + n] = p.x[(size_t)(m + r) * D_ + n] + a[r];
    }
}
__device__ __forceinline__ void st_route(const P& p, int gw, int ngw, int lane, float* xs) {
    bf16_t* h2 = WSP(bf16_t, WS_H2); int* tope = WSP(int, WS_TOPE); float* topw = WSP(float, WS_TOPW); int* topls = WSP(int, WS_TOPLS);
    unsigned* cnt = WSP(unsigned, WS_CTL) + CW_CNT;
    for (int m = gw; m < M_; m += ngw) {
        const float* xr = p.out + (size_t)m * D_; float v[16]; float s = 0.f;
#pragma unroll
        for (int j = 0; j < 16; ++j) { v[j] = xr[lane + 64 * j]; s += v[j] * v[j]; }
        s = wave_sum(s); const float r = 1.f / sqrtf(s * (1.f / D_) + EPS);
#pragma unroll
        for (int j = 0; j < 16; ++j) { const float xn = v[j] * r; h2[(size_t)m * D_ + lane + 64 * j] = f2bf(xn); xs[lane + 64 * j] = xn * p.g_moe[lane + 64 * j]; }
        __builtin_amdgcn_s_waitcnt(0xc07f);
        float logit = 0.f;
        for (int k = 0; k < D_; ++k) logit += xs[k] * p.w_router[(size_t)k * NE + lane];
        const float score = sigmoidf_(logit); const float sel = score + p.router_bias[lane];
        float m1 = sel;
        m1 = fmaxf(m1, __shfl_xor(m1, 1)); m1 = fmaxf(m1, __shfl_xor(m1, 2)); m1 = fmaxf(m1, __shfl_xor(m1, 4));
        const unsigned long long eqm = __ballot(sel == m1);
        const int g = lane >> 3; const unsigned gm = (unsigned)((eqm >> (g * 8)) & 0xffull);
        const int first = __ffs((int)gm) - 1;
        float v2 = ((lane & 7) == first) ? -3.0e38f : sel;
        v2 = fmaxf(v2, __shfl_xor(v2, 1)); v2 = fmaxf(v2, __shfl_xor(v2, 2)); v2 = fmaxf(v2, __shfl_xor(v2, 4));
        const float gs = m1 + v2;
        int grank = 0;
#pragma unroll
        for (int j = 0; j < 8; ++j) { const float o = __shfl(gs, j * 8); grank += (o > gs || (o == gs && j < g)) ? 1 : 0; }
        const float msel = (grank < 4) ? sel : -1e30f;
        int rank = 0;
        for (int j = 0; j < 64; ++j) { const float o = __shfl(msel, j); rank += (o > msel || (o == msel && j < lane)) ? 1 : 0; }
        const bool chosen = rank < TOPK;
        const float wsum = wave_sum(chosen ? score : 0.f);
        if (chosen) {
            const unsigned ls = atomicAdd(&cnt[lane], 1u);
            tope[m * TOPK + rank] = lane; topw[m * TOPK + rank] = score / wsum * 2.5f; topls[m * TOPK + rank] = (int)ls;
        }
    }
}
__device__ __forceinline__ void st_lists(const P& p, size_t gt, size_t ngt) {
    const unsigned* cnt = WSP(unsigned, WS_CTL) + CW_CNT; unsigned* basew = WSP(unsigned, WS_CTL) + CW_BASE;
    const int* tope = WSP(int, WS_TOPE); const float* topw = WSP(float, WS_TOPW); const int* topls = WSP(int, WS_TOPLS);
    int* pos = WSP(int, WS_POS); int* ltok = WSP(int, WS_LTOK); float* lw = WSP(float, WS_LW);
    for (size_t i = gt; i < (size_t)M_ * TOPK; i += ngt) {
        const int e = tope[i]; unsigned base = 0;
        for (int j = 0; j < e; ++j) base += (cnt[j] + 255u) & ~255u;
        const int slot = (int)base + topls[i];
        pos[i] = slot; ltok[slot] = (int)(i / TOPK); lw[slot] = topw[i];
    }
    for (size_t i = gt; i < (size_t)NE * 256; i += ngt) {
        const int e = (int)(i / 256), j = (int)(i % 256); unsigned base = 0;
        for (int q = 0; q < e; ++q) base += (cnt[q] + 255u) & ~255u;
        const unsigned n = cnt[e], np = (n + 255u) & ~255u;
        if (n + j < np) { ltok[base + n + j] = 0; lw[base + n + j] = 0.f; }
    }
    if (gt == 0) { unsigned base = 0; for (int e = 0; e < NE; ++e) { basew[e] = base; base += (cnt[e] + 255u) & ~255u; } basew[NE] = base; }
    { int* tile_e = (int*)(p.ws + 5 * MiB);
      for (size_t i = gt; i < (size_t)(NSLOT / 256); i += ngt) { unsigned base = 0; int e = -1;
          for (int q = 0; q < NE; ++q) { const unsigned nb = base + ((cnt[q] + 255u) & ~255u); if ((unsigned)i * 256u >= base && (unsigned)i * 256u < nb) e = q; base = nb; }
          tile_e[i] = e; }
      for (size_t i = gt; i < (size_t)M_; i += ngt) { ltok[NSLOT + i] = (int)i; lw[NSLOT + i] = 1.f; } }
}
__device__ __forceinline__ int slot_expert(const unsigned* basew, int slot) { int e = 0; while (e < NE - 1 && (unsigned)slot >= basew[e + 1]) ++e; return e; }
__device__ __forceinline__ void nv_gu(const P& p, size_t gt, size_t ngt) {
    const unsigned* basew = WSP(unsigned, WS_CTL) + CW_BASE; const int* ltok = WSP(int, WS_LTOK); const float* lw = WSP(float, WS_LW);
    const bf16_t* h2 = WSP(bf16_t, WS_H2); bf16_t* hid = WSP(bf16_t, WS_HID); bf16_t* hsh = WSP(bf16_t, WS_HSH);
    const int nslot = (int)basew[NE];
    const size_t t1 = (size_t)(nslot / 4) * EFF, t2 = (size_t)(M_ / 4) * 256;
    for (size_t i = gt; i < t1 + t2; i += ngt) {
        float g[4], u[4];
        if (i < t1) { const int j = (int)(i % EFF), sl = (int)(i / EFF) * 4; const int e = slot_expert(basew, sl);
            const bf16_t* a0 = h2 + (size_t)ltok[sl] * D_; const bf16_t* a1 = h2 + (size_t)ltok[sl + 1] * D_; const bf16_t* a2 = h2 + (size_t)ltok[sl + 2] * D_; const bf16_t* a3 = h2 + (size_t)ltok[sl + 3] * D_;
            const float* W = p.w_exp_gu + (size_t)e * D_ * 512;
            ndot4(g, a0, a1, a2, a3, p.g_moe, W + j, 512, D_); ndot4(u, a0, a1, a2, a3, p.g_moe, W + 256 + j, 512, D_);
#pragma unroll
            for (int r = 0; r < 4; ++r) hid[(size_t)(sl + r) * EFF + j] = f2bf(g[r] * sigmoidf_(g[r]) * u[r] * lw[sl + r]);
        } else { const size_t q = i - t1; const int j = (int)(q % 256), m = (int)(q / 256) * 4; const bf16_t* a = h2 + (size_t)m * D_;
            ndot4(g, a, a + D_, a + 2 * D_, a + 3 * D_, p.g_moe, p.w_sh_gu + j, 512, D_); ndot4(u, a, a + D_, a + 2 * D_, a + 3 * D_, p.g_moe, p.w_sh_gu + 256 + j, 512, D_);
#pragma unroll
            for (int r = 0; r < 4; ++r) hsh[(size_t)(m + r) * 256 + j] = f2bf(g[r] * sigmoidf_(g[r]) * u[r]);
        }
    }
}
__device__ __forceinline__ void nv_down(const P& p, size_t gt, size_t ngt) {
    const unsigned* basew = WSP(unsigned, WS_CTL) + CW_BASE;
    const bf16_t* hid = WSP(bf16_t, WS_HID); const bf16_t* hsh = WSP(bf16_t, WS_HSH); bf16_t* Y = WSP(bf16_t, WS_Y);
    const int nslot = (int)basew[NE];
    const size_t t1 = (size_t)(nslot / 4) * D_, t2 = (size_t)(M_ / 4) * D_;
    for (size_t i = gt; i < t1 + t2; i += ngt) {
        float a[4];
        if (i < t1) { const int n = (int)(i % D_), sl = (int)(i / D_) * 4; const int e = slot_expert(basew, sl); const bf16_t* r0 = hid + (size_t)sl * EFF;
            ndot4(a, r0, r0 + EFF, r0 + 2 * EFF, r0 + 3 * EFF, nullptr, p.w_exp_down + (size_t)e * EFF * D_ + n, D_, EFF);
#pragma unroll
            for (int r = 0; r < 4; ++r) Y[(size_t)(sl + r) * D_ + n] = f2bf(a[r]);
        } else { const size_t q = i - t1; const int n = (int)(q % D_), m = (int)(q / D_) * 4; const bf16_t* r0 = hsh + (size_t)m * 256;
            ndot4(a, r0, r0 + 256, r0 + 512, r0 + 768, nullptr, p.w_sh_down + n, D_, 256);
#pragma unroll
            for (int r = 0; r < 4; ++r) p.out[(size_t)(m + r) * D_ + n] += a[r];
        }
    }
}
__device__ __forceinline__ void st_combine(const P& p, int gw, int ngw, int lane) {
    const int* pos = WSP(int, WS_POS); const bf16_t* Y = WSP(bf16_t, WS_Y); bf16_t* h3 = WSP(bf16_t, WS_H3);
    for (int m = gw; m < M_; m += ngw) {
        float* xr = p.out + (size_t)m * D_; float v[16]; float s = 0.f;
#pragma unroll
        for (int j = 0; j < 16; ++j) v[j] = xr[lane + 64 * j];
        for (int k = 0; k < TOPK; ++k) { const bf16_t* yr = Y + (size_t)pos[m * TOPK + k] * D_;
#pragma unroll
            for (int j = 0; j < 16; ++j) v[j] += bf2f(yr[lane + 64 * j]); }
#pragma unroll
        for (int j = 0; j < 16; ++j) { s += v[j] * v[j]; xr[lane + 64 * j] = v[j]; }
        s = wave_sum(s); const float r = 1.f / sqrtf(s * (1.f / D_) + EPS);
#pragma unroll
        for (int j = 0; j < 16; ++j) h3[(size_t)m * D_ + lane + 64 * j] = f2bf(v[j] * r);
    }
}
__device__ __forceinline__ void nv_ple(const P& p, size_t gt, size_t ngt) {
    const bf16_t* h3 = WSP(bf16_t, WS_H3); const bf16_t* pb = WSP(bf16_t, WS_PB);
    const size_t total = (size_t)(M_ / 4) * D_;
    for (size_t i = gt; i < total; i += ngt) {
        const int n = (int)(i % D_), m = (int)(i / D_) * 4; float a[4], c[4];
        const bf16_t* r0 = h3 + (size_t)m * D_; ndot4(a, r0, r0 + D_, r0 + 2 * D_, r0 + 3 * D_, p.g_ple, p.w_ple_gate + n, D_, D_);
        const bf16_t* r1 = pb + (size_t)m * 256; ndot4(c, r1, r1 + 256, r1 + 512, r1 + 768, nullptr, p.w_ple_proj + n, D_, 256);
#pragma unroll
        for (int r = 0; r < 4; ++r) p.out[(size_t)(m + r) * D_ + n] += sigmoidf_(a[r] + p.b_ple[n]) * c[r];
    }
}


#define LAS __attribute__((address_space(3)))
#define XB_TMO      128
#define XB_XCNT(j)  (256  + 64 * (j))
#define XB_XSUB(j)  (1280 + 64 * (j))
#define XB_XGEN(j)  (2304 + 64 * (j))
#define XB_TOP      3328
#define XB_TOPGEN   3392
#define XCD_BAR_WORDS 3456
#define XB_SPIN_CAP (1u << 18)
__device__ __forceinline__ unsigned xb_ld(unsigned* p)              { return __hip_atomic_load(p, __ATOMIC_RELAXED, __HIP_MEMORY_SCOPE_AGENT); }
__device__ __forceinline__ unsigned xb_add(unsigned* p, unsigned v) { return __hip_atomic_fetch_add(p, v, __ATOMIC_RELAXED, __HIP_MEMORY_SCOPE_AGENT); }
__device__ __forceinline__ unsigned xb_xcc_id() { return (unsigned)__builtin_amdgcn_s_getreg((3 << 11) | 20) & 0xFu; }
#define XB_SPIN(cond, bar) do { unsigned _sp = 0; while (cond) { __builtin_amdgcn_s_sleep(1); \
    if ((++_sp & 255u) == 0u) { if (xb_ld(&(bar)[XB_TMO])) break; if (_sp > XB_SPIN_CAP) { atomicAdd(&(bar)[XB_TMO], 1u); break; } } } } while (0)
struct XcdBarrier { unsigned* bar; unsigned x; volatile LAS unsigned* st; };
__device__ __forceinline__ XcdBarrier xcd_barrier_post(unsigned* bar, volatile LAS unsigned* st) {
    XcdBarrier b; b.bar = bar; b.x = xb_xcc_id(); b.st = st;
    if (threadIdx.x == 0) (void)xb_add(&bar[XB_XCNT(b.x)], 1u);
    return b;
}
__device__ __forceinline__ void xcd_barrier_complete(unsigned* bar, unsigned x, unsigned& nloc, unsigned& nx) {
    const unsigned G = gridDim.x * gridDim.y * gridDim.z;
    unsigned sum, cnt, mine, sp = 0u;
    for (;;) {
        sum = 0u; cnt = 0u; mine = 0u;
#pragma unroll
        for (unsigned j = 0; j < 16; ++j) { const unsigned c = xb_ld(&bar[XB_XCNT(j)]); sum += c; cnt += (c > 0u) ? 1u : 0u; mine = (j == x) ? c : mine; }
        if (sum == G) break;
        __builtin_amdgcn_s_sleep(1);
        if ((++sp & 255u) == 0u) { if (xb_ld(&bar[XB_TMO])) break; if (sp > XB_SPIN_CAP) { atomicAdd(&bar[XB_TMO], 1u); break; } }
    }
    nloc = mine > 0u ? mine : 1u; nx = cnt > 0u ? cnt : 1u;
}
__device__ __forceinline__ void xcd_barrier(const XcdBarrier& b) {
    asm volatile("s_waitcnt vmcnt(0)" ::: "memory");
    __syncthreads();
    if (threadIdx.x == 0) {
        unsigned* bar = b.bar;
        __builtin_amdgcn_s_waitcnt(0);
        unsigned nloc = b.st[0], nx = b.st[1];
        if (nloc == 0u) { xcd_barrier_complete(bar, b.x, nloc, nx); b.st[0] = nloc; b.st[1] = nx; }
        const unsigned old = xb_add(&bar[XB_XSUB(b.x)], 1u);
        const unsigned gen = old / nloc;
        if (old + 1u == (gen + 1u) * nloc) {
            __builtin_amdgcn_fence(__ATOMIC_RELEASE, "agent");
            asm volatile("s_waitcnt vmcnt(0)" ::: "memory");
            const unsigned og = xb_add(&bar[XB_TOP], 1u);
            const unsigned tg = og / nx;
            if (og + 1u == (tg + 1u) * nx) xb_add(&bar[XB_TOPGEN], 1u);
            else XB_SPIN(xb_ld(&bar[XB_TOPGEN]) == tg, bar);
            __builtin_amdgcn_fence(__ATOMIC_ACQUIRE, "agent");
            xb_add(&bar[XB_XGEN(b.x)], 1u);
            asm volatile("s_waitcnt vmcnt(0)" ::: "memory");
        } else {
            XB_SPIN(xb_ld(&bar[XB_XGEN(b.x)]) == gen, bar);
            __builtin_amdgcn_fence(__ATOMIC_ACQUIRE, "agent");
            asm volatile("s_waitcnt vmcnt(0)" ::: "memory");
        }
    }
    __syncthreads();
}
constexpr int CW_BAR = 4096;

namespace pg8 {
typedef short bf16x8 __attribute__((ext_vector_type(8)));
typedef float f32x4 __attribute__((ext_vector_type(4)));
typedef unsigned u32x4 __attribute__((ext_vector_type(4)));
typedef unsigned u32x2 __attribute__((ext_vector_type(2)));
constexpr int BM = 256, BK = 64, HALF = 128, HTB = HALF * BK * 2, STAGE_BYTES = 8 * HTB, NXCD = 8, WGM = 8;
__host__ __device__ __forceinline__ int lds_byte(int r, int c) { const int st = (r >> 4) * 2 + (c >> 5), rr = r & 15, cc = c & 31, ob = rr * 64 + cc * 2; return st * 1024 + (ob ^ (((ob >> 9) & 1) << 5)); }
__host__ __device__ __forceinline__ void stage_rc(int b, int& R, int& C) { const int st = b / 1024, sb = b % 1024, swz = sb ^ (((sb >> 9) & 1) << 5); R = (st >> 1) * 16 + swz / 64; C = (st & 1) * 32 + (swz % 64) / 2; }
__host__ __device__ __forceinline__ int perm32(int rho) { const int n = rho >> 4, i = rho & 15; return 8 * (i >> 2) + 4 * n + (i & 3); }
__device__ __forceinline__ unsigned cvt_pk_bf16(float lo, float hi) { unsigned r; asm volatile("v_cvt_pk_bf16_f32 %0, %1, %2" : "=v"(r) : "v"(lo), "v"(hi)); return r; }

struct Unit { int pm, pn; const char* Ab; const char* Bb; int aux; };

struct DenseSched {
    const char* A; const char* Bt; size_t astep, bstep;
    int nM, nN, nwg, G, c;
    __device__ __forceinline__ void init(const void* A_, int lda, const void* Bt_, int ldb, int M, int N, int G_, int c_) {
        A = (const char*)A_; Bt = (const char*)Bt_; astep = (size_t)BM * lda * 2; bstep = (size_t)BM * ldb * 2; nM = M / BM; nN = N / BM; nwg = nM * nN; G = G_; c = c_; }
    __device__ __forceinline__ bool next(int i, Unit& u) const {
        const long L = (long)i * G + c; if (L >= nwg) return false;
        int wgid = (int)L; { const int q = nwg / NXCD, r = nwg % NXCD, xcd = wgid % NXCD, off = wgid / NXCD; wgid = (xcd < r ? xcd * (q + 1) : r * (q + 1) + (xcd - r) * q) + off; }
        const int nig = WGM * nN, gid = wgid / nig, fm = gid * WGM, gsz = (nM - fm) < WGM ? (nM - fm) : WGM;
        u.pm = fm + ((wgid % nig) % gsz); u.pn = (wgid % nig) / gsz; u.Ab = A + (size_t)u.pm * astep; u.Bb = Bt + (size_t)u.pn * bstep; u.aux = 0; return true;
    }
    __device__ __forceinline__ int row(const Unit&, int) const { return 0; }
};

template <class Epi, class Sched, bool GATHER>
__device__ __forceinline__ void gemm_phase(LAS unsigned char* lds, const int K, const int lda, const int ldb, const Sched& S, const Epi& E) {
    int tid = threadIdx.x; asm volatile("" : "+v"(tid));
    const int wid = __builtin_amdgcn_readfirstlane(tid >> 6), lane = tid & 63, wr = wid >> 2, wc = wid & 3, fr = lane & 15, fq = lane >> 4;
    const int nt = K / BK;
    unsigned voffB[2];
#pragma unroll
    for (int i = 0; i < 2; ++i) { int R, C; stage_rc(tid * 16 + i * 8192, R, C); const int Rb = Epi::PERM ? ((R & ~31) + perm32(R & 31)) : R;
        voffB[i] = (unsigned)(Rb * ldb + C) * 2u; }
    const size_t kstep = (size_t)(BK * 2);
    const size_t hstepB = (size_t)HALF * ldb * 2;
    const size_t hstepA = GATHER ? 0 : (size_t)HALF * lda * 2;
    const unsigned ldsw = (unsigned)wid * 1024u;
    const int aoff = lds_byte(wr * 64 + fr, fq * 8), boff = lds_byte(wc * 32 + fr, fq * 8);
#define PG8_SA(b, h) (((b) * 2 + (h)) * HTB)
#define PG8_SB(b, h) ((4 + (b) * 2 + (h)) * HTB)
#define PG8_STAGE(bufoff, gbase, v0, v1) do { \
        __builtin_amdgcn_global_load_lds((const unsigned*)((const char*)(gbase) + (v0)), (LAS unsigned*)(lds + (bufoff) + ldsw), 16, 0, 0); \
        __builtin_amdgcn_global_load_lds((const unsigned*)((const char*)(gbase) + (v1)), (LAS unsigned*)(lds + (bufoff) + ldsw + 8192), 16, 0, 0); } while (0)
#define PG8_STAGEB(bufoff, gbase) PG8_STAGE(bufoff, gbase, voffB[0], voffB[1])
#define PG8_LDA(dst, b, h) do { _Pragma("unroll") for (int m = 0; m < 4; ++m) _Pragma("unroll") for (int k = 0; k < 2; ++k) dst[m][k] = *(const LAS bf16x8*)(lds + PG8_SA(b, h) + aoff + m * 2048 + k * 1024); } while (0)
#define PG8_LDB(dst, b, h) do { _Pragma("unroll") for (int n = 0; n < 2; ++n) _Pragma("unroll") for (int k = 0; k < 2; ++k) dst[n][k] = *(const LAS bf16x8*)(lds + PG8_SB(b, h) + boff + n * 2048 + k * 1024); } while (0)
#define PG8_MMA(ai, bj, At, Bt) do { __builtin_amdgcn_s_setprio(1); _Pragma("unroll") for (int m = 0; m < 4; ++m) _Pragma("unroll") for (int n = 0; n < 2; ++n) _Pragma("unroll") for (int k = 0; k < 2; ++k) \
        acc[ai][bj][m][n] = __builtin_amdgcn_mfma_f32_16x16x32_bf16(Bt[n][k], At[m][k], acc[ai][bj][m][n], 0, 0, 0); __builtin_amdgcn_s_setprio(0); } while (0)
#define PG8_WAIT_V(n) asm volatile("s_waitcnt vmcnt(" #n ")" ::: "memory")
#define PG8_WAIT_L(n) asm volatile("s_waitcnt lgkmcnt(" #n ")" ::: "memory")
#define PG8_BAR __builtin_amdgcn_s_barrier()
#define PG8_SCHED __builtin_amdgcn_sched_barrier(0)
#define PG8_AOFFS(U, o00, o01, o10, o11) do { int t_ = tid; asm volatile("" : "+v"(t_)); int R0_, C0_, R1_, C1_; stage_rc(t_ * 16, R0_, C0_); stage_rc(t_ * 16 + 8192, R1_, C1_); \
        if constexpr (GATHER) { o00 = (unsigned)(S.row(U, R0_) * lda + C0_) * 2u; o01 = (unsigned)(S.row(U, R1_) * lda + C1_) * 2u; \
                                o10 = (unsigned)(S.row(U, HALF + R0_) * lda + C0_) * 2u; o11 = (unsigned)(S.row(U, HALF + R1_) * lda + C1_) * 2u; } \
        else { o00 = (unsigned)(R0_ * lda + C0_) * 2u; o01 = (unsigned)(R1_ * lda + C1_) * 2u; o10 = o00; o11 = o01; } } while (0)
    Unit cur, nxt; int ui = 0;
    if (!S.next(0, cur)) return;
    unsigned vc00, vc01, vc10, vc11, vn00 = 0, vn01 = 0, vn10 = 0, vn11 = 0;
    PG8_AOFFS(cur, vc00, vc01, vc10, vc11);
    if constexpr (GATHER) { vn00 = vc00; vn01 = vc01; vn10 = vc10; vn11 = vc11; }
    f32x4 acc[2][2][4][2];
#pragma unroll
    for (int a = 0; a < 2; ++a)
#pragma unroll
        for (int b = 0; b < 2; ++b)
#pragma unroll
            for (int m = 0; m < 4; ++m)
#pragma unroll
                for (int n = 0; n < 2; ++n) acc[a][b][m][n] = (f32x4){0.f, 0.f, 0.f, 0.f};
    bf16x8 At[4][2], B0[2][2], B1[2][2];
    const char* cA = cur.Ab; const char* cB = cur.Bb;
    PG8_STAGEB(PG8_SB(0, 0), cB); PG8_STAGEB(PG8_SB(0, 1), cB + hstepB); PG8_STAGE(PG8_SA(0, 0), cA, vc00, vc01); PG8_STAGE(PG8_SA(0, 1), cA + hstepA, vc10, vc11);
    if (wr == 1) PG8_BAR;
    PG8_WAIT_V(2); PG8_BAR;
    PG8_STAGEB(PG8_SB(1, 0), cB + kstep); PG8_STAGE(PG8_SA(1, 0), cA + kstep, vc00, vc01); PG8_STAGEB(PG8_SB(1, 1), cB + hstepB + kstep);
    PG8_WAIT_V(6); PG8_BAR;
    for (;;) {
        const bool has_next = S.next(ui + 1, nxt);
        const char* nA = has_next ? nxt.Ab : cA; const char* nB = has_next ? nxt.Bb : cB;
        if constexpr (GATHER) {
            if (has_next) { PG8_AOFFS(nxt, vn00, vn01, vn10, vn11);
                asm volatile("" : "+v"(vn00), "+v"(vn01), "+v"(vn10), "+v"(vn11));
            } else { vn00 = vc00; vn01 = vc01; vn10 = vc10; vn11 = vc11; }
        }
        for (int t = 0; t < nt; t += 2) {
            const bool last = (t == nt - 2);
            const char* a1 = cA + (size_t)(t + 1) * kstep;
            const char* a2 = last ? nA : cA + (size_t)(t + 2) * kstep; const char* b2 = last ? nB : cB + (size_t)(t + 2) * kstep;
            const char* a3 = a2 + kstep; const char* b3 = b2 + kstep;
            unsigned w00 = vc00, w01 = vc01, w10 = vc10, w11 = vc11;
            if constexpr (GATHER) { if (last) { w00 = vn00; w01 = vn01; w10 = vn10; w11 = vn11; } }
            PG8_LDB(B0, 0, 0); PG8_LDB(B1, 0, 1); PG8_SCHED; PG8_LDA(At, 0, 0); PG8_STAGE(PG8_SA(1, 1), a1 + hstepA, vc10, vc11);
            PG8_WAIT_V(8); PG8_WAIT_L(0); PG8_BAR; PG8_MMA(0, 0, At, B0); PG8_MMA(0, 1, At, B1); PG8_BAR; PG8_SCHED;
            PG8_LDA(At, 0, 1); PG8_STAGEB(PG8_SB(0, 0), b2); PG8_STAGEB(PG8_SB(0, 1), b2 + hstepB); PG8_STAGE(PG8_SA(0, 0), a2, w00, w01);
            PG8_WAIT_V(8); PG8_WAIT_L(0); PG8_BAR; PG8_MMA(1, 0, At, B0); PG8_MMA(1, 1, At, B1); PG8_BAR; PG8_SCHED;
            PG8_LDB(B0, 1, 0); PG8_LDB(B1, 1, 1); PG8_SCHED; PG8_LDA(At, 1, 0); PG8_STAGE(PG8_SA(0, 1), a2 + hstepA, w10, w11);
            PG8_WAIT_V(8); PG8_WAIT_L(0); PG8_BAR; PG8_MMA(0, 0, At, B0); PG8_MMA(0, 1, At, B1); PG8_BAR; PG8_SCHED;
            PG8_LDA(At, 1, 1); PG8_STAGEB(PG8_SB(1, 0), b3); PG8_STAGEB(PG8_SB(1, 1), b3 + hstepB); PG8_STAGE(PG8_SA(1, 0), a3, w00, w01);
            PG8_WAIT_V(8); PG8_WAIT_L(0); PG8_BAR; PG8_MMA(1, 0, At, B0); PG8_MMA(1, 1, At, B1); PG8_BAR; PG8_SCHED;
        }
        if (wr == 0) PG8_BAR;
        { int te = tid; asm volatile("" : "+v"(te)); const int le = te & 63; E(acc, cur, wr, wc, le & 15, le >> 4); }
        if (!has_next) break;
#pragma unroll
        for (int a = 0; a < 2; ++a)
#pragma unroll
            for (int b = 0; b < 2; ++b)
#pragma unroll
                for (int m = 0; m < 4; ++m)
#pragma unroll
                    for (int n = 0; n < 2; ++n) acc[a][b][m][n] = (f32x4){0.f, 0.f, 0.f, 0.f};
        cur = nxt; cA = nA; cB = nB; ++ui;
        if constexpr (GATHER) { vc00 = vn00; vc01 = vn01; vc10 = vn10; vc11 = vn11; }
        if (wr == 1) PG8_BAR;
    }
    PG8_WAIT_V(0);
    PG8_BAR;
#undef PG8_SA
#undef PG8_SB
#undef PG8_STAGE
#undef PG8_STAGEB
#undef PG8_LDA
#undef PG8_LDB
#undef PG8_MMA
#undef PG8_WAIT_V
#undef PG8_WAIT_L
#undef PG8_BAR
#undef PG8_SCHED
#undef PG8_AOFFS
}

enum { EP_Z = 0, EP_BF16 = 1, EP_MG1 = 2, EP_MG2 = 3, EP_RES = 4, EP_HID = 5, EP_DOWN = 6, EP_PLE = 7 };
__device__ __forceinline__ float bfl(unsigned w) { return __uint_as_float(w << 16); }
__device__ __forceinline__ float bfh(unsigned w) { return __uint_as_float(w & 0xffff0000u); }
__device__ __forceinline__ float sigm(float v) { return __builtin_amdgcn_rcpf(1.f + __expf(-v)); }
template <int MODE> struct Epi {
    static constexpr bool PERM = !(MODE == EP_RES || MODE == EP_PLE);
    bf16_t* O; int ldc;
    const bf16_t* aux; int ldaux;
    const float* fin; float* fout;
    __device__ __forceinline__ void operator()(const f32x4 (&acc)[2][2][4][2], const Unit& u, int wr, int wc, int fr, int fq) const {
        const int row0 = u.pm * BM + wr * 64 + fr;
        if constexpr (MODE == EP_RES || MODE == EP_PLE) {
            const int col0 = u.pn * BM + wc * 32 + 4 * fq;
#pragma unroll
            for (int ai = 0; ai < 2; ++ai)
#pragma unroll
                for (int m = 0; m < 4; ++m) { const size_t r = (size_t)(row0 + ai * HALF + m * 16);
#pragma unroll
                    for (int bj = 0; bj < 2; ++bj)
#pragma unroll
                        for (int n = 0; n < 2; ++n) { const int c = col0 + bj * HALF + n * 16; const f32x4 a = acc[ai][bj][m][n];
                            if constexpr (MODE == EP_RES) { const f32x4 xv = *(const f32x4*)(fin + r * D_ + c); *(f32x4*)(fout + r * D_ + c) = xv + a; }
                            else { const f32x4 bv = *(const f32x4*)(fin + c); const u32x2 pw = *(const u32x2*)(aux + r * ldaux + c); f32x4 o = *(const f32x4*)(fout + r * D_ + c);
                                o[0] += sigm(a[0] + bv[0]) * bfl(pw.x); o[1] += sigm(a[1] + bv[1]) * bfh(pw.x); o[2] += sigm(a[2] + bv[2]) * bfl(pw.y); o[3] += sigm(a[3] + bv[3]) * bfh(pw.y);
                                *(f32x4*)(fout + r * D_ + c) = o; } }
                    asm volatile("" ::: "memory"); }
        } else if constexpr (MODE == EP_HID) {
            const int col0 = u.pn * HALF + wc * 32 + 8 * fq;
#pragma unroll
            for (int ai = 0; ai < 2; ++ai)
#pragma unroll
                for (int m = 0; m < 4; ++m) { const size_t r = (size_t)(row0 + ai * HALF + m * 16); const float w = fin[r];
                    const f32x4 g0 = acc[ai][0][m][0], g1 = acc[ai][0][m][1], u0 = acc[ai][1][m][0], u1 = acc[ai][1][m][1];
                    float h[8];
#pragma unroll
                    for (int j = 0; j < 4; ++j) { h[j] = g0[j] * sigm(g0[j]) * u0[j] * w; h[4 + j] = g1[j] * sigm(g1[j]) * u1[j] * w; }
                    u32x4 o; o.x = cvt_pk_bf16(h[0], h[1]); o.y = cvt_pk_bf16(h[2], h[3]); o.z = cvt_pk_bf16(h[4], h[5]); o.w = cvt_pk_bf16(h[6], h[7]);
                    *(u32x4*)(O + r * ldc + col0) = o; }
        } else {
            const int col0 = u.pn * BM + wc * 32 + 8 * fq;
            const bool act = (MODE == EP_Z) && (u.pn >= ZGA / BM);
            const bool shared = (MODE == EP_DOWN) && (u.aux >= NE);
#pragma unroll
            for (int ai = 0; ai < 2; ++ai)
#pragma unroll
                for (int m = 0; m < 4; ++m) { const size_t r = (size_t)(row0 + ai * HALF + m * 16);
#pragma unroll
                    for (int bj = 0; bj < 2; ++bj) { const int c = col0 + bj * HALF; f32x4 v0 = acc[ai][bj][m][0], v1 = acc[ai][bj][m][1];
                        if constexpr (MODE == EP_Z) { if (act) { const f32x4 b0 = *(const f32x4*)(fin + c - ZGA), b1 = *(const f32x4*)(fin + c - ZGA + 4);
#pragma unroll
                            for (int j = 0; j < 4; ++j) { v0[j] = sigm(v0[j] + b0[j]); v1[j] = sigm(v1[j] + b1[j]); } } }
                        if constexpr (MODE == EP_MG1 || MODE == EP_MG2) { const u32x4 gw = *(const u32x4*)(aux + r * ldaux + c);
                            v0[0] *= bfl(gw.x); v0[1] *= bfh(gw.x); v0[2] *= bfl(gw.y); v0[3] *= bfh(gw.y); v1[0] *= bfl(gw.z); v1[1] *= bfh(gw.z); v1[2] *= bfl(gw.w); v1[3] *= bfh(gw.w); }
                        if constexpr (MODE == EP_MG2) { const u32x4 ow = *(const u32x4*)(O + r * ldc + c);
                            v0[0] += bfl(ow.x); v0[1] += bfh(ow.x); v0[2] += bfl(ow.y); v0[3] += bfh(ow.y); v1[0] += bfl(ow.z); v1[1] += bfh(ow.z); v1[2] += bfl(ow.w); v1[3] += bfh(ow.w); }
                        if (shared) { float* op = fout + (r - NSLOT) * D_ + c; const f32x4 o0 = *(const f32x4*)op, o1 = *(const f32x4*)(op + 4); *(f32x4*)op = o0 + v0; *(f32x4*)(op + 4) = o1 + v1; }
                        else { u32x4 w; w.x = cvt_pk_bf16(v0[0], v0[1]); w.y = cvt_pk_bf16(v0[2], v0[3]); w.z = cvt_pk_bf16(v1[0], v1[1]); w.w = cvt_pk_bf16(v1[2], v1[3]);
                            *(u32x4*)(O + r * ldc + c) = w; } }
                    if constexpr (MODE == EP_DOWN || MODE == EP_MG1 || MODE == EP_MG2) asm volatile("" ::: "memory"); }
        }
    }
};
}

__device__ __forceinline__ unsigned pk2(float lo, float hi) { return (unsigned)f2bf(lo) | ((unsigned)f2bf(hi) << 16); }
__device__ __forceinline__ int zdst(int c) {
    if (c < 384) return c;
    if (c < 640) return ZCKV + (c - 384);
    if (c < 672) return ZKR + (c - 640);
    if (c < 1184) return ZQS + (c - 672);
    if (c < 1312) return ZKS + (c - 1184);
    if (c < 1440) return ZVS + (c - 1312);
    if (c < 2464) return ZGA + (c - 1440);
    return ZGB + (c - 2464);
}
__device__ __forceinline__ int gudst(int j) { const int half = j >> 8, jj = j & 255; return ((jj >> 7) << 8) + (half << 7) + (jj & 127); }
template <int MAP>
__device__ __forceinline__ void conv_item(const float* W, const float* g, int K, int N, bf16_t* WT, LAS float* scr, int item, int lane) {
    const int nblk = N / 32, kb = item / nblk, nb = item % nblk, k0 = 64 * kb, n0 = 32 * nb;
#pragma unroll 8
    for (int i = 0; i < 32; ++i) { const int kk = 2 * i + (lane >> 5); float v = W[(size_t)(k0 + kk) * N + n0 + (lane & 31)]; if (g) v *= g[k0 + kk]; scr[kk * 33 + (lane & 31)] = v; }
    asm volatile("s_waitcnt lgkmcnt(0)" ::: "memory");
    const int c = lane & 7; const int d0 = (MAP == 1) ? zdst(n0) : (MAP == 2) ? gudst(n0) : n0;
#pragma unroll
    for (int j = 0; j < 4; ++j) { const int n = (lane >> 3) + 8 * j; const LAS float* s = scr + (8 * c) * 33 + n;
        pg8::u32x4 o; o.x = pk2(s[0 * 33], s[1 * 33]); o.y = pk2(s[2 * 33], s[3 * 33]); o.z = pk2(s[4 * 33], s[5 * 33]); o.w = pk2(s[6 * 33], s[7 * 33]);
        *(pg8::u32x4*)(WT + (size_t)(d0 + n) * K + k0 + 8 * c) = o; }
    asm volatile("s_waitcnt lgkmcnt(0)" ::: "memory");
}
__device__ __forceinline__ void st_wconv(const P& p, int gw, int ngw, int lane, LAS float* scr) {
    constexpr int I0 = 16 * 109, I1 = 6 * 24, I2 = 4 * 32, I3 = 8 * 32, I4 = 8 * 32, I5 = 16 * 32, I6 = 16 * 32, I7 = 4 * 32, I8 = 16 * 16, I9 = 4 * 32, IGU = 16 * 16, IDN = 4 * 32;
    constexpr int NITEMS = I0 + I1 + I2 + I3 + I4 + I5 + I6 + I7 + I8 + I9 + 64 * IGU + 64 * IDN;
    for (int it = gw; it < NITEMS; it += ngw) {
        int r = it;
        if (r < I0) { conv_item<1>(p.w_in, p.g_mix, 1024, INW, WSP(bf16_t, WS_WIN), scr, r, lane); continue; } r -= I0;
        if (r < I1) { conv_item<0>(p.w_uq, p.g_cq, 384, 768, WSP(bf16_t, WS_WUQ), scr, r, lane); continue; } r -= I1;
        if (r < I2) { conv_item<0>(p.w_ukv, p.g_ckv, 256, 1024, WSP(bf16_t, WS_WUKV), scr, r, lane); continue; } r -= I2;
        if (r < I3) { conv_item<0>(p.w_br_mla, nullptr, 512, 1024, WSP(bf16_t, WS_WBRM), scr, r, lane); continue; } r -= I3;
        if (r < I4) { conv_item<0>(p.w_br_swa, nullptr, 512, 1024, WSP(bf16_t, WS_WBRS), scr, r, lane); continue; } r -= I4;
        if (r < I5) { conv_item<0>(p.w_out, nullptr, 1024, 1024, WSP(bf16_t, WS_WOUT), scr, r, lane); continue; } r -= I5;
        if (r < I6) { conv_item<0>(p.w_ple_gate, p.g_ple, 1024, 1024, WSP(bf16_t, WS_WPG), scr, r, lane); continue; } r -= I6;
        if (r < I7) { conv_item<0>(p.w_ple_proj, nullptr, 256, 1024, WSP(bf16_t, WS_WPP), scr, r, lane); continue; } r -= I7;
        if (r < I8) { conv_item<2>(p.w_sh_gu, p.g_moe, 1024, 512, WSP(bf16_t, WS_WGU) + (size_t)NE * 512 * 1024, scr, r, lane); continue; } r -= I8;
        if (r < I9) { conv_item<0>(p.w_sh_down, nullptr, 256, 1024, WSP(bf16_t, WS_WDN) + (size_t)NE * 1024 * 256, scr, r, lane); continue; } r -= I9;
        if (r < 64 * IGU) { const int e = r / IGU; conv_item<2>(p.w_exp_gu + (size_t)e * 1024 * 512, p.g_moe, 1024, 512, WSP(bf16_t, WS_WGU) + (size_t)e * 512 * 1024, scr, r % IGU, lane); continue; } r -= 64 * IGU;
        { const int e = r / IDN; conv_item<0>(p.w_exp_down + (size_t)e * 256 * 1024, nullptr, 256, 1024, WSP(bf16_t, WS_WDN) + (size_t)e * 1024 * 256, scr, r % IDN, lane); }
    }
    { unsigned* zp = (unsigned*)(WSP(bf16_t, WS_WIN) + (size_t)416 * 1024); const int n = 96 * 1024 / 2;
      for (int i = gw * 64 + lane; i < n; i += ngw * 64) zp[i] = 0u; }
}
__device__ __forceinline__ void fs_g1(const P& p, LAS unsigned char* lds) {
    pg8::DenseSched S; S.init(WSP(bf16_t, WS_HB), D_, WSP(bf16_t, WS_WIN), D_, M_, NZ, gridDim.x, blockIdx.x);
    pg8::Epi<pg8::EP_Z> E{WSP(bf16_t, WS_Z), NZ, nullptr, 0, p.b_gate, nullptr};
    pg8::gemm_phase<pg8::Epi<pg8::EP_Z>, pg8::DenseSched, false>(lds, D_, D_, D_, S, E);
}

struct MoeSched {
    const char* A; const char* Bt; size_t astep, bstep, estep; const int* tile_e; const int* ltok; int T, NPN, nwg, G, c; bool gather;
    __device__ __forceinline__ void init(const void* A_, int lda, const void* Bt_, int ldb, int ncols_e, const int* tile_e_, const int* ltok_, int T_, bool gather_, int G_, int c_) {
        A = (const char*)A_; Bt = (const char*)Bt_; astep = (size_t)256 * lda * 2; bstep = (size_t)256 * ldb * 2; estep = (size_t)ncols_e * ldb * 2; tile_e = tile_e_; ltok = ltok_;
        T = T_; NPN = ncols_e / 256; nwg = (T + M_ / 256) * NPN; G = G_; c = c_; gather = gather_; }
    __device__ __forceinline__ bool next(int i, pg8::Unit& u) const {
        const long L = (long)i * G + c; if (L >= nwg) return false;
        int wgid = (int)L; { const int q = nwg / 8, r = nwg % 8, xcd = wgid % 8, off = wgid / 8; wgid = (xcd < r ? xcd * (q + 1) : r * (q + 1) + (xcd - r) * q) + off; }
        const int j = wgid / NPN; u.pn = wgid % NPN;
        int e; if (j < T) { u.pm = j; e = __builtin_amdgcn_readfirstlane(tile_e[j]); } else { u.pm = NSLOT / 256 + (j - T); e = NE; }
        u.Ab = gather ? A : A + (size_t)u.pm * astep; u.Bb = Bt + (size_t)e * estep + (size_t)u.pn * bstep; u.aux = e; return true;
    }
    __device__ __forceinline__ int row(const pg8::Unit& u, int r) const { return ltok[u.pm * 256 + r]; }
};
constexpr size_t WS_TILEE = 5 * MiB;
__device__ __forceinline__ void fs_g23(const P& p, LAS unsigned char* lds) {
    { pg8::DenseSched S; S.init(WSP(bf16_t, WS_Z) + ZQ, NZ, WSP(bf16_t, WS_WUQ), 384, M_, 768, gridDim.x, blockIdx.x);
      pg8::Epi<pg8::EP_BF16> E{WSP(bf16_t, WS_QMR), 768, nullptr, 0, nullptr, nullptr};
      pg8::gemm_phase<pg8::Epi<pg8::EP_BF16>, pg8::DenseSched, false>(lds, 384, NZ, 384, S, E); }
    { pg8::DenseSched S; S.init(WSP(bf16_t, WS_Z) + ZCKV, NZ, WSP(bf16_t, WS_WUKV), 256, M_, 1024, gridDim.x, blockIdx.x);
      pg8::Epi<pg8::EP_BF16> E{WSP(bf16_t, WS_KVR), 1024, nullptr, 0, nullptr, nullptr};
      pg8::gemm_phase<pg8::Epi<pg8::EP_BF16>, pg8::DenseSched, false>(lds, 256, NZ, 256, S, E); }
}
__device__ __forceinline__ void fs_merge(const P& p, LAS unsigned char* lds) {
    { pg8::DenseSched S; S.init(WSP(bf16_t, WS_OM), 512, WSP(bf16_t, WS_WBRM), 512, M_, D_, gridDim.x, blockIdx.x);
      pg8::Epi<pg8::EP_MG1> E{WSP(bf16_t, WS_MG), D_, WSP(bf16_t, WS_Z) + ZGA, NZ, nullptr, nullptr};
      pg8::gemm_phase<pg8::Epi<pg8::EP_MG1>, pg8::DenseSched, false>(lds, 512, 512, 512, S, E); }
    { pg8::DenseSched S; S.init(WSP(bf16_t, WS_OW), 512, WSP(bf16_t, WS_WBRS), 512, M_, D_, gridDim.x, blockIdx.x);
      pg8::Epi<pg8::EP_MG2> E{WSP(bf16_t, WS_MG), D_, WSP(bf16_t, WS_Z) + ZGB, NZ, nullptr, nullptr};
      pg8::gemm_phase<pg8::Epi<pg8::EP_MG2>, pg8::DenseSched, false>(lds, 512, 512, 512, S, E); }
}
__device__ __forceinline__ void fs_out(const P& p, LAS unsigned char* lds) {
    pg8::DenseSched S; S.init(WSP(bf16_t, WS_MG), D_, WSP(bf16_t, WS_WOUT), D_, M_, D_, gridDim.x, blockIdx.x);
    pg8::Epi<pg8::EP_RES> E{nullptr, 0, nullptr, 0, p.x, p.out};
    pg8::gemm_phase<pg8::Epi<pg8::EP_RES>, pg8::DenseSched, false>(lds, D_, D_, D_, S, E);
}
__device__ __forceinline__ void fs_gu(const P& p, LAS unsigned char* lds) {
    const int T = __builtin_amdgcn_readfirstlane((int)(WSP(unsigned, WS_CTL)[CW_BASE + NE] / 256u));
    MoeSched S; S.init(WSP(bf16_t, WS_H2), D_, WSP(bf16_t, WS_WGU), D_, 512, WSP(int, WS_TILEE), WSP(int, WS_LTOK), T, true, gridDim.x, blockIdx.x);
    pg8::Epi<pg8::EP_HID> E{WSP(bf16_t, WS_HID), EFF, nullptr, 0, WSP(float, WS_LW), nullptr};
    pg8::gemm_phase<pg8::Epi<pg8::EP_HID>, MoeSched, true>(lds, D_, D_, D_, S, E);
}
__device__ __forceinline__ void fs_down(const P& p, LAS unsigned char* lds) {
    const int T = __builtin_amdgcn_readfirstlane((int)(WSP(unsigned, WS_CTL)[CW_BASE + NE] / 256u));
    MoeSched S; S.init(WSP(bf16_t, WS_HID), EFF, WSP(bf16_t, WS_WDN), EFF, 1024, WSP(int, WS_TILEE), WSP(int, WS_LTOK), T, false, gridDim.x, blockIdx.x);
    pg8::Epi<pg8::EP_DOWN> E{WSP(bf16_t, WS_Y), D_, nullptr, 0, nullptr, p.out};
    pg8::gemm_phase<pg8::Epi<pg8::EP_DOWN>, MoeSched, false>(lds, EFF, EFF, EFF, S, E);
}
__device__ __forceinline__ void fs_ple(const P& p, LAS unsigned char* lds) {
    { pg8::DenseSched S; S.init(WSP(bf16_t, WS_PB), 256, WSP(bf16_t, WS_WPP), 256, M_, D_, gridDim.x, blockIdx.x);
      pg8::Epi<pg8::EP_BF16> E{WSP(bf16_t, WS_PP), D_, nullptr, 0, nullptr, nullptr};
      pg8::gemm_phase<pg8::Epi<pg8::EP_BF16>, pg8::DenseSched, false>(lds, 256, 256, 256, S, E); }
    { pg8::DenseSched S; S.init(WSP(bf16_t, WS_H3), D_, WSP(bf16_t, WS_WPG), D_, M_, D_, gridDim.x, blockIdx.x);
      pg8::Epi<pg8::EP_PLE> E{nullptr, 0, WSP(bf16_t, WS_PP), D_, p.b_ple, p.out};
      pg8::gemm_phase<pg8::Epi<pg8::EP_PLE>, pg8::DenseSched, false>(lds, D_, D_, D_, S, E); }
}

#ifndef FAST_MASK
#define FAST_MASK 0xffff
#endif
constexpr int NT = 512;
constexpr int LDS_DYN = 144 * 1024;
constexpr int MISC_OFF = 132 * 1024;
constexpr int N_STAGES = 14;
__global__ void __launch_bounds__(NT) k_fwd(P p) {
    extern __shared__ __attribute__((aligned(16))) unsigned char lds[];
    const int tid0 = threadIdx.x;
    volatile LAS unsigned* misc = (volatile LAS unsigned*)((LAS unsigned char*)lds + MISC_OFF);
    if (tid0 < 16) misc[tid0] = 0u;
    __syncthreads();
    XcdBarrier bar = xcd_barrier_post(WSP(unsigned, WS_CTL) + CW_BAR, misc);
    const int lo = p.st_lo, hi = p.st_hi;
#define RUN(k, call) if (lo <= (k) && (k) < hi) { { int tid = tid0; asm volatile("" : "+v"(tid)); const int lane = tid & 63, wave = tid >> 6; const int wg = blockIdx.x, nwg = gridDim.x; \
        const int gw = wg * (NT / 64) + wave, ngw = nwg * (NT / 64); const size_t gt = (size_t)wg * NT + tid, ngt = (size_t)nwg * NT; \
        (void)lane; (void)wave; (void)wg; (void)nwg; (void)gw; (void)ngw; (void)gt; (void)ngt; call; } if ((k) + 1 < hi) xcd_barrier(bar); }
    RUN(0, (st_prep(p, gw, ngw, lane), st_wconv(p, gw, ngw, lane, (LAS float*)((LAS unsigned char*)lds + wave * 16384))))
#if FAST_MASK & 2
    RUN(1, fs_g1(p, (LAS unsigned char*)lds))
#else
    RUN(1, nv_g1(p, gt, ngt))
#endif
#if FAST_MASK & 4
    RUN(2, fs_g23(p, (LAS unsigned char*)lds))
#else
    RUN(2, nv_g23(p, gt, ngt))
#endif
    RUN(3, st_attn_prep(p, wg, nwg, wave, lane, (bf16_t*)lds))
    RUN(4, (nv_attn<96, false>(p, gt, ngt)))
    RUN(5, (nv_attn<64, true>(p, gt, ngt)))
#if FAST_MASK & 8
    RUN(6, fs_merge(p, (LAS unsigned char*)lds))
#else
    RUN(6, nv_merge(p, gt, ngt))
#endif
#if FAST_MASK & 8
    RUN(7, fs_out(p, (LAS unsigned char*)lds))
#else
    RUN(7, nv_out(p, gt, ngt))
#endif
    RUN(8, st_route(p, gw, ngw, lane, (float*)lds + wave * 1024))
    RUN(9, st_lists(p, gt, ngt))
#if FAST_MASK & 16
    RUN(10, fs_gu(p, (LAS unsigned char*)lds))
#else
    RUN(10, nv_gu(p, gt, ngt))
#endif
#if FAST_MASK & 32
    RUN(11, fs_down(p, (LAS unsigned char*)lds))
#else
    RUN(11, nv_down(p, gt, ngt))
#endif
    RUN(12, st_combine(p, gw, ngw, lane))
#if FAST_MASK & 64
    RUN(13, fs_ple(p, (LAS unsigned char*)lds))
#else
    RUN(13, nv_ple(p, gt, ngt))
#endif
#undef RUN
}

extern "C" void kernel_launch(void* const* d_in, const int* in_sizes, int n_in, void* d_out, int out_size, void* d_ws, size_t ws_size, hipStream_t stream) {
    if (n_in != 29 || ws_size < WS_END) { fprintf(stderr, "kernel_launch: unexpected n_in %d or ws_size %zu\n", n_in, ws_size); return; }
    P p{};
    p.x = (const float*)d_in[0]; p.p = (const float*)d_in[1]; p.pos = (const int*)d_in[2];
#define IN_(name, i) p.name = (const float*)d_in[i]
    IN_(g_mix, 3); IN_(w_in, 4); IN_(b_gate, 5); IN_(g_cq, 6); IN_(w_uq, 7); IN_(g_ckv, 8); IN_(w_ukv, 9); IN_(g_qn_mla, 10); IN_(g_kn_mla, 11);
    IN_(g_qn_swa, 12); IN_(g_kn_swa, 13); IN_(sink, 14); IN_(w_br_mla, 15); IN_(w_br_swa, 16); IN_(w_out, 17); IN_(g_moe, 18); IN_(w_router, 19);
    IN_(router_bias, 20); IN_(w_exp_gu, 21); IN_(w_exp_down, 22); IN_(w_sh_gu, 23); IN_(w_sh_down, 24); IN_(g_ple, 25); IN_(w_ple_gate, 26); IN_(b_ple, 27); IN_(w_ple_proj, 28);
#undef IN_
    p.out = (float*)d_out; p.ws = (unsigned char*)d_ws;
    static int grid = 0;
    if (grid == 0) {
        int dev = 0, cus = 0, per_cu = 0;
        (void)hipGetDevice(&dev); (void)hipDeviceGetAttribute(&cus, hipDeviceAttributeMultiprocessorCount, dev);
        (void)hipFuncSetAttribute((const void*)k_fwd, hipFuncAttributeMaxDynamicSharedMemorySize, LDS_DYN);
        (void)hipOccupancyMaxActiveBlocksPerMultiprocessor(&per_cu, (const void*)k_fwd, NT, LDS_DYN);
        (void)hipGetLastError();
        if (per_cu < 1) { fprintf(stderr, "kernel_launch: occupancy query says %d blocks per CU\n", per_cu); grid = -1; return; }
        grid = cus;
    }
    if (grid < 0) return;
    (void)hipMemsetAsync((char*)d_ws + WS_CTL, 0, CTL_BYTES, stream);
    p.st_lo = 0; p.st_hi = N_STAGES;
    void* args[] = {&p};
    hipError_t e = hipLaunchCooperativeKernel((const void*)k_fwd, dim3(grid), dim3(NT), args, LDS_DYN, stream);
    if (e != hipSuccess) fprintf(stderr, "cooperative launch failed: %s (grid %d)\n", hipGetErrorString(e), grid);
}
```

```cpp
#include <hip/hip_runtime.h>
#include <stdint.h>
#include <cstdio>

constexpr int B_ = 8, S_ = 2048, D_ = 1024, M_ = B_ * S_;
constexpr int NZ = 3584;
constexpr int INW = 3488;
constexpr int ZQ = 0, ZKR = 384, ZCKV = 512, ZQS = 768, ZKS = 1280, ZVS = 1408, ZGA = 1536, ZGB = 2560;
constexpr int NE = 64, TOPK = 8, EFF = 256;
constexpr int NSLOT = M_ * TOPK + NE * 256;
constexpr float EPS = 1e-6f;
constexpr float LOG2E = 1.4426950408889634f;

typedef unsigned short bf16_t;
__device__ __forceinline__ float bf2f(bf16_t v) { return __uint_as_float((unsigned)v << 16); }
__device__ __forceinline__ bf16_t f2bf(float f) { unsigned u = __float_as_uint(f); return (bf16_t)((u + 0x7fffu + ((u >> 16) & 1u)) >> 16); }
__device__ __forceinline__ float sigmoidf_(float v) { return 1.f / (1.f + __expf(-v)); }
__device__ __forceinline__ float wave_sum(float v) {
#pragma unroll
    for (int o = 1; o < 64; o <<= 1) v += __shfl_xor(v, o);
    return v;
}
__device__ __forceinline__ float wave_max(float v) {
#pragma unroll
    for (int o = 1; o < 64; o <<= 1) v = fmaxf(v, __shfl_xor(v, o));
    return v;
}

constexpr size_t MiB = 1u << 20;
constexpr size_t WS_CTL = 0, CTL_BYTES = 64 * 1024;
constexpr size_t WS_TOPE = 1 * MiB, WS_TOPW = WS_TOPE + 512 * 1024, WS_TOPLS = WS_TOPW + 512 * 1024, WS_POS = WS_TOPLS + 512 * 1024;
constexpr size_t WS_LTOK = 3 * MiB, WS_LW = WS_LTOK + 640 * 1024;
constexpr size_t WS_PB = 6 * MiB, WS_WDN = 14 * MiB, WS_WPG = 48 * MiB, WS_WPP = 50 * MiB, WS_WSHDN = 46 * MiB;
constexpr size_t WS_HID = 51 * MiB, WS_HSH = 123 * MiB, WS_R = 131 * MiB;
constexpr size_t WS_WGU = 131 * MiB, WS_WSHGU = 195 * MiB, WS_WIN = 196 * MiB, WS_WUQ = 203 * MiB, WS_WUKV = 204 * MiB, WS_WBRM = 205 * MiB, WS_WBRS = 206 * MiB, WS_WOUT = 207 * MiB;
constexpr size_t WS_Z = 210 * MiB, WS_HB = 322 * MiB, WS_MG = 322 * MiB, WS_QMR = 354 * MiB, WS_OM = 354 * MiB, WS_OW = 370 * MiB, WS_KVR = 378 * MiB;
constexpr size_t WS_QM = 410 * MiB, WS_KM = 434 * MiB, WS_VTM = 458 * MiB, WS_QS = 474 * MiB, WS_KS = 490 * MiB, WS_VTS = 494 * MiB;
constexpr size_t WS_H2 = 210 * MiB, WS_Y = 131 * MiB, WS_H3 = 419 * MiB, WS_PP = 451 * MiB, WS_END = 498 * MiB;
constexpr int CW_CNT = 0;
constexpr int CW_BASE = 64;

struct P {
    const float *x, *p; const int* pos;
    const float *g_mix, *w_in, *b_gate, *g_cq, *w_uq, *g_ckv, *w_ukv, *g_qn_mla, *g_kn_mla, *g_qn_swa, *g_kn_swa, *sink;
    const float *w_br_mla, *w_br_swa, *w_out, *g_moe, *w_router, *router_bias, *w_exp_gu, *w_exp_down, *w_sh_gu, *w_sh_down;
    const float *g_ple, *w_ple_gate, *b_ple, *w_ple_proj;
    float* out; unsigned char* ws; int st_lo; int st_hi;
};
#define WSP(T, off) ((T*)(p.ws + (off)))

__device__ __forceinline__ void ndot4(float (&acc)[4], const bf16_t* a0, const bf16_t* a1, const bf16_t* a2, const bf16_t* a3, const float* g, const float* W, int ldw, int K) {
    float c0 = 0.f, c1 = 0.f, c2 = 0.f, c3 = 0.f;
    for (int k = 0; k < K; ++k) {
        const float w = W[(size_t)k * ldw] * (g ? g[k] : 1.f);
        c0 += bf2f(a0[k]) * w; c1 += bf2f(a1[k]) * w; c2 += bf2f(a2[k]) * w; c3 += bf2f(a3[k]) * w;
    }
    acc[0] = c0; acc[1] = c1; acc[2] = c2; acc[3] = c3;
}
__device__ __forceinline__ int zsrc(int n) {
    if (n < 384) return n;
    if (n < 416) return 640 + (n - 384);
    if (n < 512) return -1;
    if (n < 768) return 384 + (n - 512);
    if (n < 1280) return 672 + (n - 768);
    if (n < 1408) return 1184 + (n - 1280);
    if (n < 1536) return 1312 + (n - 1408);
    if (n < 2560) return 1440 + (n - 1536);
    return 2464 + (n - 2560);
}

__device__ __forceinline__ void st_prep(const P& p, int gw, int ngw, int lane) {
    bf16_t* hb = WSP(bf16_t, WS_HB); bf16_t* pb = WSP(bf16_t, WS_PB);
    for (int m = gw; m < M_; m += ngw) {
        const float* xr = p.x + (size_t)m * D_; float v[16]; float s = 0.f;
#pragma unroll
        for (int j = 0; j < 16; ++j) { v[j] = xr[lane + 64 * j]; s += v[j] * v[j]; }
        s = wave_sum(s); const float r = 1.f / sqrtf(s * (1.f / D_) + EPS);
#pragma unroll
        for (int j = 0; j < 16; ++j) hb[(size_t)m * D_ + lane + 64 * j] = f2bf(v[j] * r);
#pragma unroll
        for (int j = 0; j < 4; ++j) pb[(size_t)m * 256 + lane + 64 * j] = f2bf(p.p[(size_t)m * 256 + lane + 64 * j]);
    }
}
__device__ __forceinline__ void nv_g1(const P& p, size_t gt, size_t ngt) {
    const bf16_t* hb = WSP(bf16_t, WS_HB); bf16_t* z = WSP(bf16_t, WS_Z);
    const size_t total = (size_t)(M_ / 4) * NZ;
    for (size_t i = gt; i < total; i += ngt) {
        const int n = (int)(i % NZ); const int m = (int)(i / NZ) * 4; const int src = zsrc(n);
        float acc[4] = {0.f, 0.f, 0.f, 0.f};
        if (src >= 0) { const bf16_t* a = hb + (size_t)m * D_; ndot4(acc, a, a + D_, a + 2 * D_, a + 3 * D_, p.g_mix, p.w_in + src, INW, D_); }
#pragma unroll
        for (int r = 0; r < 4; ++r) { float v = acc[r]; if (n >= ZGA) v = sigmoidf_(v + p.b_gate[n - ZGA]); z[(size_t)(m + r) * NZ + n] = f2bf(v); }
    }
}
__device__ __forceinline__ void nv_g23(const P& p, size_t gt, size_t ngt) {
    const bf16_t* z = WSP(bf16_t, WS_Z); bf16_t* qmr = WSP(bf16_t, WS_QMR); bf16_t* kvr = WSP(bf16_t, WS_KVR);
    const size_t t1 = (size_t)(M_ / 4) * 768, t2 = (size_t)(M_ / 4) * 1024;
    for (size_t i = gt; i < t1 + t2; i += ngt) {
        float acc[4];
        if (i < t1) { const int n = (int)(i % 768), m = (int)(i / 768) * 4; const bf16_t* a = z + (size_t)m * NZ + ZQ;
            ndot4(acc, a, a + NZ, a + 2 * NZ, a + 3 * NZ, p.g_cq, p.w_uq + n, 768, 384);
#pragma unroll
            for (int r = 0; r < 4; ++r) qmr[(size_t)(m + r) * 768 + n] = f2bf(acc[r]);
        } else { const size_t j = i - t1; const int n = (int)(j % 1024), m = (int)(j / 1024) * 4; const bf16_t* a = z + (size_t)m * NZ + ZCKV;
            ndot4(acc, a, a + NZ, a + 2 * NZ, a + 3 * NZ, p.g_ckv, p.w_ukv + n, 1024, 256);
#pragma unroll
            for (int r = 0; r < 4; ++r) kvr[(size_t)(m + r) * 1024 + n] = f2bf(acc[r]);
        }
    }
}

constexpr int VT_PITCH = 66;
__device__ __forceinline__ void st_attn_prep(const P& p, int wg, int nwg, int wave, int lane, bf16_t* lds) {
    const bf16_t* z = WSP(bf16_t, WS_Z); const bf16_t* qmr = WSP(bf16_t, WS_QMR); const bf16_t* kvr = WSP(bf16_t, WS_KVR);
    bf16_t* QM = WSP(bf16_t, WS_QM); bf16_t* KM = WSP(bf16_t, WS_KM); bf16_t* VTM = WSP(bf16_t, WS_VTM);
    bf16_t* QS = WSP(bf16_t, WS_QS); bf16_t* KS = WSP(bf16_t, WS_KS); bf16_t* VTS = WSP(bf16_t, WS_VTS);
    const float sc_m = 0.10206207261596575f * LOG2E;
    const float sc_s = 0.125f * LOG2E;
    for (int tile = wg; tile < M_ / 64; tile += nwg) {
        __syncthreads();
        for (int tt = 0; tt < 8; ++tt) {
            const int tl = wave * 8 + tt, m = tile * 64 + tl, b = m / S_, s = m % S_;
            const bf16_t* zr = z + (size_t)m * NZ;
            const float posf = (float)p.pos[m];
            float sq = 0.f, skv = 0.f;
#pragma unroll
            for (int j = 0; j < 6; ++j) { const float v = bf2f(zr[ZQ + lane + 64 * j]); sq += v * v; }
#pragma unroll
            for (int j = 0; j < 4; ++j) { const float v = bf2f(zr[ZCKV + lane + 64 * j]); skv += v * v; }
            sq = wave_sum(sq); skv = wave_sum(skv);
            const float rq = 1.f / sqrtf(sq * (1.f / 384.f) + EPS), rkv = 1.f / sqrtf(skv * (1.f / 256.f) + EPS);
            const float inv_m = exp2f(-13.287712379549449f * (float)(lane & 15) * (1.f / 16.f));
            const float inv_s = exp2f(-13.287712379549449f * (float)(lane & 31) * (1.f / 32.f));
            float cm, sm, cs, ss; sincosf(posf * inv_m, &sm, &cm); sincosf(posf * inv_s, &ss, &cs);
            const float krope = bf2f(zr[ZKR + (lane & 31)]);
            for (int h = 0; h < 8; ++h) {
                { float v0 = bf2f(qmr[(size_t)m * 768 + h * 96 + lane]) * rq;
                  float v1 = (lane < 32) ? bf2f(qmr[(size_t)m * 768 + h * 96 + 64 + lane]) * rq : 0.f;
                  const float ssum = wave_sum(v0 * v0 + v1 * v1); const float r = 1.f / sqrtf(ssum * (1.f / 96.f) + EPS);
                  v0 *= r * p.g_qn_mla[lane]; v1 *= (lane < 32) ? r * p.g_qn_mla[64 + lane] : 0.f;
                  const float o = __shfl_xor(v1, 16);
                  const float rot = (lane < 16) ? (v1 * cm - o * sm) : (v1 * cm + o * sm);
                  bf16_t* dst = QM + ((size_t)(b * 8 + h) * S_ + s) * 96;
                  dst[lane] = f2bf(v0 * sc_m); if (lane < 32) dst[64 + lane] = f2bf(rot * sc_m); }
                { float v0 = bf2f(kvr[(size_t)m * 1024 + h * 128 + lane]) * rkv;
                  float v1 = (lane < 32) ? krope : 0.f;
                  const float ssum = wave_sum(v0 * v0 + v1 * v1); const float r = 1.f / sqrtf(ssum * (1.f / 96.f) + EPS);
                  v0 *= r * p.g_kn_mla[lane]; v1 *= (lane < 32) ? r * p.g_kn_mla[64 + lane] : 0.f;
                  const float o = __shfl_xor(v1, 16);
                  const float rot = (lane < 16) ? (v1 * cm - o * sm) : (v1 * cm + o * sm);
                  bf16_t* dst = KM + ((size_t)(b * 8 + h) * S_ + s) * 96;
                  dst[lane] = f2bf(v0); if (lane < 32) dst[64 + lane] = f2bf(rot);
                  const float vv = bf2f(kvr[(size_t)m * 1024 + h * 128 + 64 + lane]) * rkv;
                  lds[(h * 64 + lane) * VT_PITCH + tl] = f2bf(vv); }
                { float v = bf2f(zr[ZQS + h * 64 + lane]);
                  const float ssum = wave_sum(v * v); const float r = 1.f / sqrtf(ssum * (1.f / 64.f) + EPS);
                  v *= r * p.g_qn_swa[lane];
                  const float o = __shfl_xor(v, 32);
                  const float rot = (lane < 32) ? (v * cs - o * ss) : (v * cs + o * ss);
                  QS[((size_t)(b * 8 + h) * S_ + s) * 64 + lane] = f2bf(rot * sc_s); }
                if (h < 2) {
                  float v = bf2f(zr[ZKS + h * 64 + lane]);
                  const float ssum = wave_sum(v * v); const float r = 1.f / sqrtf(ssum * (1.f / 64.f) + EPS);
                  v *= r * p.g_kn_swa[lane];
                  const float o = __shfl_xor(v, 32);
                  const float rot = (lane < 32) ? (v * cs - o * ss) : (v * cs + o * ss);
                  KS[((size_t)(b * 2 + h) * S_ + s) * 64 + lane] = f2bf(rot);
                  lds[(512 + h * 64 + lane) * VT_PITCH + tl] = zr[ZVS + h * 64 + lane]; }
            }
        }
        __syncthreads();
        const int b = (tile * 64) / S_, s0 = (tile * 64) % S_;
        for (int r = wave; r < 640; r += 8) {
            const bf16_t v = lds[r * VT_PITCH + lane];
            if (r < 512) VTM[((size_t)(b * 8 + (r >> 6)) * 64 + (r & 63)) * S_ + s0 + lane] = v;
            else { const int rr = r - 512; VTS[((size_t)(b * 2 + (rr >> 6)) * 64 + (rr & 63)) * S_ + s0 + lane] = v; }
        }
    }
}

template <int DK, bool SWA>
__device__ __forceinline__ void nv_attn(const P& p, size_t gt, size_t ngt) {
    const bf16_t* Q = SWA ? WSP(bf16_t, WS_QS) : WSP(bf16_t, WS_QM);
    const bf16_t* K = SWA ? WSP(bf16_t, WS_KS) : WSP(bf16_t, WS_KM);
    const bf16_t* VT = SWA ? WSP(bf16_t, WS_VTS) : WSP(bf16_t, WS_VTM);
    bf16_t* O = SWA ? WSP(bf16_t, WS_OW) : WSP(bf16_t, WS_OM);
    const size_t total = (size_t)B_ * 8 * S_;
    for (size_t i = gt; i < total; i += ngt) {
        const int q = (int)(i % S_), h = (int)((i / S_) % 8), b = (int)(i / ((size_t)S_ * 8));
        const int kvh = SWA ? (b * 2 + h / 4) : (b * 8 + h);
        const bf16_t* qp = Q + ((size_t)(b * 8 + h) * S_ + q) * DK;
        const bf16_t* kb = K + (size_t)kvh * S_ * DK; const bf16_t* vb = VT + (size_t)kvh * 64 * S_;
        float m, l; float o[64]; unsigned qf[DK / 2];
#pragma unroll
        for (int d = 0; d < 64; ++d) o[d] = 0.f;
#pragma unroll
        for (int d = 0; d < DK / 2; ++d) qf[d] = ((const unsigned*)qp)[d];
        if (SWA) { m = p.sink[h] * LOG2E; l = 1.f; } else { m = -1e30f; l = 0.f; }
        const int k0 = SWA ? max(0, q - 128) : 0, k1 = SWA ? min(S_ - 1, q + 128) : S_ - 1;
        for (int k = k0; k <= k1; ++k) {
            float s = 0.f; const bf16_t* kp = kb + (size_t)k * DK;
#pragma unroll
            for (int d = 0; d < DK / 2; ++d) { const unsigned kk = ((const unsigned*)kp)[d];
                s += __uint_as_float(qf[d] << 16) * __uint_as_float(kk << 16) + __uint_as_float(qf[d] & 0xffff0000u) * __uint_as_float(kk & 0xffff0000u); }
            const float mn = fmaxf(m, s), al = exp2f(m - mn), pr = exp2f(s - mn);
            l = l * al + pr; m = mn;
#pragma unroll
            for (int d = 0; d < 64; ++d) o[d] = o[d] * al + pr * bf2f(vb[(size_t)d * S_ + k]);
        }
        const float il = 1.f / l;
        bf16_t* op = O + ((size_t)(b * S_ + q)) * 512 + h * 64;
#pragma unroll
        for (int d = 0; d < 64; ++d) op[d] = f2bf(o[d] * il);
    }
}
__device__ __forceinline__ void nv_merge(const P& p, size_t gt, size_t ngt) {
    const bf16_t* z = WSP(bf16_t, WS_Z); const bf16_t* om = WSP(bf16_t, WS_OM); const bf16_t* ow = WSP(bf16_t, WS_OW); bf16_t* mg = WSP(bf16_t, WS_MG);
    const size_t total = (size_t)(M_ / 4) * D_;
    for (size_t i = gt; i < total; i += ngt) {
        const int n = (int)(i % D_), m = (int)(i / D_) * 4; float a[4], c[4];
        const bf16_t* r0 = om + (size_t)m * 512; ndot4(a, r0, r0 + 512, r0 + 1024, r0 + 1536, nullptr, p.w_br_mla + n, D_, 512);
        const bf16_t* r1 = ow + (size_t)m * 512; ndot4(c, r1, r1 + 512, r1 + 1024, r1 + 1536, nullptr, p.w_br_swa + n, D_, 512);
#pragma unroll
        for (int r = 0; r < 4; ++r) { const bf16_t* zr = z + (size_t)(m + r) * NZ; mg[(size_t)(m + r) * D_ + n] = f2bf(bf2f(zr[ZGA + n]) * a[r] + bf2f(zr[ZGB + n]) * c[r]); }
    }
}
__device__ __forceinline__ void nv_out(const P& p, size_t gt, size_t ngt) {
    const bf16_t* mg = WSP(bf16_t, WS_MG);
    const size_t total = (size_t)(M_ / 4) * D_;
    for (size_t i = gt; i < total; i += ngt) {
        const int n = (int)(i % D_), m = (int)(i / D_) * 4; float a[4];
        const bf16_t* r0 = mg + (size_t)m * D_; ndot4(a, r0, r0 + D_, r0 + 2 * D_, r0 + 3 * D_, nullptr, p.w_out + n, D_, D_);
#pragma unroll
        for (int r = 0; r < 4; ++r) p.out[(size_t)(m + r) * D_ + n] = p.x[(size_t)(m + r) * D_ + n] + a[r];
    }
}
__device__ __forceinline__ void st_route(const P& p, int gw, int ngw, int lane, float* xs) {
    bf16_t* h2 = WSP(bf16_t, WS_H2); int* tope = WSP(int, WS_TOPE); float* topw = WSP(float, WS_TOPW); int* topls = WSP(int, WS_TOPLS);
    unsigned* cnt = WSP(unsigned, WS_CTL) + CW_CNT;
    for (int m = gw; m < M_; m += ngw) {
        const float* xr = p.out + (size_t)m * D_; float v[16]; float s = 0.f;
#pragma unroll
        for (int j = 0; j < 16; ++j) { v[j] = xr[lane + 64 * j]; s += v[j] * v[j]; }
        s = wave_sum(s); const float r = 1.f / sqrtf(s * (1.f / D_) + EPS);
#pragma unroll
        for (int j = 0; j < 16; ++j) { const float xn = v[j] * r; h2[(size_t)m * D_ + lane + 64 * j] = f2bf(xn); xs[lane + 64 * j] = xn * p.g_moe[lane + 64 * j]; }
        __builtin_amdgcn_s_waitcnt(0xc07f);
        float logit = 0.f;
        for (int k = 0; k < D_; ++k) logit += xs[k] * p.w_router[(size_t)k * NE + lane];
        const float score = sigmoidf_(logit); const float sel = score + p.router_bias[lane];
        float m1 = sel;
        m1 = fmaxf(m1, __shfl_xor(m1, 1)); m1 = fmaxf(m1, __shfl_xor(m1, 2)); m1 = fmaxf(m1, __shfl_xor(m1, 4));
        const unsigned long long eqm = __ballot(sel == m1);
        const int g = lane >> 3; const unsigned gm = (unsigned)((eqm >> (g * 8)) & 0xffull);
        const int first = __ffs((int)gm) - 1;
        float v2 = ((lane & 7) == first) ? -3.0e38f : sel;
        v2 = fmaxf(v2, __shfl_xor(v2, 1)); v2 = fmaxf(v2, __shfl_xor(v2, 2)); v2 = fmaxf(v2, __shfl_xor(v2, 4));
        const float gs = m1 + v2;
        int grank = 0;
#pragma unroll
        for (int j = 0; j < 8; ++j) { const float o = __shfl(gs, j * 8); grank += (o > gs || (o == gs && j < g)) ? 1 : 0; }
        const float msel = (grank < 4) ? sel : -1e30f;
        int rank = 0;
        for (int j = 0; j < 64; ++j) { const float o = __shfl(msel, j); rank += (o > msel || (o == msel && j < lane)) ? 1 : 0; }
        const bool chosen = rank < TOPK;
        const float wsum = wave_sum(chosen ? score : 0.f);
        if (chosen) {
            const unsigned ls = atomicAdd(&cnt[lane], 1u);
            tope[m * TOPK + rank] = lane; topw[m * TOPK + rank] = score / wsum * 2.5f; topls[m * TOPK + rank] = (int)ls;
        }
    }
}
__device__ __forceinline__ void st_lists(const P& p, size_t gt, size_t ngt) {
    const unsigned* cnt = WSP(unsigned, WS_CTL) + CW_CNT; unsigned* basew = WSP(unsigned, WS_CTL) + CW_BASE;
    const int* tope = WSP(int, WS_TOPE); const float* topw = WSP(float, WS_TOPW); const int* topls = WSP(int, WS_TOPLS);
    int* pos = WSP(int, WS_POS); int* ltok = WSP(int, WS_LTOK); float* lw = WSP(float, WS_LW);
    for (size_t i = gt; i < (size_t)M_ * TOPK; i += ngt) {
        const int e = tope[i]; unsigned base = 0;
        for (int j = 0; j < e; ++j) base += (cnt[j] + 255u) & ~255u;
        const int slot = (int)base + topls[i];
        pos[i] = slot; ltok[slot] = (int)(i / TOPK); lw[slot] = topw[i];
    }
    for (size_t i = gt; i < (size_t)NE * 256; i += ngt) {
        const int e = (int)(i / 256), j = (int)(i % 256); unsigned base = 0;
        for (int q = 0; q < e; ++q) base += (cnt[q] + 255u) & ~255u;
        const unsigned n = cnt[e], np = (n + 255u) & ~255u;
        if (n + j < np) { ltok[base + n + j] = 0; lw[base + n + j] = 0.f; }
    }
    if (gt == 0) { unsigned base = 0; for (int e = 0; e < NE; ++e) { basew[e] = base; base += (cnt[e] + 255u) & ~255u; } basew[NE] = base; }
    { int* tile_e = (int*)(p.ws + 5 * MiB);
      for (size_t i = gt; i < (size_t)(NSLOT / 256); i += ngt) { unsigned base = 0; int e = -1;
          for (int q = 0; q < NE; ++q) { const unsigned nb = base + ((cnt[q] + 255u) & ~255u); if ((unsigned)i * 256u >= base && (unsigned)i * 256u < nb) e = q; base = nb; }
          tile_e[i] = e; }
      for (size_t i = gt; i < (size_t)M_; i += ngt) { ltok[NSLOT + i] = (int)i; lw[NSLOT + i] = 1.f; } }
}
__device__ __forceinline__ int slot_expert(const unsigned* basew, int slot) { int e = 0; while (e < NE - 1 && (unsigned)slot >= basew[e + 1]) ++e; return e; }
__device__ __forceinline__ void nv_gu(const P& p, size_t gt, size_t ngt) {
    const unsigned* basew = WSP(unsigned, WS_CTL) + CW_BASE; const int* ltok = WSP(int, WS_LTOK); const float* lw = WSP(float, WS_LW);
    const bf16_t* h2 = WSP(bf16_t, WS_H2); bf16_t* hid = WSP(bf16_t, WS_HID); bf16_t* hsh = WSP(bf16_t, WS_HSH);
    const int nslot = (int)basew[NE];
    const size_t t1 = (size_t)(nslot / 4) * EFF, t2 = (size_t)(M_ / 4) * 256;
    for (size_t i = gt; i < t1 + t2; i += ngt) {
        float g[4], u[4];
        if (i < t1) { const int j = (int)(i % EFF), sl = (int)(i / EFF) * 4; const int e = slot_expert(basew, sl);
            const bf16_t* a0 = h2 + (size_t)ltok[sl] * D_; const bf16_t* a1 = h2 + (size_t)ltok[sl + 1] * D_; const bf16_t* a2 = h2 + (size_t)ltok[sl + 2] * D_; const bf16_t* a3 = h2 + (size_t)ltok[sl + 3] * D_;
            const float* W = p.w_exp_gu + (size_t)e * D_ * 512;
            ndot4(g, a0, a1, a2, a3, p.g_moe, W + j, 512, D_); ndot4(u, a0, a1, a2, a3, p.g_moe, W + 256 + j, 512, D_);
#pragma unroll
            for (int r = 0; r < 4; ++r) hid[(size_t)(sl + r) * EFF + j] = f2bf(g[r] * sigmoidf_(g[r]) * u[r] * lw[sl + r]);
        } else { const size_t q = i - t1; const int j = (int)(q % 256), m = (int)(q / 256) * 4; const bf16_t* a = h2 + (size_t)m * D_;
            ndot4(g, a, a + D_, a + 2 * D_, a + 3 * D_, p.g_moe, p.w_sh_gu + j, 512, D_); ndot4(u, a, a + D_, a + 2 * D_, a + 3 * D_, p.g_moe, p.w_sh_gu + 256 + j, 512, D_);
#pragma unroll
            for (int r = 0; r < 4; ++r) hsh[(size_t)(m + r) * 256 + j] = f2bf(g[r] * sigmoidf_(g[r]) * u[r]);
        }
    }
}
__device__ __forceinline__ void nv_down(const P& p, size_t gt, size_t ngt) {
    const unsigned* basew = WSP(unsigned, WS_CTL) + CW_BASE;
    const bf16_t* hid = WSP(bf16_t, WS_HID); const bf16_t* hsh = WSP(bf16_t, WS_HSH); bf16_t* Y = WSP(bf16_t, WS_Y);
    const int nslot = (int)basew[NE];
    const size_t t1 = (size_t)(nslot / 4) * D_, t2 = (size_t)(M_ / 4) * D_;
    for (size_t i = gt; i < t1 + t2; i += ngt) {
        float a[4];
        if (i < t1) { const int n = (int)(i % D_), sl = (int)(i / D_) * 4; const int e = slot_expert(basew, sl); const bf16_t* r0 = hid + (size_t)sl * EFF;
            ndot4(a, r0, r0 + EFF, r0 + 2 * EFF, r0 + 3 * EFF, nullptr, p.w_exp_down + (size_t)e * EFF * D_ + n, D_, EFF);
#pragma unroll
            for (int r = 0; r < 4; ++r) Y[(size_t)(sl + r) * D_ + n] = f2bf(a[r]);
        } else { const size_t q = i - t1; const int n = (int)(q % D_), m = (int)(q / D_) * 4; const bf16_t* r0 = hsh + (size_t)m * 256;
            ndot4(a, r0, r0 + 256, r0 + 512, r0 + 768, nullptr, p.w_sh_down + n, D_, 256);
#pragma unroll
            for (int r = 0; r < 4; ++r) p.out[(size_t)(m + r) * D_ + n] += a[r];
        }
    }
}
__device__ __forceinline__ void st_combine(const P& p, int gw, int ngw, int lane) {
    const int* pos = WSP(int, WS_POS); const bf16_t* Y = WSP(bf16_t, WS_Y); bf16_t* h3 = WSP(bf16_t, WS_H3);
    for (int m = gw; m < M_; m += ngw) {
        float* xr = p.out + (size_t)m * D_; float v[16]; float s = 0.f;
#pragma unroll
        for (int j = 0; j < 16; ++j) v[j] = xr[lane + 64 * j];
        for (int k = 0; k < TOPK; ++k) { const bf16_t* yr = Y + (size_t)pos[m * TOPK + k] * D_;
#pragma unroll
            for (int j = 0; j < 16; ++j) v[j] += bf2f(yr[lane + 64 * j]); }
#pragma unroll
        for (int j = 0; j < 16; ++j) { s += v[j] * v[j]; xr[lane + 64 * j] = v[j]; }
        s = wave_sum(s); const float r = 1.f / sqrtf(s * (1.f / D_) + EPS);
#pragma unroll
        for (int j = 0; j < 16; ++j) h3[(size_t)m * D_ + lane + 64 * j] = f2bf(v[j] * r);
    }
}
__device__ __forceinline__ void nv_ple(const P& p, size_t gt, size_t ngt) {
    const bf16_t* h3 = WSP(bf16_t, WS_H3); const bf16_t* pb = WSP(bf16_t, WS_PB);
    const size_t total = (size_t)(M_ / 4) * D_;
    for (size_t i = gt; i < total; i += ngt) {
        const int n = (int)(i % D_), m = (int)(i / D_) * 4; float a[4], c[4];
        const bf16_t* r0 = h3 + (size_t)m * D_; ndot4(a, r0, r0 + D_, r0 + 2 * D_, r0 + 3 * D_, p.g_ple, p.w_ple_gate + n, D_, D_);
        const bf16_t* r1 = pb + (size_t)m * 256; ndot4(c, r1, r1 + 256, r1 + 512, r1 + 768, nullptr, p.w_ple_proj + n, D_, 256);
#pragma unroll
        for (int r = 0; r < 4; ++r) p.out[(size_t)(m + r) * D_ + n] += sigmoidf_(a[r] + p.b_ple[n]) * c[r];
    }
}


#define LAS __attribute__((address_space(3)))
#define XB_TMO      128
#define XB_XCNT(j)  (256  + 64 * (j))
#define XB_XSUB(j)  (1280 + 64 * (j))
#define XB_XGEN(j)  (2304 + 64 * (j))
#define XB_TOP      3328
#define XB_TOPGEN   3392
#define XCD_BAR_WORDS 3456
#define XB_SPIN_CAP (1u << 18)
__device__ __forceinline__ unsigned xb_ld(unsigned* p)              { return __hip_atomic_load(p, __ATOMIC_RELAXED, __HIP_MEMORY_SCOPE_AGENT); }
__device__ __forceinline__ unsigned xb_add(unsigned* p, unsigned v) { return __hip_atomic_fetch_add(p, v, __ATOMIC_RELAXED, __HIP_MEMORY_SCOPE_AGENT); }
__device__ __forceinline__ unsigned xb_xcc_id() { return (unsigned)__builtin_amdgcn_s_getreg((3 << 11) | 20) & 0xFu; }
#define XB_SPIN(cond, bar) do { unsigned _sp = 0; while (cond) { __builtin_amdgcn_s_sleep(1); \
    if ((++_sp & 255u) == 0u) { if (xb_ld(&(bar)[XB_TMO])) break; if (_sp > XB_SPIN_CAP) { atomicAdd(&(bar)[XB_TMO], 1u); break; } } } } while (0)
struct XcdBarrier { unsigned* bar; unsigned x; volatile LAS unsigned* st; };
__device__ __forceinline__ XcdBarrier xcd_barrier_post(unsigned* bar, volatile LAS unsigned* st) {
    XcdBarrier b; b.bar = bar; b.x = xb_xcc_id(); b.st = st;
    if (threadIdx.x == 0) (void)xb_add(&bar[XB_XCNT(b.x)], 1u);
    return b;
}
__device__ __forceinline__ void xcd_barrier_complete(unsigned* bar, unsigned x, unsigned& nloc, unsigned& nx) {
    const unsigned G = gridDim.x * gridDim.y * gridDim.z;
    unsigned sum, cnt, mine, sp = 0u;
    for (;;) {
        sum = 0u; cnt = 0u; mine = 0u;
#pragma unroll
        for (unsigned j = 0; j < 16; ++j) { const unsigned c = xb_ld(&bar[XB_XCNT(j)]); sum += c; cnt += (c > 0u) ? 1u : 0u; mine = (j == x) ? c : mine; }
        if (sum == G) break;
        __builtin_amdgcn_s_sleep(1);
        if ((++sp & 255u) == 0u) { if (xb_ld(&bar[XB_TMO])) break; if (sp > XB_SPIN_CAP) { atomicAdd(&bar[XB_TMO], 1u); break; } }
    }
    nloc = mine > 0u ? mine : 1u; nx = cnt > 0u ? cnt : 1u;
}
__device__ __forceinline__ void xcd_barrier(const XcdBarrier& b) {
    asm volatile("s_waitcnt vmcnt(0)" ::: "memory");
    __syncthreads();
    if (threadIdx.x == 0) {
        unsigned* bar = b.bar;
        __builtin_amdgcn_s_waitcnt(0);
        unsigned nloc = b.st[0], nx = b.st[1];
        if (nloc == 0u) { xcd_barrier_complete(bar, b.x, nloc, nx); b.st[0] = nloc; b.st[1] = nx; }
        const unsigned old = xb_add(&bar[XB_XSUB(b.x)], 1u);
        const unsigned gen = old / nloc;
        if (old + 1u == (gen + 1u) * nloc) {
            __builtin_amdgcn_fence(__ATOMIC_RELEASE, "agent");
            asm volatile("s_waitcnt vmcnt(0)" ::: "memory");
            const unsigned og = xb_add(&bar[XB_TOP], 1u);
            const unsigned tg = og / nx;
            if (og + 1u == (tg + 1u) * nx) xb_add(&bar[XB_TOPGEN], 1u);
            else XB_SPIN(xb_ld(&bar[XB_TOPGEN]) == tg, bar);
            __builtin_amdgcn_fence(__ATOMIC_ACQUIRE, "agent");
            xb_add(&bar[XB_XGEN(b.x)], 1u);
            asm volatile("s_waitcnt vmcnt(0)" ::: "memory");
        } else {
            XB_SPIN(xb_ld(&bar[XB_XGEN(b.x)]) == gen, bar);
            __builtin_amdgcn_fence(__ATOMIC_ACQUIRE, "agent");
            asm volatile("s_waitcnt vmcnt(0)" ::: "memory");
        }
    }
    __syncthreads();
}
constexpr int CW_BAR = 4096;

namespace pg8 {
typedef short bf16x8 __attribute__((ext_vector_type(8)));
typedef float f32x4 __attribute__((ext_vector_type(4)));
typedef unsigned u32x4 __attribute__((ext_vector_type(4)));
typedef unsigned u32x2 __attribute__((ext_vector_type(2)));
constexpr int BM = 256, BK = 64, HALF = 128, HTB = HALF * BK * 2, STAGE_BYTES = 8 * HTB, NXCD = 8, WGM = 8;
__host__ __device__ __forceinline__ int lds_byte(int r, int c) { const int st = (r >> 4) * 2 + (c >> 5), rr = r & 15, cc = c & 31, ob = rr * 64 + cc * 2; return st * 1024 + (ob ^ (((ob >> 9) & 1) << 5)); }
__host__ __device__ __forceinline__ void stage_rc(int b, int& R, int& C) { const int st = b / 1024, sb = b % 1024, swz = sb ^ (((sb >> 9) & 1) << 5); R = (st >> 1) * 16 + swz / 64; C = (st & 1) * 32 + (swz % 64) / 2; }
__host__ __device__ __forceinline__ int perm32(int rho) { const int n = rho >> 4, i = rho & 15; return 8 * (i >> 2) + 4 * n + (i & 3); }
__device__ __forceinline__ unsigned cvt_pk_bf16(float lo, float hi) { unsigned r; asm volatile("v_cvt_pk_bf16_f32 %0, %1, %2" : "=v"(r) : "v"(lo), "v"(hi)); return r; }

struct Unit { int pm, pn; const char* Ab; const char* Bb; int aux; };

struct DenseSched {
    const char* A; const char* Bt; size_t astep, bstep;
    int nM, nN, nwg, G, c;
    __device__ __forceinline__ void init(const void* A_, int lda, const void* Bt_, int ldb, int M, int N, int G_, int c_) {
        A = (const char*)A_; Bt = (const char*)Bt_; astep = (size_t)BM * lda * 2; bstep = (size_t)BM * ldb * 2; nM = M / BM; nN = N / BM; nwg = nM * nN; G = G_; c = c_; }
    __device__ __forceinline__ bool next(int i, Unit& u) const {
        const long L = (long)i * G + c; if (L >= nwg) return false;
        int wgid = (int)L; { const int q = nwg / NXCD, r = nwg % NXCD, xcd = wgid % NXCD, off = wgid / NXCD; wgid = (xcd < r ? xcd * (q + 1) : r * (q + 1) + (xcd - r) * q) + off; }
        const int nig = WGM * nN, gid = wgid / nig, fm = gid * WGM, gsz = (nM - fm) < WGM ? (nM - fm) : WGM;
        u.pm = fm + ((wgid % nig) % gsz); u.pn = (wgid % nig) / gsz; u.Ab = A + (size_t)u.pm * astep; u.Bb = Bt + (size_t)u.pn * bstep; u.aux = 0; return true;
    }
    __device__ __forceinline__ int row(const Unit&, int) const { return 0; }
};

template <class Epi, class Sched, bool GATHER>
__device__ __forceinline__ void gemm_phase(LAS unsigned char* lds, const int K, const int lda, const int ldb, const Sched& S, const Epi& E) {
    int tid = threadIdx.x; asm volatile("" : "+v"(tid));
    const int wid = __builtin_amdgcn_readfirstlane(tid >> 6), lane = tid & 63, wr = wid >> 2, wc = wid & 3, fr = lane & 15, fq = lane >> 4;
    const int nt = K / BK;
    unsigned voffB[2];
#pragma unroll
    for (int i = 0; i < 2; ++i) { int R, C; stage_rc(tid * 16 + i * 8192, R, C); const int Rb = Epi::PERM ? ((R & ~31) + perm32(R & 31)) : R;
        voffB[i] = (unsigned)(Rb * ldb + C) * 2u; }
    const size_t kstep = (size_t)(BK * 2);
    const size_t hstepB = (size_t)HALF * ldb * 2;
    const size_t hstepA = GATHER ? 0 : (size_t)HALF * lda * 2;
    const unsigned ldsw = (unsigned)wid * 1024u;
    const int aoff = lds_byte(wr * 64 + fr, fq * 8), boff = lds_byte(wc * 32 + fr, fq * 8);
#define PG8_SA(b, h) (((b) * 2 + (h)) * HTB)
#define PG8_SB(b, h) ((4 + (b) * 2 + (h)) * HTB)
#define PG8_STAGE(bufoff, gbase, v0, v1) do { \
        __builtin_amdgcn_global_load_lds((const unsigned*)((const char*)(gbase) + (v0)), (LAS unsigned*)(lds + (bufoff) + ldsw), 16, 0, 0); \
        __builtin_amdgcn_global_load_lds((const unsigned*)((const char*)(gbase) + (v1)), (LAS unsigned*)(lds + (bufoff) + ldsw + 8192), 16, 0, 0); } while (0)
#define PG8_STAGEB(bufoff, gbase) PG8_STAGE(bufoff, gbase, voffB[0], voffB[1])
#define PG8_LDA(dst, b, h) do { _Pragma("unroll") for (int m = 0; m < 4; ++m) _Pragma("unroll") for (int k = 0; k < 2; ++k) dst[m][k] = *(const LAS bf16x8*)(lds + PG8_SA(b, h) + aoff + m * 2048 + k * 1024); } while (0)
#define PG8_LDB(dst, b, h) do { _Pragma("unroll") for (int n = 0; n < 2; ++n) _Pragma("unroll") for (int k = 0; k < 2; ++k) dst[n][k] = *(const LAS bf16x8*)(lds + PG8_SB(b, h) + boff + n * 2048 + k * 1024); } while (0)
#define PG8_MMA(ai, bj, At, Bt) do { __builtin_amdgcn_s_setprio(1); _Pragma("unroll") for (int m = 0; m < 4; ++m) _Pragma("unroll") for (int n = 0; n < 2; ++n) _Pragma("unroll") for (int k = 0; k < 2; ++k) \
        acc[ai][bj][m][n] = __builtin_amdgcn_mfma_f32_16x16x32_bf16(Bt[n][k], At[m][k], acc[ai][bj][m][n], 0, 0, 0); __builtin_amdgcn_s_setprio(0); } while (0)
#define PG8_WAIT_V(n) asm volatile("s_waitcnt vmcnt(" #n ")" ::: "memory")
#define PG8_WAIT_L(n) asm volatile("s_waitcnt lgkmcnt(" #n ")" ::: "memory")
#define PG8_BAR __builtin_amdgcn_s_barrier()
#define PG8_SCHED __builtin_amdgcn_sched_barrier(0)
#define PG8_AOFFS(U, o00, o01, o10, o11) do { int t_ = tid; asm volatile("" : "+v"(t_)); int R0_, C0_, R1_, C1_; stage_rc(t_ * 16, R0_, C0_); stage_rc(t_ * 16 + 8192, R1_, C1_); \
        if constexpr (GATHER) { o00 = (unsigned)(S.row(U, R0_) * lda + C0_) * 2u; o01 = (unsigned)(S.row(U, R1_) * lda + C1_) * 2u; \
                                o10 = (unsigned)(S.row(U, HALF + R0_) * lda + C0_) * 2u; o11 = (unsigned)(S.row(U, HALF + R1_) * lda + C1_) * 2u; } \
        else { o00 = (unsigned)(R0_ * lda + C0_) * 2u; o01 = (unsigned)(R1_ * lda + C1_) * 2u; o10 = o00; o11 = o01; } } while (0)
    Unit cur, nxt; int ui = 0;
    if (!S.next(0, cur)) return;
    unsigned vc00, vc01, vc10, vc11, vn00 = 0, vn01 = 0, vn10 = 0, vn11 = 0;
    PG8_AOFFS(cur, vc00, vc01, vc10, vc11);
    if constexpr (GATHER) { vn00 = vc00; vn01 = vc01; vn10 = vc10; vn11 = vc11; }
    f32x4 acc[2][2][4][2];
#pragma unroll
    for (int a = 0; a < 2; ++a)
#pragma unroll
        for (int b = 0; b < 2; ++b)
#pragma unroll
            for (int m = 0; m < 4; ++m)
#pragma unroll
                for (int n = 0; n < 2; ++n) acc[a][b][m][n] = (f32x4){0.f, 0.f, 0.f, 0.f};
    bf16x8 At[4][2], B0[2][2], B1[2][2];
    const char* cA = cur.Ab; const char* cB = cur.Bb;
    PG8_STAGEB(PG8_SB(0, 0), cB); PG8_STAGEB(PG8_SB(0, 1), cB + hstepB); PG8_STAGE(PG8_SA(0, 0), cA, vc00, vc01); PG8_STAGE(PG8_SA(0, 1), cA + hstepA, vc10, vc11);
    if (wr == 1) PG8_BAR;
    PG8_WAIT_V(2); PG8_BAR;
    PG8_STAGEB(PG8_SB(1, 0), cB + kstep); PG8_STAGE(PG8_SA(1, 0), cA + kstep, vc00, vc01); PG8_STAGEB(PG8_SB(1, 1), cB + hstepB + kstep);
    PG8_WAIT_V(6); PG8_BAR;
    for (;;) {
        const bool has_next = S.next(ui + 1, nxt);
        const char* nA = has_next ? nxt.Ab : cA; const char* nB = has_next ? nxt.Bb : cB;
        if constexpr (GATHER) {
            if (has_next) { PG8_AOFFS(nxt, vn00, vn01, vn10, vn11);
                asm volatile("" : "+v"(vn00), "+v"(vn01), "+v"(vn10), "+v"(vn11));
            } else { vn00 = vc00; vn01 = vc01; vn10 = vc10; vn11 = vc11; }
        }
        for (int t = 0; t < nt; t += 2) {
            const bool last = (t == nt - 2);
            const char* a1 = cA + (size_t)(t + 1) * kstep;
            const char* a2 = last ? nA : cA + (size_t)(t + 2) * kstep; const char* b2 = last ? nB : cB + (size_t)(t + 2) * kstep;
            const char* a3 = a2 + kstep; const char* b3 = b2 + kstep;
            unsigned w00 = vc00, w01 = vc01, w10 = vc10, w11 = vc11;
            if constexpr (GATHER) { if (last) { w00 = vn00; w01 = vn01; w10 = vn10; w11 = vn11; } }
            PG8_LDB(B0, 0, 0); PG8_LDB(B1, 0, 1); PG8_SCHED; PG8_LDA(At, 0, 0); PG8_STAGE(PG8_SA(1, 1), a1 + hstepA, vc10, vc11);
            PG8_WAIT_V(8); PG8_WAIT_L(0); PG8_BAR; PG8_MMA(0, 0, At, B0); PG8_MMA(0, 1, At, B1); PG8_BAR; PG8_SCHED;
            PG8_LDA(At, 0, 1); PG8_STAGEB(PG8_SB(0, 0), b2); PG8_STAGEB(PG8_SB(0, 1), b2 + hstepB); PG8_STAGE(PG8_SA(0, 0), a2, w00, w01);
            PG8_WAIT_V(8); PG8_WAIT_L(0); PG8_BAR; PG8_MMA(1, 0, At, B0); PG8_MMA(1, 1, At, B1); PG8_BAR; PG8_SCHED;
            PG8_LDB(B0, 1, 0); PG8_LDB(B1, 1, 1); PG8_SCHED; PG8_LDA(At, 1, 0); PG8_STAGE(PG8_SA(0, 1), a2 + hstepA, w10, w11);
            PG8_WAIT_V(8); PG8_WAIT_L(0); PG8_BAR; PG8_MMA(0, 0, At, B0); PG8_MMA(0, 1, At, B1); PG8_BAR; PG8_SCHED;
            PG8_LDA(At, 1, 1); PG8_STAGEB(PG8_SB(1, 0), b3); PG8_STAGEB(PG8_SB(1, 1), b3 + hstepB); PG8_STAGE(PG8_SA(1, 0), a3, w00, w01);
            PG8_WAIT_V(8); PG8_WAIT_L(0); PG8_BAR; PG8_MMA(1, 0, At, B0); PG8_MMA(1, 1, At, B1); PG8_BAR; PG8_SCHED;
        }
        if (wr == 0) PG8_BAR;
        { int te = tid; asm volatile("" : "+v"(te)); const int le = te & 63; E(acc, cur, wr, wc, le & 15, le >> 4); }
        if (!has_next) break;
#pragma unroll
        for (int a = 0; a < 2; ++a)
#pragma unroll
            for (int b = 0; b < 2; ++b)
#pragma unroll
                for (int m = 0; m < 4; ++m)
#pragma unroll
                    for (int n = 0; n < 2; ++n) acc[a][b][m][n] = (f32x4){0.f, 0.f, 0.f, 0.f};
        cur = nxt; cA = nA; cB = nB; ++ui;
        if constexpr (GATHER) { vc00 = vn00; vc01 = vn01; vc10 = vn10; vc11 = vn11; }
        if (wr == 1) PG8_BAR;
    }
    PG8_WAIT_V(0);
    PG8_BAR;
#undef PG8_SA
#undef PG8_SB
#undef PG8_STAGE
#undef PG8_STAGEB
#undef PG8_LDA
#undef PG8_LDB
#undef PG8_MMA
#undef PG8_WAIT_V
#undef PG8_WAIT_L
#undef PG8_BAR
#undef PG8_SCHED
#undef PG8_AOFFS
}

enum { EP_Z = 0, EP_BF16 = 1, EP_MG1 = 2, EP_MG2 = 3, EP_RES = 4, EP_HID = 5, EP_DOWN = 6, EP_PLE = 7 };
__device__ __forceinline__ float bfl(unsigned w) { return __uint_as_float(w << 16); }
__device__ __forceinline__ float bfh(unsigned w) { return __uint_as_float(w & 0xffff0000u); }
__device__ __forceinline__ float sigm(float v) { return __builtin_amdgcn_rcpf(1.f + __expf(-v)); }
template <int MODE> struct Epi {
    static constexpr bool PERM = !(MODE == EP_RES || MODE == EP_PLE);
    bf16_t* O; int ldc;
    const bf16_t* aux; int ldaux;
    const float* fin; float* fout;
    __device__ __forceinline__ void operator()(const f32x4 (&acc)[2][2][4][2], const Unit& u, int wr, int wc, int fr, int fq) const {
        const int row0 = u.pm * BM + wr * 64 + fr;
        if constexpr (MODE == EP_RES || MODE == EP_PLE) {
            const int col0 = u.pn * BM + wc * 32 + 4 * fq;
#pragma unroll
            for (int ai = 0; ai < 2; ++ai)
#pragma unroll
                for (int m = 0; m < 4; ++m) { const size_t r = (size_t)(row0 + ai * HALF + m * 16);
#pragma unroll
                    for (int bj = 0; bj < 2; ++bj)
#pragma unroll
                        for (int n = 0; n < 2; ++n) { const int c = col0 + bj * HALF + n * 16; const f32x4 a = acc[ai][bj][m][n];
                            if constexpr (MODE == EP_RES) { const f32x4 xv = *(const f32x4*)(fin + r * D_ + c); *(f32x4*)(fout + r * D_ + c) = xv + a; }
                            else { const f32x4 bv = *(const f32x4*)(fin + c); const u32x2 pw = *(const u32x2*)(aux + r * ldaux + c); f32x4 o = *(const f32x4*)(fout + r * D_ + c);
                                o[0] += sigm(a[0] + bv[0]) * bfl(pw.x); o[1] += sigm(a[1] + bv[1]) * bfh(pw.x); o[2] += sigm(a[2] + bv[2]) * bfl(pw.y); o[3] += sigm(a[3] + bv[3]) * bfh(pw.y);
                                *(f32x4*)(fout + r * D_ + c) = o; } }
                    asm volatile("" ::: "memory"); }
        } else if constexpr (MODE == EP_HID) {
            const int col0 = u.pn * HALF + wc * 32 + 8 * fq;
#pragma unroll
            for (int ai = 0; ai < 2; ++ai)
#pragma unroll
                for (int m = 0; m < 4; ++m) { const size_t r = (size_t)(row0 + ai * HALF + m * 16); const float w = fin[r];
                    const f32x4 g0 = acc[ai][0][m][0], g1 = acc[ai][0][m][1], u0 = acc[ai][1][m][0], u1 = acc[ai][1][m][1];
                    float h[8];
#pragma unroll
                    for (int j = 0; j < 4; ++j) { h[j] = g0[j] * sigm(g0[j]) * u0[j] * w; h[4 + j] = g1[j] * sigm(g1[j]) * u1[j] * w; }
                    u32x4 o; o.x = cvt_pk_bf16(h[0], h[1]); o.y = cvt_pk_bf16(h[2], h[3]); o.z = cvt_pk_bf16(h[4], h[5]); o.w = cvt_pk_bf16(h[6], h[7]);
                    *(u32x4*)(O + r * ldc + col0) = o; }
        } else {
            const int col0 = u.pn * BM + wc * 32 + 8 * fq;
            const bool act = (MODE == EP_Z) && (u.pn >= ZGA / BM);
            const bool shared = (MODE == EP_DOWN) && (u.aux >= NE);
#pragma unroll
            for (int ai = 0; ai < 2; ++ai)
#pragma unroll
                for (int m = 0; m < 4; ++m) { const size_t r = (size_t)(row0 + ai * HALF + m * 16);
#pragma unroll
                    for (int bj = 0; bj < 2; ++bj) { const int c = col0 + bj * HALF; f32x4 v0 = acc[ai][bj][m][0], v1 = acc[ai][bj][m][1];
                        if constexpr (MODE == EP_Z) { if (act) { const f32x4 b0 = *(const f32x4*)(fin + c - ZGA), b1 = *(const f32x4*)(fin + c - ZGA + 4);
#pragma unroll
                            for (int j = 0; j < 4; ++j) { v0[j] = sigm(v0[j] + b0[j]); v1[j] = sigm(v1[j] + b1[j]); } } }
                        if constexpr (MODE == EP_MG1 || MODE == EP_MG2) { const u32x4 gw = *(const u32x4*)(aux + r * ldaux + c);
                            v0[0] *= bfl(gw.x); v0[1] *= bfh(gw.x); v0[2] *= bfl(gw.y); v0[3] *= bfh(gw.y); v1[0] *= bfl(gw.z); v1[1] *= bfh(gw.z); v1[2] *= bfl(gw.w); v1[3] *= bfh(gw.w); }
                        if constexpr (MODE == EP_MG2) { const u32x4 ow = *(const u32x4*)(O + r * ldc + c);
                            v0[0] += bfl(ow.x); v0[1] += bfh(ow.x); v0[2] += bfl(ow.y); v0[3] += bfh(ow.y); v1[0] += bfl(ow.z); v1[1] += bfh(ow.z); v1[2] += bfl(ow.w); v1[3] += bfh(ow.w); }
                        if (shared) { float* op = fout + (r - NSLOT) * D_ + c; const f32x4 o0 = *(const f32x4*)op, o1 = *(const f32x4*)(op + 4); *(f32x4*)op = o0 + v0; *(f32x4*)(op + 4) = o1 + v1; }
                        else { u32x4 w; w.x = cvt_pk_bf16(v0[0], v0[1]); w.y = cvt_pk_bf16(v0[2], v0[3]); w.z = cvt_pk_bf16(v1[0], v1[1]); w.w = cvt_pk_bf16(v1[2], v1[3]);
                            *(u32x4*)(O + r * ldc + c) = w; } }
                    if constexpr (MODE == EP_DOWN || MODE == EP_MG1 || MODE == EP_MG2) asm volatile("" ::: "memory"); }
        }
    }
};
}

__device__ __forceinline__ unsigned pk2(float lo, float hi) { return (unsigned)f2bf(lo) | ((unsigned)f2bf(hi) << 16); }
__device__ __forceinline__ int zdst(int c) {
    if (c < 384) return c;
    if (c < 640) return ZCKV + (c - 384);
    if (c < 672) return ZKR + (c - 640);
    if (c < 1184) return ZQS + (c - 672);
    if (c < 1312) return ZKS + (c - 1184);
    if (c < 1440) return ZVS + (c - 1312);
    if (c < 2464) return ZGA + (c - 1440);
    return ZGB + (c - 2464);
}
__device__ __forceinline__ int gudst(int j) { const int half = j >> 8, jj = j & 255; return ((jj >> 7) << 8) + (half << 7) + (jj & 127); }
template <int MAP>
__device__ __forceinline__ void conv_item(const float* W, const float* g, int K, int N, bf16_t* WT, LAS float* scr, int item, int lane) {
    const int nblk = N / 32, kb = item / nblk, nb = item % nblk, k0 = 64 * kb, n0 = 32 * nb;
#pragma unroll 8
    for (int i = 0; i < 32; ++i) { const int kk = 2 * i + (lane >> 5); float v = W[(size_t)(k0 + kk) * N + n0 + (lane & 31)]; if (g) v *= g[k0 + kk]; scr[kk * 33 + (lane & 31)] = v; }
    asm volatile("s_waitcnt lgkmcnt(0)" ::: "memory");
    const int c = lane & 7; const int d0 = (MAP == 1) ? zdst(n0) : (MAP == 2) ? gudst(n0) : n0;
#pragma unroll
    for (int j = 0; j < 4; ++j) { const int n = (lane >> 3) + 8 * j; const LAS float* s = scr + (8 * c) * 33 + n;
        pg8::u32x4 o; o.x = pk2(s[0 * 33], s[1 * 33]); o.y = pk2(s[2 * 33], s[3 * 33]); o.z = pk2(s[4 * 33], s[5 * 33]); o.w = pk2(s[6 * 33], s[7 * 33]);
        *(pg8::u32x4*)(WT + (size_t)(d0 + n) * K + k0 + 8 * c) = o; }
    asm volatile("s_waitcnt lgkmcnt(0)" ::: "memory");
}
__device__ __forceinline__ void st_wconv(const P& p, int gw, int ngw, int lane, LAS float* scr) {
    constexpr int I0 = 16 * 109, I1 = 6 * 24, I2 = 4 * 32, I3 = 8 * 32, I4 = 8 * 32, I5 = 16 * 32, I6 = 16 * 32, I7 = 4 * 32, I8 = 16 * 16, I9 = 4 * 32, IGU = 16 * 16, IDN = 4 * 32;
    constexpr int NITEMS = I0 + I1 + I2 + I3 + I4 + I5 + I6 + I7 + I8 + I9 + 64 * IGU + 64 * IDN;
    for (int it = gw; it < NITEMS; it += ngw) {
        int r = it;
        if (r < I0) { conv_item<1>(p.w_in, p.g_mix, 1024, INW, WSP(bf16_t, WS_WIN), scr, r, lane); continue; } r -= I0;
        if (r < I1) { conv_item<0>(p.w_uq, p.g_cq, 384, 768, WSP(bf16_t, WS_WUQ), scr, r, lane); continue; } r -= I1;
        if (r < I2) { conv_item<0>(p.w_ukv, p.g_ckv, 256, 1024, WSP(bf16_t, WS_WUKV), scr, r, lane); continue; } r -= I2;
        if (r < I3) { conv_item<0>(p.w_br_mla, nullptr, 512, 1024, WSP(bf16_t, WS_WBRM), scr, r, lane); continue; } r -= I3;
        if (r < I4) { conv_item<0>(p.w_br_swa, nullptr, 512, 1024, WSP(bf16_t, WS_WBRS), scr, r, lane); continue; } r -= I4;
        if (r < I5) { conv_item<0>(p.w_out, nullptr, 1024, 1024, WSP(bf16_t, WS_WOUT), scr, r, lane); continue; } r -= I5;
        if (r < I6) { conv_item<0>(p.w_ple_gate, p.g_ple, 1024, 1024, WSP(bf16_t, WS_WPG), scr, r, lane); continue; } r -= I6;
        if (r < I7) { conv_item<0>(p.w_ple_proj, nullptr, 256, 1024, WSP(bf16_t, WS_WPP), scr, r, lane); continue; } r -= I7;
        if (r < I8) { conv_item<2>(p.w_sh_gu, p.g_moe, 1024, 512, WSP(bf16_t, WS_WGU) + (size_t)NE * 512 * 1024, scr, r, lane); continue; } r -= I8;
        if (r < I9) { conv_item<0>(p.w_sh_down, nullptr, 256, 1024, WSP(bf16_t, WS_WDN) + (size_t)NE * 1024 * 256, scr, r, lane); continue; } r -= I9;
        if (r < 64 * IGU) { const int e = r / IGU; conv_item<2>(p.w_exp_gu + (size_t)e * 1024 * 512, p.g_moe, 1024, 512, WSP(bf16_t, WS_WGU) + (size_t)e * 512 * 1024, scr, r % IGU, lane); continue; } r -= 64 * IGU;
        { const int e = r / IDN; conv_item<0>(p.w_exp_down + (size_t)e * 256 * 1024, nullptr, 256, 1024, WSP(bf16_t, WS_WDN) + (size_t)e * 1024 * 256, scr, r % IDN, lane); }
    }
    { unsigned* zp = (unsigned*)(WSP(bf16_t, WS_WIN) + (size_t)416 * 1024); const int n = 96 * 1024 / 2;
      for (int i = gw * 64 + lane; i < n; i += ngw * 64) zp[i] = 0u; }
}
__device__ __forceinline__ void fs_g1(const P& p, LAS unsigned char* lds) {
    pg8::DenseSched S; S.init(WSP(bf16_t, WS_HB), D_, WSP(bf16_t, WS_WIN), D_, M_, NZ, gridDim.x, blockIdx.x);
    pg8::Epi<pg8::EP_Z> E{WSP(bf16_t, WS_Z), NZ, nullptr, 0, p.b_gate, nullptr};
    pg8::gemm_phase<pg8::Epi<pg8::EP_Z>, pg8::DenseSched, false>(lds, D_, D_, D_, S, E);
}

struct MoeSched {
    const char* A; const char* Bt; size_t astep, bstep, estep; const int* tile_e; const int* ltok; int T, NPN, nwg, G, c; bool gather;
    __device__ __forceinline__ void init(const void* A_, int lda, const void* Bt_, int ldb, int ncols_e, const int* tile_e_, const int* ltok_, int T_, bool gather_, int G_, int c_) {
        A = (const char*)A_; Bt = (const char*)Bt_; astep = (size_t)256 * lda * 2; bstep = (size_t)256 * ldb * 2; estep = (size_t)ncols_e * ldb * 2; tile_e = tile_e_; ltok = ltok_;
        T = T_; NPN = ncols_e / 256; nwg = (T + M_ / 256) * NPN; G = G_; c = c_; gather = gather_; }
    __device__ __forceinline__ bool next(int i, pg8::Unit& u) const {
        const long L = (long)i * G + c; if (L >= nwg) return false;
        int wgid = (int)L; { const int q = nwg / 8, r = nwg % 8, xcd = wgid % 8, off = wgid / 8; wgid = (xcd < r ? xcd * (q + 1) : r * (q + 1) + (xcd - r) * q) + off; }
        const int j = wgid / NPN; u.pn = wgid % NPN;
        int e; if (j < T) { u.pm = j; e = __builtin_amdgcn_readfirstlane(tile_e[j]); } else { u.pm = NSLOT / 256 + (j - T); e = NE; }
        u.Ab = gather ? A : A + (size_t)u.pm * astep; u.Bb = Bt + (size_t)e * estep + (size_t)u.pn * bstep; u.aux = e; return true;
    }
    __device__ __forceinline__ int row(const pg8::Unit& u, int r) const { return ltok[u.pm * 256 + r]; }
};
constexpr size_t WS_TILEE = 5 * MiB;
__device__ __forceinline__ void fs_g23(const P& p, LAS unsigned char* lds) {
    { pg8::DenseSched S; S.init(WSP(bf16_t, WS_Z) + ZQ, NZ, WSP(bf16_t, WS_WUQ), 384, M_, 768, gridDim.x, blockIdx.x);
      pg8::Epi<pg8::EP_BF16> E{WSP(bf16_t, WS_QMR), 768, nullptr, 0, nullptr, nullptr};
      pg8::gemm_phase<pg8::Epi<pg8::EP_BF16>, pg8::DenseSched, false>(lds, 384, NZ, 384, S, E); }
    { pg8::DenseSched S; S.init(WSP(bf16_t, WS_Z) + ZCKV, NZ, WSP(bf16_t, WS_WUKV), 256, M_, 1024, gridDim.x, blockIdx.x);
      pg8::Epi<pg8::EP_BF16> E{WSP(bf16_t, WS_KVR), 1024, nullptr, 0, nullptr, nullptr};
      pg8::gemm_phase<pg8::Epi<pg8::EP_BF16>, pg8::DenseSched, false>(lds, 256, NZ, 256, S, E); }
}
__device__ __forceinline__ void fs_merge(const P& p, LAS unsigned char* lds) {
    { pg8::DenseSched S; S.init(WSP(bf16_t, WS_OM), 512, WSP(bf16_t, WS_WBRM), 512, M_, D_, gridDim.x, blockIdx.x);
      pg8::Epi<pg8::EP_MG1> E{WSP(bf16_t, WS_MG), D_, WSP(bf16_t, WS_Z) + ZGA, NZ, nullptr, nullptr};
      pg8::gemm_phase<pg8::Epi<pg8::EP_MG1>, pg8::DenseSched, false>(lds, 512, 512, 512, S, E); }
    { pg8::DenseSched S; S.init(WSP(bf16_t, WS_OW), 512, WSP(bf16_t, WS_WBRS), 512, M_, D_, gridDim.x, blockIdx.x);
      pg8::Epi<pg8::EP_MG2> E{WSP(bf16_t, WS_MG), D_, WSP(bf16_t, WS_Z) + ZGB, NZ, nullptr, nullptr};
      pg8::gemm_phase<pg8::Epi<pg8::EP_MG2>, pg8::DenseSched, false>(lds, 512, 512, 512, S, E); }
}
__device__ __forceinline__ void fs_out(const P& p, LAS unsigned char* lds) {
    pg8::DenseSched S; S.init(WSP(bf16_t, WS_MG), D_, WSP(bf16_t, WS_WOUT), D_, M_, D_, gridDim.x, blockIdx.x);
    pg8::Epi<pg8::EP_RES> E{nullptr, 0, nullptr, 0, p.x, p.out};
    pg8::gemm_phase<pg8::Epi<pg8::EP_RES>, pg8::DenseSched, false>(lds, D_, D_, D_, S, E);
}
__device__ __forceinline__ void fs_gu(const P& p, LAS unsigned char* lds) {
    const int T = __builtin_amdgcn_readfirstlane((int)(WSP(unsigned, WS_CTL)[CW_BASE + NE] / 256u));
    MoeSched S; S.init(WSP(bf16_t, WS_H2), D_, WSP(bf16_t, WS_WGU), D_, 512, WSP(int, WS_TILEE), WSP(int, WS_LTOK), T, true, gridDim.x, blockIdx.x);
    pg8::Epi<pg8::EP_HID> E{WSP(bf16_t, WS_HID), EFF, nullptr, 0, WSP(float, WS_LW), nullptr};
    pg8::gemm_phase<pg8::Epi<pg8::EP_HID>, MoeSched, true>(lds, D_, D_, D_, S, E);
}
__device__ __forceinline__ void fs_down(const P& p, LAS unsigned char* lds) {
    const int T = __builtin_amdgcn_readfirstlane((int)(WSP(unsigned, WS_CTL)[CW_BASE + NE] / 256u));
    MoeSched S; S.init(WSP(bf16_t, WS_HID), EFF, WSP(bf16_t, WS_WDN), EFF, 1024, WSP(int, WS_TILEE), WSP(int, WS_LTOK), T, false, gridDim.x, blockIdx.x);
    pg8::Epi<pg8::EP_DOWN> E{WSP(bf16_t, WS_Y), D_, nullptr, 0, nullptr, p.out};
    pg8::gemm_phase<pg8::Epi<pg8::EP_DOWN>, MoeSched, false>(lds, EFF, EFF, EFF, S, E);
}
__device__ __forceinline__ void fs_ple(const P& p, LAS unsigned char* lds) {
    { pg8::DenseSched S; S.init(WSP(bf16_t, WS_PB), 256, WSP(bf16_t, WS_WPP), 256, M_, D_, gridDim.x, blockIdx.x);
      pg8::Epi<pg8::EP_BF16> E{WSP(bf16_t, WS_PP), D_, nullptr, 0, nullptr, nullptr};
      pg8::gemm_phase<pg8::Epi<pg8::EP_BF16>, pg8::DenseSched, false>(lds, 256, 256, 256, S, E); }
    { pg8::DenseSched S; S.init(WSP(bf16_t, WS_H3), D_, WSP(bf16_t, WS_WPG), D_, M_, D_, gridDim.x, blockIdx.x);
      pg8::Epi<pg8::EP_PLE> E{nullptr, 0, WSP(bf16_t, WS_PP), D_, p.b_ple, p.out};
      pg8::gemm_phase<pg8::Epi<pg8::EP_PLE>, pg8::DenseSched, false>(lds, D_, D_, D_, S, E); }
}

namespace fa {
typedef short bf16x8 __attribute__((ext_vector_type(8)));
typedef short s16x4 __attribute__((ext_vector_type(4)));
typedef float f32x16 __attribute__((ext_vector_type(16)));
typedef unsigned u32x4 __attribute__((ext_vector_type(4)));
typedef unsigned u32x2 __attribute__((ext_vector_type(2)));
__device__ __forceinline__ unsigned cvtpk(float lo, float hi) { unsigned r; asm volatile("v_cvt_pk_bf16_f32 %0, %1, %2" : "=v"(r) : "v"(lo), "v"(hi)); return r; }
__device__ __forceinline__ int crow(int r, int hi) { return (r & 3) + 8 * (r >> 2) + 4 * hi; }

template <int DK, bool SWA>
__device__ __forceinline__ void attn_unit(const P& p, LAS unsigned char* lds, const int b, const int h, const int qb) {
    constexpr int PK = DK * 2 + 16, PV = 136, KBYTES = 64 * PK, BUF = KBYTES + 64 * PV, KS = DK / 16, CPR = DK / 8;
    int tid = threadIdx.x; asm volatile("" : "+v"(tid));
    const int lane = tid & 63, wave = __builtin_amdgcn_readfirstlane(tid >> 6), r32 = lane & 31, hi = lane >> 5;
    const int q0w = qb * 256 + wave * 32;
    const bf16_t* Qg = (SWA ? WSP(bf16_t, WS_QS) : WSP(bf16_t, WS_QM)) + ((size_t)(b * 8 + h) * S_ + q0w + r32) * DK;
    const int kvh = SWA ? (b * 2 + h / 4) : (b * 8 + h);
    const bf16_t* Kg = (SWA ? WSP(bf16_t, WS_KS) : WSP(bf16_t, WS_KM)) + (size_t)kvh * S_ * DK;
    const bf16_t* Vg = (SWA ? WSP(bf16_t, WS_VTS) : WSP(bf16_t, WS_VTM)) + (size_t)kvh * 64 * S_;
    bf16x8 qf[KS];
#pragma unroll
    for (int s = 0; s < KS; ++s) qf[s] = *(const bf16x8*)(Qg + 16 * s + 8 * hi);
    int t0 = 0, t1 = S_ / 64;
    if (SWA) { const int kmin = max(0, qb * 256 - 128), kmax = min(S_ - 1, qb * 256 + 255 + 128); t0 = kmin / 64; t1 = kmax / 64 + 1; }
    const int wk0 = q0w - 128, wk1 = q0w + 31 + 128;
    const int qpos = q0w + r32;
    const int kc0 = tid, kc1 = 512 + tid;
    const bool k1on = (64 * CPR > 512) && (tid < 64 * CPR - 512);
    const unsigned kd0 = (unsigned)((kc0 / CPR) * PK + (kc0 % CPR) * 16), kd1 = (unsigned)((kc1 / CPR) * PK + (kc1 % CPR) * 16);
    const int vd = tid >> 3, vp = tid & 7;
    const unsigned vdst = (unsigned)(KBYTES + vd * PV + vp * 16);
    u32x4 sk0, sk1 = {0u, 0u, 0u, 0u}, sv;
#define FA_LOAD(t) do { const int k0_ = (t) * 64; sk0 = *(const u32x4*)(Kg + (size_t)k0_ * DK + kc0 * 8); if (k1on) sk1 = *(const u32x4*)(Kg + (size_t)k0_ * DK + kc1 * 8); \
        sv = *(const u32x4*)(Vg + (size_t)vd * S_ + k0_ + vp * 8); } while (0)
#define FA_WRITE(bufo) do { *(LAS u32x4*)(lds + (bufo) + kd0) = sk0; if (k1on) *(LAS u32x4*)(lds + (bufo) + kd1) = sk1; \
        *(LAS u32x2*)(lds + (bufo) + vdst) = (u32x2){sv.x, sv.y}; *(LAS u32x2*)(lds + (bufo) + vdst + 8) = (u32x2){sv.z, sv.w}; } while (0)
    float m_run, l_run; f32x16 o0, o1;
#pragma unroll
    for (int r = 0; r < 16; ++r) { o0[r] = 0.f; o1[r] = 0.f; }
    if (SWA) { m_run = p.sink[h] * LOG2E; l_run = (hi == 0) ? 1.f : 0.f; } else { m_run = -1e30f; l_run = 0.f; }
    FA_LOAD(t0); FA_WRITE(0);
    __syncthreads();
    for (int t = t0; t < t1; ++t) {
        const int bufo = ((t - t0) & 1) * BUF, k0 = t * 64;
        if (t + 1 < t1) FA_LOAD(t + 1);
        const bool active = !SWA || !(k0 + 63 < wk0 || k0 > wk1);
        if (active) {
            f32x16 s0, s1;
#pragma unroll
            for (int r = 0; r < 16; ++r) { s0[r] = 0.f; s1[r] = 0.f; }
#pragma unroll
            for (int s = 0; s < KS; ++s) {
                const bf16x8 ka = *(const LAS bf16x8*)(lds + bufo + r32 * PK + 32 * s + 16 * hi);
                const bf16x8 kb = *(const LAS bf16x8*)(lds + bufo + (32 + r32) * PK + 32 * s + 16 * hi);
                s0 = __builtin_amdgcn_mfma_f32_32x32x16_bf16(ka, qf[s], s0, 0, 0, 0);
                s1 = __builtin_amdgcn_mfma_f32_32x32x16_bf16(kb, qf[s], s1, 0, 0, 0);
            }
            if (SWA) {
#pragma unroll
                for (int r = 0; r < 16; ++r) { const int d0 = k0 + crow(r, hi) - qpos, d1 = d0 + 32;
                    if (d0 > 128 || d0 < -128) s0[r] = -1e30f; if (d1 > 128 || d1 < -128) s1[r] = -1e30f; }
            }
            float mx = fmaxf(s0[0], s1[0]);
#pragma unroll
            for (int r = 1; r < 16; ++r) mx = fmaxf(mx, fmaxf(s0[r], s1[r]));
            mx = fmaxf(mx, __shfl_xor(mx, 32));
            const float mn = fmaxf(m_run, mx), al = exp2f(m_run - mn); m_run = mn;
            float ls = 0.f;
#pragma unroll
            for (int r = 0; r < 16; ++r) { s0[r] = exp2f(s0[r] - mn); s1[r] = exp2f(s1[r] - mn); ls += s0[r] + s1[r]; }
            l_run = l_run * al + ls;
#pragma unroll
            for (int r = 0; r < 16; ++r) { o0[r] *= al; o1[r] *= al; }
#pragma unroll
            for (int kb = 0; kb < 2; ++kb)
#pragma unroll
                for (int s2 = 0; s2 < 2; ++s2) {
                    u32x4 pw;
                    if (kb == 0) { pw.x = cvtpk(s0[8 * s2 + 0], s0[8 * s2 + 1]); pw.y = cvtpk(s0[8 * s2 + 2], s0[8 * s2 + 3]); pw.z = cvtpk(s0[8 * s2 + 4], s0[8 * s2 + 5]); pw.w = cvtpk(s0[8 * s2 + 6], s0[8 * s2 + 7]); }
                    else         { pw.x = cvtpk(s1[8 * s2 + 0], s1[8 * s2 + 1]); pw.y = cvtpk(s1[8 * s2 + 2], s1[8 * s2 + 3]); pw.z = cvtpk(s1[8 * s2 + 4], s1[8 * s2 + 5]); pw.w = cvtpk(s1[8 * s2 + 6], s1[8 * s2 + 7]); }
                    const bf16x8 pf = __builtin_bit_cast(bf16x8, pw);
                    const unsigned vo = (unsigned)(bufo + KBYTES + r32 * PV + (32 * kb + 16 * s2 + 4 * hi) * 2);
                    const s16x4 a0 = *(const LAS s16x4*)(lds + vo), a1 = *(const LAS s16x4*)(lds + vo + 16);
                    const s16x4 c0 = *(const LAS s16x4*)(lds + vo + 32 * PV), c1 = *(const LAS s16x4*)(lds + vo + 32 * PV + 16);
                    const bf16x8 va = (bf16x8){a0[0], a0[1], a0[2], a0[3], a1[0], a1[1], a1[2], a1[3]};
                    const bf16x8 vc = (bf16x8){c0[0], c0[1], c0[2], c0[3], c1[0], c1[1], c1[2], c1[3]};
                    o0 = __builtin_amdgcn_mfma_f32_32x32x16_bf16(va, pf, o0, 0, 0, 0);
                    o1 = __builtin_amdgcn_mfma_f32_32x32x16_bf16(vc, pf, o1, 0, 0, 0);
                }
        }
        if (t + 1 < t1) FA_WRITE(BUF - bufo);
        __syncthreads();
    }
#undef FA_LOAD
#undef FA_WRITE
    const float lt = l_run + __shfl_xor(l_run, 32); const float il = 1.f / lt;
    bf16_t* Og = (SWA ? WSP(bf16_t, WS_OW) : WSP(bf16_t, WS_OM)) + (size_t)(b * S_ + qpos) * 512 + h * 64;
#pragma unroll
    for (int g = 0; g < 4; ++g) {
        u32x2 w0, w1;
        w0.x = cvtpk(o0[4 * g + 0] * il, o0[4 * g + 1] * il); w0.y = cvtpk(o0[4 * g + 2] * il, o0[4 * g + 3] * il);
        w1.x = cvtpk(o1[4 * g + 0] * il, o1[4 * g + 1] * il); w1.y = cvtpk(o1[4 * g + 2] * il, o1[4 * g + 3] * il);
        *(u32x2*)(Og + 8 * g + 4 * hi) = w0; *(u32x2*)(Og + 32 + 8 * g + 4 * hi) = w1;
    }
}
}
__device__ __forceinline__ void fs_attn(const P& p, LAS unsigned char* lds) {
    const int G = gridDim.x, bx = blockIdx.x; const int vcu = (G % 8 == 0) ? (bx % 8) * (G / 8) + bx / 8 : bx;
    for (int U = vcu; U < 512; U += G) { const int bh = U >> 3, qb = U & 7; fa::attn_unit<96, false>(p, lds, bh >> 3, bh & 7, qb); }
    for (int U = vcu; U < 512; U += G) { const int bh = U >> 3, qb = U & 7; fa::attn_unit<64, true>(p, lds, bh >> 3, bh & 7, qb); }
}

#ifndef FAST_MASK
#define FAST_MASK 0xffff
#endif
constexpr int NT = 512;
constexpr int LDS_DYN = 144 * 1024;
constexpr int MISC_OFF = 132 * 1024;
constexpr int N_STAGES = 14;
__global__ void __launch_bounds__(NT) k_fwd(P p) {
    extern __shared__ __attribute__((aligned(16))) unsigned char lds[];
    const int tid0 = threadIdx.x;
    volatile LAS unsigned* misc = (volatile LAS unsigned*)((LAS unsigned char*)lds + MISC_OFF);
    if (tid0 < 16) misc[tid0] = 0u;
    __syncthreads();
    XcdBarrier bar = xcd_barrier_post(WSP(unsigned, WS_CTL) + CW_BAR, misc);
    const int lo = p.st_lo, hi = p.st_hi;
#define RUN(k, call) if (lo <= (k) && (k) < hi) { { int tid = tid0; asm volatile("" : "+v"(tid)); const int lane = tid & 63, wave = tid >> 6; const int wg = blockIdx.x, nwg = gridDim.x; \
        const int gw = wg * (NT / 64) + wave, ngw = nwg * (NT / 64); const size_t gt = (size_t)wg * NT + tid, ngt = (size_t)nwg * NT; \
        (void)lane; (void)wave; (void)wg; (void)nwg; (void)gw; (void)ngw; (void)gt; (void)ngt; call; } if ((k) + 1 < hi) xcd_barrier(bar); }
    RUN(0, (st_prep(p, gw, ngw, lane), st_wconv(p, gw, ngw, lane, (LAS float*)((LAS unsigned char*)lds + wave * 16384))))
#if FAST_MASK & 2
    RUN(1, fs_g1(p, (LAS unsigned char*)lds))
#else
    RUN(1, nv_g1(p, gt, ngt))
#endif
#if FAST_MASK & 4
    RUN(2, fs_g23(p, (LAS unsigned char*)lds))
#else
    RUN(2, nv_g23(p, gt, ngt))
#endif
    RUN(3, st_attn_prep(p, wg, nwg, wave, lane, (bf16_t*)lds))
#if FAST_MASK & 128
    RUN(4, fs_attn(p, (LAS unsigned char*)lds))
#else
    RUN(4, (nv_attn<96, false>(p, gt, ngt)))
    RUN(5, (nv_attn<64, true>(p, gt, ngt)))
#endif
#if FAST_MASK & 8
    RUN(6, fs_merge(p, (LAS unsigned char*)lds))
#else
    RUN(6, nv_merge(p, gt, ngt))
#endif
#if FAST_MASK & 8
    RUN(7, fs_out(p, (LAS unsigned char*)lds))
#else
    RUN(7, nv_out(p, gt, ngt))
#endif
    RUN(8, st_route(p, gw, ngw, lane, (float*)lds + wave * 1024))
    RUN(9, st_lists(p, gt, ngt))
#if FAST_MASK & 16
    RUN(10, fs_gu(p, (LAS unsigned char*)lds))
#else
    RUN(10, nv_gu(p, gt, ngt))
#endif
#if FAST_MASK & 32
    RUN(11, fs_down(p, (LAS unsigned char*)lds))
#else
    RUN(11, nv_down(p, gt, ngt))
#endif
    RUN(12, st_combine(p, gw, ngw, lane))
#if FAST_MASK & 64
    RUN(13, fs_ple(p, (LAS unsigned char*)lds))
#else
    RUN(13, nv_ple(p, gt, ngt))
#endif
#undef RUN
}

extern "C" void kernel_launch(void* const* d_in, const int* in_sizes, int n_in, void* d_out, int out_size, void* d_ws, size_t ws_size, hipStream_t stream) {
    if (n_in != 29 || ws_size < WS_END) { fprintf(stderr, "kernel_launch: unexpected n_in %d or ws_size %zu\n", n_in, ws_size); return; }
    P p{};
    p.x = (const float*)d_in[0]; p.p = (const float*)d_in[1]; p.pos = (const int*)d_in[2];
#define IN_(name, i) p.name = (const float*)d_in[i]
    IN_(g_mix, 3); IN_(w_in, 4); IN_(b_gate, 5); IN_(g_cq, 6); IN_(w_uq, 7); IN_(g_ckv, 8); IN_(w_ukv, 9); IN_(g_qn_mla, 10); IN_(g_kn_mla, 11);
    IN_(g_qn_swa, 12); IN_(g_kn_swa, 13); IN_(sink, 14); IN_(w_br_mla, 15); IN_(w_br_swa, 16); IN_(w_out, 17); IN_(g_moe, 18); IN_(w_router, 19);
    IN_(router_bias, 20); IN_(w_exp_gu, 21); IN_(w_exp_down, 22); IN_(w_sh_gu, 23); IN_(w_sh_down, 24); IN_(g_ple, 25); IN_(w_ple_gate, 26); IN_(b_ple, 27); IN_(w_ple_proj, 28);
#undef IN_
    p.out = (float*)d_out; p.ws = (unsigned char*)d_ws;
    static int grid = 0;
    if (grid == 0) {
        int dev = 0, cus = 0, per_cu = 0;
        (void)hipGetDevice(&dev); (void)hipDeviceGetAttribute(&cus, hipDeviceAttributeMultiprocessorCount, dev);
        (void)hipFuncSetAttribute((const void*)k_fwd, hipFuncAttributeMaxDynamicSharedMemorySize, LDS_DYN);
        (void)hipOccupancyMaxActiveBlocksPerMultiprocessor(&per_cu, (const void*)k_fwd, NT, LDS_DYN);
        (void)hipGetLastError();
        if (per_cu < 1) { fprintf(stderr, "kernel_launch: occupancy query says %d blocks per CU\n", per_cu); grid = -1; return; }
        grid = cus;
    }
    if (grid < 0) return;
    (void)hipMemsetAsync((char*)d_ws + WS_CTL, 0, CTL_BYTES, stream);
    p.st_lo = 0; p.st_hi = N_STAGES;
    void* args[] = {&p};
    hipError_t e = hipLaunchCooperativeKernel((const void*)k_fwd, dim3(grid), dim3(NT), args, LDS_DYN, stream);
    if (e != hipSuccess) fprintf(stderr, "cooperative launch failed: %s (grid %d)\n", hipGetErrorString(e), grid);
}
```

```cpp
#include <hip/hip_runtime.h>
#include <stdint.h>
#include <cstdio>

constexpr int B_ = 8, S_ = 2048, D_ = 1024, M_ = B_ * S_;
constexpr int NZ = 3584;
constexpr int INW = 3488;
constexpr int ZQ = 0, ZKR = 384, ZCKV = 512, ZQS = 768, ZKS = 1280, ZVS = 1408, ZGA = 1536, ZGB = 2560;
constexpr int NE = 64, TOPK = 8, EFF = 256;
constexpr int NSLOT = M_ * TOPK + NE * 256;
constexpr float EPS = 1e-6f;
constexpr float LOG2E = 1.4426950408889634f;

typedef unsigned short bf16_t;
__device__ __forceinline__ float bf2f(bf16_t v) { return __uint_as_float((unsigned)v << 16); }
__device__ __forceinline__ bf16_t f2bf(float f) { unsigned u = __float_as_uint(f); return (bf16_t)((u + 0x7fffu + ((u >> 16) & 1u)) >> 16); }
__device__ __forceinline__ float sigmoidf_(float v) { return 1.f / (1.f + __expf(-v)); }
__device__ __forceinline__ float wave_sum(float v) {
#pragma unroll
    for (int o = 1; o < 64; o <<= 1) v += __shfl_xor(v, o);
    return v;
}
__device__ __forceinline__ float wave_max(float v) {
#pragma unroll
    for (int o = 1; o < 64; o <<= 1) v = fmaxf(v, __shfl_xor(v, o));
    return v;
}

constexpr size_t MiB = 1u << 20;
constexpr size_t WS_CTL = 0, CTL_BYTES = 64 * 1024;
constexpr size_t WS_TOPE = 1 * MiB, WS_TOPW = WS_TOPE + 512 * 1024, WS_TOPLS = WS_TOPW + 512 * 1024, WS_POS = WS_TOPLS + 512 * 1024;
constexpr size_t WS_LTOK = 3 * MiB, WS_LW = WS_LTOK + 640 * 1024;
constexpr size_t WS_PB = 6 * MiB, WS_WDN = 14 * MiB, WS_WPG = 48 * MiB, WS_WPP = 50 * MiB, WS_WSHDN = 46 * MiB;
constexpr size_t WS_HID = 51 * MiB, WS_HSH = 123 * MiB, WS_R = 131 * MiB;
constexpr size_t WS_WGU = 131 * MiB, WS_WSHGU = 195 * MiB, WS_WIN = 196 * MiB, WS_WUQ = 203 * MiB, WS_WUKV = 204 * MiB, WS_WBRM = 205 * MiB, WS_WBRS = 206 * MiB, WS_WOUT = 207 * MiB;
constexpr size_t WS_Z = 210 * MiB, WS_HB = 322 * MiB, WS_MG = 322 * MiB, WS_QMR = 354 * MiB, WS_OM = 354 * MiB, WS_OW = 370 * MiB, WS_KVR = 378 * MiB;
constexpr size_t WS_QM = 410 * MiB, WS_KM = 434 * MiB, WS_VTM = 458 * MiB, WS_QS = 474 * MiB, WS_KS = 490 * MiB, WS_VTS = 494 * MiB;
constexpr size_t WS_H3F8 = 31 * MiB;
constexpr size_t WS_H2 = 210 * MiB, WS_Y = 131 * MiB, WS_H3 = 419 * MiB, WS_PP = 93 * MiB, WS_END = 498 * MiB;
constexpr size_t WS_WRH = 209 * MiB, WS_WRL = WS_WRH + 128 * 1024, WS_RSTD2 = WS_WRL + 128 * 1024;
constexpr size_t WS_LR = WS_LW + 640 * 1024;
constexpr size_t WS_INV3 = WS_TOPW;
constexpr size_t WS_WCNT = WS_RSTD2 + 64 * 1024;
constexpr size_t WS_TCNT = WS_WCNT + 512 * 1024;
constexpr int CW_CNT = 0;
constexpr int CW_BASE = 64;

struct P {
    const float *x, *p; const int* pos;
    const float *g_mix, *w_in, *b_gate, *g_cq, *w_uq, *g_ckv, *w_ukv, *g_qn_mla, *g_kn_mla, *g_qn_swa, *g_kn_swa, *sink;
    const float *w_br_mla, *w_br_swa, *w_out, *g_moe, *w_router, *router_bias, *w_exp_gu, *w_exp_down, *w_sh_gu, *w_sh_down;
    const float *g_ple, *w_ple_gate, *b_ple, *w_ple_proj;
    float* out; unsigned char* ws; int st_lo; int st_hi;
};
#define WSP(T, off) ((T*)(p.ws + (off)))
__device__ __forceinline__ int tid_of(int wv) { int l; asm volatile("v_mbcnt_lo_u32_b32 %0, -1, 0\n\tv_mbcnt_hi_u32_b32 %0, -1, %0" : "=v"(l)); return wv * 64 + l; }

typedef float f32x4_t __attribute__((ext_vector_type(4)));
typedef unsigned u32x2_t __attribute__((ext_vector_type(2)));
typedef unsigned u32x4_t __attribute__((ext_vector_type(4)));
__device__ __forceinline__ unsigned cvtpk_(float lo, float hi) { unsigned r; asm volatile("v_cvt_pk_bf16_f32 %0, %1, %2" : "=v"(r) : "v"(lo), "v"(hi)); return r; }
__device__ __forceinline__ float bflo(unsigned w) { return __uint_as_float(w << 16); }
__device__ __forceinline__ float bfhi(unsigned w) { return __uint_as_float(w & 0xffff0000u); }
__device__ __forceinline__ void st_prep(const P& p, int gw, int ngw, int lane) {
    bf16_t* hb = WSP(bf16_t, WS_HB); bf16_t* pb = WSP(bf16_t, WS_PB);
    f32x4_t nv[4], npv;
    if (gw < M_) { const f32x4_t* xr = (const f32x4_t*)(p.x + (size_t)gw * D_) + lane;
#pragma unroll
        for (int j = 0; j < 4; ++j) nv[j] = xr[64 * j];
        npv = ((const f32x4_t*)(p.p + (size_t)gw * 256))[lane]; }
    for (int m = gw; m < M_; m += ngw) {
        f32x4_t v[4]; const f32x4_t pv = npv; float s = 0.f;
#pragma unroll
        for (int j = 0; j < 4; ++j) v[j] = nv[j];
        if (m + ngw < M_) { const f32x4_t* xr = (const f32x4_t*)(p.x + (size_t)(m + ngw) * D_) + lane;
#pragma unroll
            for (int j = 0; j < 4; ++j) nv[j] = xr[64 * j];
            npv = ((const f32x4_t*)(p.p + (size_t)(m + ngw) * 256))[lane]; }
#pragma unroll
        for (int j = 0; j < 4; ++j) s += (v[j].x * v[j].x + v[j].y * v[j].y) + (v[j].z * v[j].z + v[j].w * v[j].w);
        s = wave_sum(s); const float r = 1.f / sqrtf(s * (1.f / D_) + EPS);
        u32x2_t* o = (u32x2_t*)(hb + (size_t)m * D_) + lane;
#pragma unroll
        for (int j = 0; j < 4; ++j) o[64 * j] = (u32x2_t){cvtpk_(v[j].x * r, v[j].y * r), cvtpk_(v[j].z * r, v[j].w * r)};
        ((u32x2_t*)(pb + (size_t)m * 256))[lane] = (u32x2_t){cvtpk_(pv.x, pv.y), cvtpk_(pv.z, pv.w)};
    }
}
constexpr size_t WS_CS = 51 * MiB;
__device__ __forceinline__ void st_rope(const P& p, size_t gt, size_t ngt) {
    float* cs = WSP(float, WS_CS);
    for (size_t i = gt; i < (size_t)M_ * 48; i += ngt) { const int m = (int)(i / 48), f = (int)(i % 48);
        const float posf = (float)p.pos[m]; float sv, cv;
        if (f < 16) { sincosf(posf * exp2f(-13.287712379549449f * (float)f * (1.f / 16.f)), &sv, &cv); cs[(size_t)m * 96 + f] = cv; cs[(size_t)m * 96 + 16 + f] = sv; }
        else { const int g = f - 16; sincosf(posf * exp2f(-13.287712379549449f * (float)g * (1.f / 32.f)), &sv, &cv); cs[(size_t)m * 96 + 32 + g] = cv; cs[(size_t)m * 96 + 64 + g] = sv; } }
}
constexpr int VT_PITCH = 72;
typedef float f32x2_t __attribute__((ext_vector_type(2)));
struct P8 { f32x2_t p[4]; };
__device__ __forceinline__ P8 cvp8(const u32x4_t w) { P8 r; r.p[0] = (f32x2_t){bflo(w.x), bfhi(w.x)}; r.p[1] = (f32x2_t){bflo(w.y), bfhi(w.y)}; r.p[2] = (f32x2_t){bflo(w.z), bfhi(w.z)}; r.p[3] = (f32x2_t){bflo(w.w), bfhi(w.w)}; return r; }
__device__ __forceinline__ P8 ldp8(const float* ptr) { const f32x4_t a = *(const f32x4_t*)ptr, b = *(const f32x4_t*)(ptr + 4); P8 r; r.p[0] = (f32x2_t){a.x, a.y}; r.p[1] = (f32x2_t){a.z, a.w}; r.p[2] = (f32x2_t){b.x, b.y}; r.p[3] = (f32x2_t){b.z, b.w}; return r; }
__device__ __forceinline__ P8 f4p8(const f32x4_t a, const f32x4_t b) { P8 r; r.p[0] = (f32x2_t){a.x, a.y}; r.p[1] = (f32x2_t){a.z, a.w}; r.p[2] = (f32x2_t){b.x, b.y}; r.p[3] = (f32x2_t){b.z, b.w}; return r; }
__device__ __forceinline__ void stp8(bf16_t* ptr, const P8& x) { u32x4_t w; w.x = cvtpk_(x.p[0].x, x.p[0].y); w.y = cvtpk_(x.p[1].x, x.p[1].y); w.z = cvtpk_(x.p[2].x, x.p[2].y); w.w = cvtpk_(x.p[3].x, x.p[3].y); *(u32x4_t*)ptr = w; }
__device__ __forceinline__ float ssqp(const P8& x) { f32x2_t a = x.p[0] * x.p[0]; a = x.p[1] * x.p[1] + a; a = x.p[2] * x.p[2] + a; a = x.p[3] * x.p[3] + a; return a.x + a.y; }
template <int CTRL> __device__ __forceinline__ float dppf(float v) { return __uint_as_float((unsigned)__builtin_amdgcn_update_dpp(0, (int)__float_as_uint(v), CTRL, 0xF, 0xF, true)); }
__device__ __forceinline__ float sum8_dpp(float v) { v += dppf<0x141>(v); v += dppf<0xB1>(v); v += dppf<0x4E>(v); return v; }
__device__ __forceinline__ float sum16_dpp(float v) { v += dppf<0x140>(v); return sum8_dpp(v); }
__device__ __forceinline__ float wave_sum_dpp(float v) { v = sum16_dpp(v);
    return __uint_as_float((unsigned)__builtin_amdgcn_readlane((int)__float_as_uint(v), 0)) + __uint_as_float((unsigned)__builtin_amdgcn_readlane((int)__float_as_uint(v), 16))
         + __uint_as_float((unsigned)__builtin_amdgcn_readlane((int)__float_as_uint(v), 32)) + __uint_as_float((unsigned)__builtin_amdgcn_readlane((int)__float_as_uint(v), 48)); }
template <int GL, int PX>
__device__ __forceinline__ void norm_rope(P8& x, bool valid, float pre, float inv_n, const P8& g, const P8& c, const P8& s) {
    float ss = valid ? pre * pre * ssqp(x) : 0.f;
    ss = (GL == 16) ? sum16_dpp(ss) : sum8_dpp(ss);
    const float r = pre * __builtin_amdgcn_rsqf(ss * inv_n + EPS);
    const f32x2_t rr = {r, r};
#pragma unroll
    for (int j = 0; j < 4; ++j) { x.p[j] *= rr * g.p[j];
        f32x2_t o;
        o.x = (PX == 2) ? dppf<0x4E>(x.p[j].x) : dppf<0x1B>(dppf<0x141>(x.p[j].x)); o.y = (PX == 2) ? dppf<0x4E>(x.p[j].y) : dppf<0x1B>(dppf<0x141>(x.p[j].y));
        x.p[j] = x.p[j] * c.p[j] + o * s.p[j]; }
}
__device__ __forceinline__ void st_attn_prep(const P& p, int wg, int nwg, int wave, int lane, bf16_t* lds) {
    const bf16_t* z = WSP(bf16_t, WS_Z); const bf16_t* qmr = WSP(bf16_t, WS_QMR); const bf16_t* kvr = WSP(bf16_t, WS_KVR); const float* cs = WSP(float, WS_CS);
    bf16_t* QM = WSP(bf16_t, WS_QM); bf16_t* KM = WSP(bf16_t, WS_KM); bf16_t* VTM = WSP(bf16_t, WS_VTM);
    bf16_t* QS = WSP(bf16_t, WS_QS); bf16_t* KS = WSP(bf16_t, WS_KS); bf16_t* VTS = WSP(bf16_t, WS_VTS);
    const float sc_m = 0.10206207261596575f * LOG2E;
    const float sc_s = 0.125f * LOG2E;
    const int c16 = lane & 15, h16 = lane >> 4, c8 = lane & 7, h8 = lane >> 3;
    const bool v12 = c16 < 12, rotm = (c16 >= 8) && v12;
    P8 gqm = ldp8(p.g_qn_mla + 8 * (v12 ? c16 : 0)), gqs = ldp8(p.g_qn_swa + 8 * c8);
    const P8 gkm = ldp8(p.g_kn_mla + 8 * (v12 ? c16 : 0)), gks = ldp8(p.g_kn_swa + 8 * c8);
#pragma unroll
    for (int j = 0; j < 4; ++j) { gqm.p[j] *= (f32x2_t){sc_m, sc_m}; gqs.p[j] *= (f32x2_t){sc_s, sc_s}; }
    const unsigned sgm = (c16 >= 10) ? 0u : 0x80000000u, sgs = (c8 >= 4) ? 0u : 0x80000000u;
    for (int tile = wg; tile < M_ / 64; tile += nwg) {
        __syncthreads();
        struct Raw { u32x4_t zq, zkv, qa, qb, ka, kb, vm, qs, ksv; f32x4_t cm0, cm1, sm0, sm1, cw0, cw1, sw0, sw1; };
        auto load_raw = [&](int m) { Raw r; const bf16_t* zr = z + (size_t)m * NZ; const bf16_t* qr = qmr + (size_t)m * 768; const bf16_t* kr = kvr + (size_t)m * 1024;
            r.zq = *(const u32x4_t*)(zr + ZQ + 8 * (lane < 48 ? lane : 0)); r.zkv = *(const u32x4_t*)(zr + ZCKV + 8 * (lane & 31));
            r.qa = *(const u32x4_t*)(qr + h16 * 96 + 8 * (c16 < 12 ? c16 : 0)); r.qb = *(const u32x4_t*)(qr + (4 + h16) * 96 + 8 * (c16 < 12 ? c16 : 0));
            r.ka = (c16 < 8) ? *(const u32x4_t*)(kr + h16 * 128 + 8 * c16) : *(const u32x4_t*)(zr + ZKR + 8 * (c16 & 3));
            r.kb = (c16 < 8) ? *(const u32x4_t*)(kr + (4 + h16) * 128 + 8 * c16) : *(const u32x4_t*)(zr + ZKR + 8 * (c16 & 3));
            r.vm = *(const u32x4_t*)(kr + h8 * 128 + 64 + 8 * c8); r.qs = *(const u32x4_t*)(zr + ZQS + 8 * lane); r.ksv = *(const u32x4_t*)(zr + ZKS + 8 * (lane & 31));
            const float* csr = cs + (size_t)m * 96; const float* cm = csr + 8 * (c16 & 1); const float* cw = csr + 32 + 8 * (c8 & 3);
            r.cm0 = *(const f32x4_t*)cm; r.cm1 = *(const f32x4_t*)(cm + 4); r.sm0 = *(const f32x4_t*)(cm + 16); r.sm1 = *(const f32x4_t*)(cm + 20);
            r.cw0 = *(const f32x4_t*)cw; r.cw1 = *(const f32x4_t*)(cw + 4); r.sw0 = *(const f32x4_t*)(cw + 32); r.sw1 = *(const f32x4_t*)(cw + 36);
            return r; };
        Raw nx = load_raw(tile * 64 + wave * 8);
        for (int tt = 0; tt < 8; ++tt) {
            const int tl = wave * 8 + tt, m = tile * 64 + tl, b = m / S_, s = m % S_;
            const int tls = tl ^ (8 * ((lane >> 1) & 7));
            const Raw cu = nx;
            if (tt < 7) nx = load_raw(m + 1);
            const P8 zq = cvp8(cu.zq), zkv = cvp8(cu.zkv); P8 qa = cvp8(cu.qa), qb = cvp8(cu.qb), ka = cvp8(cu.ka), kb = cvp8(cu.kb), vm = cvp8(cu.vm), qs = cvp8(cu.qs), ks = cvp8(cu.ksv);
            const float rq = __builtin_amdgcn_rsqf(wave_sum_dpp(lane < 48 ? ssqp(zq) : 0.f) * (1.f / 384.f) + EPS);
            const float rkv = __builtin_amdgcn_rsqf(wave_sum_dpp(lane < 32 ? ssqp(zkv) : 0.f) * (1.f / 256.f) + EPS);
            P8 cM = f4p8(cu.cm0, cu.cm1), sM = f4p8(cu.sm0, cu.sm1), cW = f4p8(cu.cw0, cu.cw1), sW = f4p8(cu.sw0, cu.sw1);
#pragma unroll
            for (int j = 0; j < 4; ++j) {
                cM.p[j].x = rotm ? cM.p[j].x : 1.f; cM.p[j].y = rotm ? cM.p[j].y : 1.f;
                sM.p[j].x = rotm ? __uint_as_float(__float_as_uint(sM.p[j].x) ^ sgm) : 0.f; sM.p[j].y = rotm ? __uint_as_float(__float_as_uint(sM.p[j].y) ^ sgm) : 0.f;
                sW.p[j].x = __uint_as_float(__float_as_uint(sW.p[j].x) ^ sgs); sW.p[j].y = __uint_as_float(__float_as_uint(sW.p[j].y) ^ sgs); }
            const float kpre = (c16 < 8) ? rkv : 1.f;
            norm_rope<16, 2>(qa, v12, rq, 1.f / 96.f, gqm, cM, sM);
            norm_rope<16, 2>(qb, v12, rq, 1.f / 96.f, gqm, cM, sM);
            norm_rope<16, 2>(ka, v12, kpre, 1.f / 96.f, gkm, cM, sM);
            norm_rope<16, 2>(kb, v12, kpre, 1.f / 96.f, gkm, cM, sM);
            if (v12) { stp8(QM + ((size_t)(b * 8 + h16) * S_ + s) * 96 + 8 * c16, qa); stp8(QM + ((size_t)(b * 8 + 4 + h16) * S_ + s) * 96 + 8 * c16, qb);
                       stp8(KM + ((size_t)(b * 8 + h16) * S_ + s) * 96 + 8 * c16, ka); stp8(KM + ((size_t)(b * 8 + 4 + h16) * S_ + s) * 96 + 8 * c16, kb); }
            { const f32x2_t rv = {rkv, rkv};
#pragma unroll
              for (int j = 0; j < 4; ++j) { const f32x2_t t = vm.p[j] * rv; const unsigned w = cvtpk_(t.x, t.y);
                  lds[(h8 * 64 + 8 * c8 + 2 * j) * VT_PITCH + tls] = (bf16_t)(w & 0xffffu); lds[(h8 * 64 + 8 * c8 + 2 * j + 1) * VT_PITCH + tls] = (bf16_t)(w >> 16); } }
            norm_rope<8, 4>(qs, true, 1.f, 1.f / 64.f, gqs, cW, sW);
            stp8(QS + ((size_t)(b * 8 + h8) * S_ + s) * 64 + 8 * c8, qs);
            norm_rope<8, 4>(ks, lane < 16, 1.f, 1.f / 64.f, gks, cW, sW);
            if (lane < 16) stp8(KS + ((size_t)(b * 2 + h8) * S_ + s) * 64 + 8 * c8, ks);
            else if (lane < 32) { const unsigned wv[4] = {cu.ksv.x, cu.ksv.y, cu.ksv.z, cu.ksv.w};
#pragma unroll
                for (int j = 0; j < 4; ++j) { lds[(512 + (h8 - 2) * 64 + 8 * c8 + 2 * j) * VT_PITCH + tls] = (bf16_t)(wv[j] & 0xffffu); lds[(512 + (h8 - 2) * 64 + 8 * c8 + 2 * j + 1) * VT_PITCH + tls] = (bf16_t)(wv[j] >> 16); } }
        }
        __syncthreads();
        const int b = (tile * 64) / S_, s0 = (tile * 64) % S_;
        int ln = lane; asm volatile("" : "+v"(ln));
        for (int r0 = wave * 8; r0 < 640; r0 += 64) { const int r = r0 + (ln >> 3), t8 = (ln & 7) * 8;
            const u32x4_t v = *(const u32x4_t*)(lds + r * VT_PITCH + (t8 ^ (8 * ((r >> 4) & 7))));
            if (r < 512) *(u32x4_t*)(VTM + ((size_t)(b * 8 + (r >> 6)) * 64 + (r & 63)) * S_ + s0 + t8) = v;
            else { const int rr = r - 512; *(u32x4_t*)(VTS + ((size_t)(b * 2 + (rr >> 6)) * 64 + (rr & 63)) * S_ + s0 + t8) = v; } }
    }
}

#define LAS __attribute__((address_space(3)))
#define XB_TMO      128
#define XB_XCNT(j)  (256  + 64 * (j))
#define XB_XSUB(j)  (1280 + 64 * (j))
#define XB_XGEN(j)  (2304 + 64 * (j))
#define XB_TOP      3328
#define XB_TOPGEN   3392
#define XCD_BAR_WORDS 3456
#define XB_SPIN_CAP (1u << 18)
__device__ __forceinline__ unsigned xb_ld(unsigned* p)              { return __hip_atomic_load(p, __ATOMIC_RELAXED, __HIP_MEMORY_SCOPE_AGENT); }
__device__ __forceinline__ unsigned xb_add(unsigned* p, unsigned v) { return __hip_atomic_fetch_add(p, v, __ATOMIC_RELAXED, __HIP_MEMORY_SCOPE_AGENT); }
__device__ __forceinline__ unsigned xb_xcc_id() { return (unsigned)__builtin_amdgcn_s_getreg((3 << 11) | 20) & 0xFu; }
#define XB_SPIN(cond, bar) do { unsigned _sp = 0; while (cond) { __builtin_amdgcn_s_sleep(1); \
    if ((++_sp & 255u) == 0u) { if (xb_ld(&(bar)[XB_TMO])) break; if (_sp > XB_SPIN_CAP) { atomicAdd(&(bar)[XB_TMO], 1u); break; } } } } while (0)
struct XcdBarrier { unsigned* bar; unsigned x; volatile LAS unsigned* st; int wv; };
__device__ __forceinline__ XcdBarrier xcd_barrier_post(unsigned* bar, volatile LAS unsigned* st, int wv) {
    XcdBarrier b; b.bar = bar; b.x = xb_xcc_id(); b.st = st; b.wv = wv;
    if (tid_of(wv) == 0) (void)xb_add(&bar[XB_XCNT(b.x)], 1u);
    return b;
}
__device__ __forceinline__ void xcd_barrier_complete(unsigned* bar, unsigned x, unsigned& nloc, unsigned& nx) {
    const unsigned G = gridDim.x * gridDim.y * gridDim.z;
    unsigned sum, cnt, mine, sp = 0u;
    for (;;) {
        sum = 0u; cnt = 0u; mine = 0u;
#pragma unroll
        for (unsigned j = 0; j < 16; ++j) { const unsigned c = xb_ld(&bar[XB_XCNT(j)]); sum += c; cnt += (c > 0u) ? 1u : 0u; mine = (j == x) ? c : mine; }
        if (sum == G) break;
        __builtin_amdgcn_s_sleep(1);
        if ((++sp & 255u) == 0u) { if (xb_ld(&bar[XB_TMO])) break; if (sp > XB_SPIN_CAP) { atomicAdd(&bar[XB_TMO], 1u); break; } }
    }
    nloc = mine > 0u ? mine : 1u; nx = cnt > 0u ? cnt : 1u;
}
__device__ __forceinline__ void xcd_barrier(const XcdBarrier& b) {
    asm volatile("s_waitcnt vmcnt(0)" ::: "memory");
    __syncthreads();
    if (tid_of(b.wv) == 0) {
        unsigned* bar = b.bar;
        __builtin_amdgcn_s_waitcnt(0);
        unsigned nloc = b.st[0], nx = b.st[1];
        if (nloc == 0u) { xcd_barrier_complete(bar, b.x, nloc, nx); b.st[0] = nloc; b.st[1] = nx; }
        const unsigned old = xb_add(&bar[XB_XSUB(b.x)], 1u);
        const unsigned gen = old / nloc;
        if (old + 1u == (gen + 1u) * nloc) {
            __builtin_amdgcn_fence(__ATOMIC_RELEASE, "agent");
            asm volatile("s_waitcnt vmcnt(0)" ::: "memory");
            const unsigned og = xb_add(&bar[XB_TOP], 1u);
            const unsigned tg = og / nx;
            if (og + 1u == (tg + 1u) * nx) xb_add(&bar[XB_TOPGEN], 1u);
            else XB_SPIN(xb_ld(&bar[XB_TOPGEN]) == tg, bar);
            __builtin_amdgcn_fence(__ATOMIC_ACQUIRE, "agent");
            xb_add(&bar[XB_XGEN(b.x)], 1u);
            asm volatile("s_waitcnt vmcnt(0)" ::: "memory");
        } else {
            XB_SPIN(xb_ld(&bar[XB_XGEN(b.x)]) == gen, bar);
            __builtin_amdgcn_fence(__ATOMIC_ACQUIRE, "agent");
            asm volatile("s_waitcnt vmcnt(0)" ::: "memory");
        }
    }
    __syncthreads();
}
constexpr int CW_DEP = 8192;
constexpr int CW_BAR = 4096;

namespace pg8 {
typedef short bf16x8 __attribute__((ext_vector_type(8)));
typedef float f32x4 __attribute__((ext_vector_type(4)));
typedef unsigned u32x4 __attribute__((ext_vector_type(4)));
typedef unsigned u32x2 __attribute__((ext_vector_type(2)));
constexpr int GTBL_OFF = 128 * 1024;
constexpr int BM = 256, BK = 64, HALF = 128, HTB = HALF * BK * 2, STAGE_BYTES = 8 * HTB, NXCD = 8, WGM = 8;
__host__ __device__ __forceinline__ int lds_byte(int r, int c) { const int st = (r >> 4) * 2 + (c >> 5), rr = r & 15, cc = c & 31, ob = rr * 64 + cc * 2; return st * 1024 + (ob ^ (((ob >> 9) & 1) << 5)); }
__host__ __device__ __forceinline__ void stage_rc(int b, int& R, int& C) { const int st = b / 1024, sb = b % 1024, swz = sb ^ (((sb >> 9) & 1) << 5); R = (st >> 1) * 16 + swz / 64; C = (st & 1) * 32 + (swz % 64) / 2; }
__host__ __device__ __forceinline__ int perm32(int rho) { const int n = rho >> 4, i = rho & 15; return 8 * (i >> 2) + 4 * n + (i & 3); }
__device__ __forceinline__ unsigned cvt_pk_bf16(float lo, float hi) { unsigned r; asm volatile("v_cvt_pk_bf16_f32 %0, %1, %2" : "=v"(r) : "v"(lo), "v"(hi)); return r; }

struct Unit { int pm, pn; const char* Ab; const char* Bb; int aux; };

struct DenseSched {
    const char* A; const char* Bt; size_t astep, bstep;
    int nM, nN, nwg, G, c, lim;
    __device__ __forceinline__ void init(const void* A_, int lda, const void* Bt_, int ldb, int M, int N, int G_, int c_) {
        A = (const char*)A_; Bt = (const char*)Bt_; astep = (size_t)BM * lda * 2; bstep = (size_t)BM * ldb * 2; nM = M / BM; nN = N / BM; nwg = nM * nN; G = G_; c = c_; lim = nwg; }
    __device__ __forceinline__ bool next(int i, Unit& u) const {
        const int L = i * G + c; if (L >= lim) return false;
        int wgid = L; { const int q = nwg / NXCD, r = nwg % NXCD, xcd = wgid % NXCD, off = wgid / NXCD; wgid = (xcd < r ? xcd * (q + 1) : r * (q + 1) + (xcd - r) * q) + off; }
        const int nig = WGM * nN, gid = wgid / nig, fm = gid * WGM, gsz = (nM - fm) < WGM ? (nM - fm) : WGM;
        u.pm = fm + ((wgid % nig) % gsz); u.pn = (wgid % nig) / gsz; u.Ab = A + (size_t)u.pm * astep; u.Bb = Bt + (size_t)u.pn * bstep; u.aux = 0; return true;
    }
    __device__ __forceinline__ int row(const Unit&, int) const { return 0; }
    __device__ __forceinline__ const int* rowtab(const Unit&) const { return nullptr; }
    __device__ __forceinline__ void wait(const Unit&) const {}
};
__device__ __forceinline__ void st16_wt(void* ptr, u32x4 v) { asm volatile("global_store_dwordx4 %0, %1, off sc0 sc1" :: "v"(ptr), "v"(v) : "memory"); }
__device__ __forceinline__ void dep_signal(unsigned* f) { asm volatile("s_waitcnt vmcnt(0)" ::: "memory"); if (__builtin_amdgcn_mbcnt_hi(-1, __builtin_amdgcn_mbcnt_lo(-1, 0)) == 0) (void)__hip_atomic_fetch_add(f, 1u, __ATOMIC_RELAXED, __HIP_MEMORY_SCOPE_AGENT); }
__device__ __forceinline__ void dep_wait(const unsigned* f, unsigned need) { unsigned sp = 0;
    while (__hip_atomic_load(f, __ATOMIC_RELAXED, __HIP_MEMORY_SCOPE_AGENT) < need) { __builtin_amdgcn_s_sleep(2); if (++sp > (1u << 22)) break; }
    asm volatile("" ::: "memory"); }
struct DepSched : DenseSched {
    static constexpr bool A_COHERENT = false;
    const unsigned* flag; unsigned need;
    __device__ __forceinline__ void wait(const Unit& u) const { dep_wait(flag + u.pm, need); }
};
struct G1Sched {
    DenseSched d;
    __device__ __forceinline__ void init(const void* A_, int lda, const void* Bt_, int ldb, int G_, int c_) { d.init(A_, lda, Bt_, ldb, M_, 11 * BM, G_, c_); }
    __device__ __forceinline__ bool next(int i, Unit& u) const {
        const int L = i * d.G + d.c; if (L >= 64 * 14) return false;
        if (L < 192) { u.pm = L / 3; u.pn = L % 3; }
        else { DenseSched t = d; t.G = 1; t.c = L - 192; (void)t.next(0, u); u.pn += 3; }
        u.Ab = d.A + (size_t)u.pm * d.astep; u.Bb = d.Bt + (size_t)u.pn * d.bstep; u.aux = 0; return true;
    }
    __device__ __forceinline__ int row(const Unit&, int) const { return 0; }
    __device__ __forceinline__ const int* rowtab(const Unit&) const { return nullptr; }
    __device__ __forceinline__ void wait(const Unit&) const {}
};

template <class T, class = void> struct sched_coherent { static constexpr bool value = false; };
template <class T> struct sched_coherent<T, decltype((void)T::A_COHERENT)> { static constexpr bool value = T::A_COHERENT; };
typedef int i32x4 __attribute__((ext_vector_type(4)));
typedef int i32x8 __attribute__((ext_vector_type(8)));
template <class Epi, class Sched, bool GATHER, bool F8 = false>
__device__ __forceinline__ void gemm_phase(LAS unsigned char* lds, const int wv, const int K, const int lda, const int ldb, const Sched& S, const Epi& E) {
    int tid = tid_of(wv); asm volatile("" : "+v"(tid));
    const int wid = __builtin_amdgcn_readfirstlane(tid >> 6), lane = tid & 63, wr = wid >> 2, wc = wid & 3, fr = lane & 15, fq = lane >> 4;
    int nt = K / BK; if constexpr (F8) asm volatile("" : "+s"(nt));
    unsigned voffB[2];
#pragma unroll
    for (int i = 0; i < 2; ++i) { int R, C; stage_rc(tid * 16 + i * 8192, R, C);
        const int Rb = Epi::PERM2 ? (64 * (R >> 5) + 16 * ((R & 15) >> 2) + 4 * ((R >> 4) & 1) + (R & 3)) : Epi::PERM ? ((R & ~31) + perm32(R & 31)) : R;
        voffB[i] = (unsigned)(Rb * ldb + C) * 2u; }
    const size_t kstep = (size_t)(BK * 2);
    const size_t hstepB = Epi::PERM2 ? (size_t)8 * ldb * 2 : (size_t)HALF * ldb * 2;
    const size_t hstepA = GATHER ? 0 : (size_t)HALF * lda * 2;
    const unsigned ldsw = (unsigned)wid * 1024u;
    const int aoff = lds_byte(wr * 64 + fr, fq * 8), boff = lds_byte(wc * 32 + fr, fq * 8);
#define PG8_SA(b, h) (((b) * 2 + (h)) * HTB)
#define PG8_SB(b, h) ((4 + (b) * 2 + (h)) * HTB)
#define PG8_STAGE(bufoff, gbase, v0, v1) do { const char* gb_ = (const char*)(gbase); asm volatile("" : "+s"(gb_));     \
        __builtin_amdgcn_global_load_lds((const unsigned*)(gb_ + (v0)), (LAS unsigned*)(lds + (bufoff) + ldsw), 16, 0, 0); \
        __builtin_amdgcn_global_load_lds((const unsigned*)(gb_ + (v1)), (LAS unsigned*)(lds + (bufoff) + ldsw + 8192), 16, 0, 0); } while (0)
#define PG8_STAGE_C(bufoff, gbase, v0, v1) do { const char* gb_ = (const char*)(gbase); asm volatile("" : "+s"(gb_)); \
        __builtin_amdgcn_global_load_lds((const unsigned*)(gb_ + (v0)), (LAS unsigned*)(lds + (bufoff) + ldsw), 16, 0, 17); \
        __builtin_amdgcn_global_load_lds((const unsigned*)(gb_ + (v1)), (LAS unsigned*)(lds + (bufoff) + ldsw + 8192), 16, 0, 17); } while (0)
#define PG8_STAGEB(bufoff, gbase) PG8_STAGE(bufoff, gbase, voffB[0], voffB[1])
#define PG8_LDA(dst, b, h) do { _Pragma("unroll") for (int m = 0; m < 4; ++m) _Pragma("unroll") for (int k = 0; k < 2; ++k) dst[m][k] = *(const LAS bf16x8*)(lds + PG8_SA(b, h) + aoff + m * 2048 + k * 1024); } while (0)
#define PG8_LDB(dst, b, h) do { _Pragma("unroll") for (int n = 0; n < 2; ++n) _Pragma("unroll") for (int k = 0; k < 2; ++k) dst[n][k] = *(const LAS bf16x8*)(lds + PG8_SB(b, h) + boff + n * 2048 + k * 1024); } while (0)
#define PG8_CAT(x) __builtin_shufflevector(__builtin_bit_cast(i32x4, (x)[0]), __builtin_bit_cast(i32x4, (x)[1]), 0, 1, 2, 3, 4, 5, 6, 7)
#define PG8_MMA(ai, bj, At, Bt) do { __builtin_amdgcn_s_setprio(1); \
        if constexpr (F8) { _Pragma("unroll") for (int m = 0; m < 4; ++m) _Pragma("unroll") for (int n = 0; n < 2; ++n) \
            acc[ai][bj][m][n] = __builtin_amdgcn_mfma_scale_f32_16x16x128_f8f6f4(PG8_CAT(Bt[n]), PG8_CAT(At[m]), acc[ai][bj][m][n], 0, 0, 0, 0, 0, 0); } \
        else { _Pragma("unroll") for (int m = 0; m < 4; ++m) _Pragma("unroll") for (int n = 0; n < 2; ++n) _Pragma("unroll") for (int k = 0; k < 2; ++k) \
            acc[ai][bj][m][n] = __builtin_amdgcn_mfma_f32_16x16x32_bf16(Bt[n][k], At[m][k], acc[ai][bj][m][n], 0, 0, 0); } \
        __builtin_amdgcn_s_setprio(0); } while (0)
#define PG8_WAIT_V(n) asm volatile("s_waitcnt vmcnt(" #n ")" ::: "memory")
#define PG8_WAIT_L(n) asm volatile("s_waitcnt lgkmcnt(" #n ")" ::: "memory")
#define PG8_BAR __builtin_amdgcn_s_barrier()
#define PG8_SCHED __builtin_amdgcn_sched_barrier(0)
    unsigned vc00, vc01, gtb = 0, gcb = 0;
    { int t_ = tid; asm volatile("" : "+v"(t_)); int R0_, C0_, R1_, C1_; stage_rc(t_ * 16, R0_, C0_); stage_rc(t_ * 16 + 8192, R1_, C1_);
      vc00 = (unsigned)(R0_ * lda + C0_) * 2u; vc01 = (unsigned)(R1_ * lda + C1_) * 2u; gtb = (unsigned)R0_ * 4u; gcb = (unsigned)C0_ * 2u; }
    const unsigned rowb = (unsigned)lda * 2u;
#define PG8_STAGEA(bufoff, gbase, half, tpar) do { if constexpr (GATHER) { \
        const LAS int* tp_ = (const LAS int*)(lds + GTBL_OFF + (tpar) * 1024 + (half) * 512 + gtb); const unsigned ra_ = (unsigned)tp_[0], rb_ = (unsigned)tp_[64]; \
        PG8_STAGE(bufoff, gbase, ra_ * rowb + gcb, rb_ * rowb + gcb); } else if constexpr (sched_coherent<Sched>::value) PG8_STAGE_C(bufoff, gbase, vc00, vc01); else PG8_STAGE(bufoff, gbase, vc00, vc01); } while (0)
#define PG8_TBLDMA(U, tpar) do { const char* tb_ = (const char*)(S.rowtab(U) + (wid & 3) * 64); asm volatile("" : "+s"(tb_)); \
        __builtin_amdgcn_global_load_lds((const unsigned*)(tb_ + (unsigned)(tid_of(wv) & 63) * 4u), (LAS unsigned*)(lds + GTBL_OFF + (tpar) * 1024 + (wid & 3) * 256), 4, 0, 0); } while (0)
    Unit cur, nxt; int ui = 0;
    if (!S.next(0, cur)) return;
    S.wait(cur);
    if constexpr (GATHER) { PG8_TBLDMA(cur, 0); asm volatile("s_waitcnt vmcnt(0)" ::: "memory"); __builtin_amdgcn_s_barrier(); }
    f32x4 acc[2][2][4][2];
#pragma unroll
    for (int a = 0; a < 2; ++a)
#pragma unroll
        for (int b = 0; b < 2; ++b)
#pragma unroll
            for (int m = 0; m < 4; ++m)
#pragma unroll
                for (int n = 0; n < 2; ++n) acc[a][b][m][n] = (f32x4){0.f, 0.f, 0.f, 0.f};
    bf16x8 At[4][2], B0[2][2], B1[2][2];
    const char* cA = cur.Ab; const char* cB = cur.Bb;
    PG8_STAGEB(PG8_SB(0, 0), cB); PG8_STAGEB(PG8_SB(0, 1), cB + hstepB); PG8_STAGEA(PG8_SA(0, 0), cA, 0, 0); PG8_STAGEA(PG8_SA(0, 1), cA + hstepA, 1, 0);
    if (wr == 1) PG8_BAR;
    PG8_WAIT_V(2); PG8_BAR;
    PG8_STAGEB(PG8_SB(1, 0), cB + kstep); PG8_STAGEA(PG8_SA(1, 0), cA + kstep, 0, 0); PG8_STAGEB(PG8_SB(1, 1), cB + hstepB + kstep);
    PG8_WAIT_V(6); PG8_BAR;
    for (;;) {
        const bool has_next = S.next(ui + 1, nxt);
        const char* nA = has_next ? nxt.Ab : cA; const char* nB = has_next ? nxt.Bb : cB;
        if (has_next) S.wait(nxt);
        const int cpar = ui & 1, npar = has_next ? (cpar ^ 1) : cpar;
        if constexpr (GATHER) { if (has_next) PG8_TBLDMA(nxt, npar); }
        for (int t = 0; t < nt; t += 2) {
            const bool last = (t == nt - 2);
            const char* a1 = cA + (size_t)(t + 1) * kstep;
            const char* a2 = last ? nA : cA + (size_t)(t + 2) * kstep; const char* b2 = last ? nB : cB + (size_t)(t + 2) * kstep;
            const char* a3 = a2 + kstep; const char* b3 = b2 + kstep;
            const int wpar = last ? npar : cpar;
            PG8_LDB(B0, 0, 0); PG8_LDB(B1, 0, 1); PG8_SCHED; PG8_LDA(At, 0, 0); PG8_STAGEA(PG8_SA(1, 1), a1 + hstepA, 1, cpar);
            PG8_WAIT_V(8); PG8_WAIT_L(0); PG8_BAR; PG8_MMA(0, 0, At, B0); PG8_MMA(0, 1, At, B1); PG8_BAR; PG8_SCHED;
            PG8_LDA(At, 0, 1); PG8_STAGEB(PG8_SB(0, 0), b2); PG8_STAGEB(PG8_SB(0, 1), b2 + hstepB); PG8_STAGEA(PG8_SA(0, 0), a2, 0, wpar);
            PG8_WAIT_V(8); PG8_WAIT_L(0); PG8_BAR; PG8_MMA(1, 0, At, B0); PG8_MMA(1, 1, At, B1); PG8_BAR; PG8_SCHED;
            PG8_LDB(B0, 1, 0); PG8_LDB(B1, 1, 1); PG8_SCHED; PG8_LDA(At, 1, 0); PG8_STAGEA(PG8_SA(0, 1), a2 + hstepA, 1, wpar);
            PG8_WAIT_V(8); PG8_WAIT_L(0); PG8_BAR; PG8_MMA(0, 0, At, B0); PG8_MMA(0, 1, At, B1); PG8_BAR; PG8_SCHED;
            PG8_LDA(At, 1, 1); PG8_STAGEB(PG8_SB(1, 0), b3); PG8_STAGEB(PG8_SB(1, 1), b3 + hstepB); PG8_STAGEA(PG8_SA(1, 0), a3, 0, wpar);
            PG8_WAIT_V(8); PG8_WAIT_L(0); PG8_BAR; PG8_MMA(1, 0, At, B0); PG8_MMA(1, 1, At, B1); PG8_BAR; PG8_SCHED;
        }
        if (wr == 0) PG8_BAR;
        { const int le = tid_of(wv) & 63; E(acc, cur, wr, wc, le & 15, le >> 4); }
        if (!has_next) break;
#pragma unroll
        for (int a = 0; a < 2; ++a)
#pragma unroll
            for (int b = 0; b < 2; ++b)
#pragma unroll
                for (int m = 0; m < 4; ++m)
#pragma unroll
                    for (int n = 0; n < 2; ++n) acc[a][b][m][n] = (f32x4){0.f, 0.f, 0.f, 0.f};
        cur = nxt; cA = nA; cB = nB; ++ui;
        if (wr == 1) PG8_BAR;
    }
    PG8_WAIT_V(0);
    PG8_BAR;
#undef PG8_SA
#undef PG8_SB
#undef PG8_STAGE
#undef PG8_STAGEB
#undef PG8_STAGE_C
#undef PG8_LDA
#undef PG8_LDB
#undef PG8_MMA
#undef PG8_CAT
#undef PG8_WAIT_V
#undef PG8_WAIT_L
#undef PG8_BAR
#undef PG8_SCHED
#undef PG8_STAGEA
#undef PG8_TBLDMA
}

constexpr float HID_SC = 16.f, WDN_SC = 64.f, XN_SC = 8.f, WGU_SC = 128.f;
enum { EP_Z = 0, EP_BF16 = 1, EP_MG1 = 2, EP_MG2 = 3, EP_RES = 4, EP_HID = 5, EP_DOWN = 6, EP_PLE = 7 };
__device__ __forceinline__ float bfl(unsigned w) { return __uint_as_float(w << 16); }
__device__ __forceinline__ float bfh(unsigned w) { return __uint_as_float(w & 0xffff0000u); }
__device__ __forceinline__ float sigm(float v) { return __builtin_amdgcn_rcpf(1.f + __expf(-v)); }
template <int MODE> struct Epi {
    static constexpr bool PERM = !(MODE == EP_RES || MODE == EP_PLE), PERM2 = (MODE == EP_DOWN);
    bf16_t* O; int ldc;
    const bf16_t* aux; int ldaux;
    const float* fin; float* fout; const float* fin2; bf16_t* O2; unsigned* flags;
    __device__ __forceinline__ void operator()(const f32x4 (&acc)[2][2][4][2], const Unit& u, int wr, int wc, int fr, int fq) const {
        const int row0 = u.pm * BM + wr * 64 + fr;
        if constexpr (MODE == EP_RES) {
            const int col0 = u.pn * BM + wc * 32 + 4 * fq;
            f32x4 xc[4], xn[4];
#pragma unroll
            for (int q = 0; q < 4; ++q) xc[q] = *(const f32x4*)(fin + (size_t)row0 * D_ + col0 + (q >> 1) * HALF + (q & 1) * 16);
#pragma unroll
            for (int g = 0; g < 8; ++g) { const size_t r = (size_t)(row0 + (g >> 2) * HALF + (g & 3) * 16);
                if (g < 7) { const size_t r1 = (size_t)(row0 + ((g + 1) >> 2) * HALF + ((g + 1) & 3) * 16);
#pragma unroll
                    for (int q = 0; q < 4; ++q) xn[q] = *(const f32x4*)(fin + r1 * D_ + col0 + (q >> 1) * HALF + (q & 1) * 16); }
                asm volatile("" ::: "memory");
#pragma unroll
                for (int q = 0; q < 4; ++q) { const f32x4 o = xc[q] + acc[g >> 2][q >> 1][g & 3][q & 1]; *(f32x4*)(fout + r * D_ + col0 + (q >> 1) * HALF + (q & 1) * 16) = o; }
                asm volatile("" ::: "memory");
#pragma unroll
                for (int q = 0; q < 4; ++q) xc[q] = xn[q]; }
        } else if constexpr (MODE == EP_PLE) {
            const int col0 = u.pn * BM + wc * 32 + 4 * fq;
            constexpr float qs = 1.f / (XN_SC * WGU_SC);
            f32x4 bv[4]; u32x2 pc[4], hc[4], pn_[4], hn[4]; float ic, in_ = 0.f;
#pragma unroll
            for (int q = 0; q < 4; ++q) { const int c = col0 + (q >> 1) * HALF + (q & 1) * 16; bv[q] = *(const f32x4*)(fin + c);
                pc[q] = *(const u32x2*)(aux + (size_t)row0 * ldaux + c); hc[q] = *(const u32x2*)(O + (size_t)row0 * D_ + c); }
            ic = fin2[row0];
#pragma unroll
            for (int g = 0; g < 8; ++g) { const size_t r = (size_t)(row0 + (g >> 2) * HALF + (g & 3) * 16);
                if (g < 7) { const size_t r1 = (size_t)(row0 + ((g + 1) >> 2) * HALF + ((g + 1) & 3) * 16);
#pragma unroll
                    for (int q = 0; q < 4; ++q) { const int c = col0 + (q >> 1) * HALF + (q & 1) * 16; pn_[q] = *(const u32x2*)(aux + r1 * ldaux + c); hn[q] = *(const u32x2*)(O + r1 * D_ + c); }
                    in_ = fin2[r1]; }
                asm volatile("" ::: "memory");
#pragma unroll
                for (int q = 0; q < 4; ++q) { const int c = col0 + (q >> 1) * HALF + (q & 1) * 16; const f32x4 a = acc[g >> 2][q >> 1][g & 3][q & 1]; const u32x2 pw = pc[q], hw = hc[q]; f32x4 o;
                    o[0] = bfl(hw.x) * ic + sigm(a[0] * qs + bv[q][0]) * bfl(pw.x); o[1] = bfh(hw.x) * ic + sigm(a[1] * qs + bv[q][1]) * bfh(pw.x);
                    o[2] = bfl(hw.y) * ic + sigm(a[2] * qs + bv[q][2]) * bfl(pw.y); o[3] = bfh(hw.y) * ic + sigm(a[3] * qs + bv[q][3]) * bfh(pw.y);
                    *(f32x4*)(fout + r * D_ + c) = o; }
                asm volatile("" ::: "memory");
#pragma unroll
                for (int q = 0; q < 4; ++q) { pc[q] = pn_[q]; hc[q] = hn[q]; }
                ic = in_; }
        } else if constexpr (MODE == EP_DOWN) {
            unsigned char* Y8 = (unsigned char*)O; const int col0 = u.pn * BM + wc * 64 + 16 * fq;
#pragma unroll
            for (int ai = 0; ai < 2; ++ai)
#pragma unroll
                for (int m = 0; m < 4; ++m) { const size_t r = (size_t)(row0 + ai * HALF + m * 16); u32x4 w;
#pragma unroll
                    for (int bj = 0; bj < 2; ++bj)
#pragma unroll
                        for (int n = 0; n < 2; ++n) { const f32x4 a = acc[ai][bj][m][n] * (16.f / (HID_SC * WDN_SC)); int d = 0;
                            d = __builtin_amdgcn_cvt_pk_fp8_f32(a[0], a[1], d, false); d = __builtin_amdgcn_cvt_pk_fp8_f32(a[2], a[3], d, true); w[2 * bj + n] = (unsigned)d; }
                    *(u32x4*)(Y8 + r * 1024 + col0) = w; }
        } else if constexpr (MODE == EP_HID) {
            const int col0 = u.pn * HALF + wc * 32 + 8 * fq;
#pragma unroll
            for (int ai = 0; ai < 2; ++ai)
#pragma unroll
                for (int m = 0; m < 4; ++m) { const size_t r = (size_t)(row0 + ai * HALF + m * 16); const float w = fin[r]; constexpr float rs = 1.f / (XN_SC * WGU_SC);
                    const f32x4 g0 = acc[ai][0][m][0] * rs, g1 = acc[ai][0][m][1] * rs, u0 = acc[ai][1][m][0] * rs, u1 = acc[ai][1][m][1] * rs;
                    float h[8];
#pragma unroll
                    for (int j = 0; j < 4; ++j) { h[j] = g0[j] * sigm(g0[j]) * u0[j] * w; h[4 + j] = g1[j] * sigm(g1[j]) * u1[j] * w; }
#pragma unroll
                    for (int j = 0; j < 8; ++j) h[j] = __builtin_amdgcn_fmed3f(h[j] * HID_SC, -448.f, 448.f);
                    int d0 = 0, d1 = 0;
                    d0 = __builtin_amdgcn_cvt_pk_fp8_f32(h[0], h[1], d0, false); d0 = __builtin_amdgcn_cvt_pk_fp8_f32(h[2], h[3], d0, true);
                    d1 = __builtin_amdgcn_cvt_pk_fp8_f32(h[4], h[5], d1, false); d1 = __builtin_amdgcn_cvt_pk_fp8_f32(h[6], h[7], d1, true);
                    *(u32x2*)((unsigned char*)O + r * ldc + col0) = (u32x2){(unsigned)d0, (unsigned)d1}; }
        } else if constexpr (MODE == EP_MG1 || MODE == EP_MG2) {
            const int col0 = u.pn * BM + wc * 32 + 8 * fq;
            u32x4 gc[2], gn[2], oc[2], on[2];
#pragma unroll
            for (int bj = 0; bj < 2; ++bj) { gc[bj] = *(const u32x4*)(aux + (size_t)row0 * ldaux + col0 + bj * HALF); if constexpr (MODE == EP_MG2) oc[bj] = *(const u32x4*)(O + (size_t)row0 * ldc + col0 + bj * HALF); }
#pragma unroll
            for (int g = 0; g < 8; ++g) { const size_t r = (size_t)(row0 + (g >> 2) * HALF + (g & 3) * 16);
                if (g < 7) { const size_t r1 = (size_t)(row0 + ((g + 1) >> 2) * HALF + ((g + 1) & 3) * 16);
#pragma unroll
                    for (int bj = 0; bj < 2; ++bj) { gn[bj] = *(const u32x4*)(aux + r1 * ldaux + col0 + bj * HALF); if constexpr (MODE == EP_MG2) on[bj] = *(const u32x4*)(O + r1 * ldc + col0 + bj * HALF); } }
                asm volatile("" ::: "memory");
#pragma unroll
                for (int bj = 0; bj < 2; ++bj) { const int c = col0 + bj * HALF; f32x4 v0 = acc[g >> 2][bj][g & 3][0], v1 = acc[g >> 2][bj][g & 3][1]; const u32x4 gw = gc[bj];
                    v0[0] *= bfl(gw.x); v0[1] *= bfh(gw.x); v0[2] *= bfl(gw.y); v0[3] *= bfh(gw.y); v1[0] *= bfl(gw.z); v1[1] *= bfh(gw.z); v1[2] *= bfl(gw.w); v1[3] *= bfh(gw.w);
                    if constexpr (MODE == EP_MG2) { const u32x4 ow = oc[bj];
                        v0[0] += bfl(ow.x); v0[1] += bfh(ow.x); v0[2] += bfl(ow.y); v0[3] += bfh(ow.y); v1[0] += bfl(ow.z); v1[1] += bfh(ow.z); v1[2] += bfl(ow.w); v1[3] += bfh(ow.w); }
                    u32x4 w; w.x = cvt_pk_bf16(v0[0], v0[1]); w.y = cvt_pk_bf16(v0[2], v0[3]); w.z = cvt_pk_bf16(v1[0], v1[1]); w.w = cvt_pk_bf16(v1[2], v1[3]);
                    *(u32x4*)(O + r * ldc + c) = w; }
                asm volatile("" ::: "memory");
#pragma unroll
                for (int bj = 0; bj < 2; ++bj) { gc[bj] = gn[bj]; if constexpr (MODE == EP_MG2) oc[bj] = on[bj]; } }
        } else {
            const int col0 = u.pn * BM + wc * 32 + 8 * fq;
            const bool act = (MODE == EP_Z) && (u.pn >= ZGA / BM);
#pragma unroll
            for (int ai = 0; ai < 2; ++ai)
#pragma unroll
                for (int m = 0; m < 4; ++m) { const size_t r = (size_t)(row0 + ai * HALF + m * 16);
#pragma unroll
                    for (int bj = 0; bj < 2; ++bj) { const int c = col0 + bj * HALF; f32x4 v0 = acc[ai][bj][m][0], v1 = acc[ai][bj][m][1];
                        if constexpr (MODE == EP_Z) { if (act) { const f32x4 b0 = *(const f32x4*)(fin + c - ZGA), b1 = *(const f32x4*)(fin + c - ZGA + 4);
#pragma unroll
                            for (int j = 0; j < 4; ++j) { v0[j] = sigm(v0[j] + b0[j]); v1[j] = sigm(v1[j] + b1[j]); } } }
                        if constexpr (MODE == EP_MG1 || MODE == EP_MG2) { const u32x4 gw = *(const u32x4*)(aux + r * ldaux + c);
                            v0[0] *= bfl(gw.x); v0[1] *= bfh(gw.x); v0[2] *= bfl(gw.y); v0[3] *= bfh(gw.y); v1[0] *= bfl(gw.z); v1[1] *= bfh(gw.z); v1[2] *= bfl(gw.w); v1[3] *= bfh(gw.w); }
                        if constexpr (MODE == EP_MG2) { const u32x4 ow = *(const u32x4*)(O + r * ldc + c);
                            v0[0] += bfl(ow.x); v0[1] += bfh(ow.x); v0[2] += bfl(ow.y); v0[3] += bfh(ow.y); v1[0] += bfl(ow.z); v1[1] += bfh(ow.z); v1[2] += bfl(ow.w); v1[3] += bfh(ow.w); }
                        { u32x4 w; w.x = cvt_pk_bf16(v0[0], v0[1]); w.y = cvt_pk_bf16(v0[2], v0[3]); w.z = cvt_pk_bf16(v1[0], v1[1]); w.w = cvt_pk_bf16(v1[2], v1[3]);
                            if (MODE == EP_Z && u.pn < 3) st16_wt(O + r * ldc + c, w); else *(u32x4*)(O + r * ldc + c) = w; } }
                    if constexpr (MODE == EP_MG1 || MODE == EP_MG2) asm volatile("" ::: "memory"); }
            if constexpr (MODE == EP_Z) { if (u.pn < 3) dep_signal(flags + (u.pn == 2 ? 64 : 0) + u.pm); }
        }
    }
};
}

__device__ __forceinline__ unsigned pk2(float lo, float hi) { return (unsigned)f2bf(lo) | ((unsigned)f2bf(hi) << 16); }
__device__ __forceinline__ int zdst(int c) {
    if (c < 384) return c;
    if (c < 640) return ZCKV + (c - 384);
    if (c < 672) return ZKR + (c - 640);
    if (c < 1184) return ZQS + (c - 672);
    if (c < 1312) return ZKS + (c - 1184);
    if (c < 1440) return ZVS + (c - 1312);
    if (c < 2464) return ZGA + (c - 1440);
    return ZGB + (c - 2464);
}
__device__ __forceinline__ int gudst(int j) { const int half = j >> 8, jj = j & 255; return ((jj >> 7) << 8) + (half << 7) + (jj & 127); }
struct ConvJob { const float* src; const float* gp; bf16_t* dst; int K, N; float sc; };
template <int K, int N, int MAP>
__device__ __forceinline__ ConvJob conv_mk(const float* W, const float* g, bf16_t* WT, int item) {
    constexpr int nblk = N / 32; const int kb = item / nblk, nb = item % nblk, k0 = 64 * kb, n0 = 32 * nb;
    const int d0 = (MAP == 1) ? zdst(n0) : (MAP == 2) ? gudst(n0) : n0;
    return ConvJob{W + (size_t)k0 * N + n0, g ? g + k0 : nullptr, WT + (size_t)d0 * K + k0, K, N, 0.f};
}
template <int K, int N, int MAP>
__device__ __forceinline__ ConvJob conv_mk8(const float* W, const float* g, unsigned char* WT, int item, float sc) {
    constexpr int nblk = N / 32; const int kb = item / nblk, nb = item % nblk, k0 = 64 * kb, n0 = 32 * nb;
    const int d0 = (MAP == 2) ? gudst(n0) : n0;
    return ConvJob{W + (size_t)k0 * N + n0, g ? g + k0 : nullptr, (bf16_t*)(WT + (size_t)d0 * K + k0), K, N, sc};
}
__device__ __forceinline__ void conv_load(const ConvJob& j, int lane, f32x4_t (&v)[8]) {
    const int kq = lane >> 3, n4 = (lane & 7) * 4; const float* sp = j.src + (size_t)kq * j.N + n4;
#pragma unroll
    for (int i = 0; i < 8; ++i) v[i] = *(const f32x4_t*)(sp + (size_t)(8 * i) * j.N);
}
__device__ __forceinline__ void conv_finish(const ConvJob& j, int lane, const f32x4_t (&v)[8], LAS float* scr) {
    const int kq = lane >> 3, n4 = (lane & 7) * 4;
    const bool f8 = j.sc > 0.f; const float scl = f8 ? j.sc : 1.f;
#pragma unroll
    for (int i = 0; i < 8; ++i) { const int kk = kq + 8 * i; const float gg = (j.gp ? j.gp[kk] : 1.f) * scl; LAS float* d = scr + kk * 33 + n4;
        d[0] = v[i].x * gg; d[1] = v[i].y * gg; d[2] = v[i].z * gg; d[3] = v[i].w * gg; }
    asm volatile("s_waitcnt lgkmcnt(0)" ::: "memory");
    const int c = lane & 7;
    if (f8) {
#pragma unroll
        for (int q = 0; q < 4; ++q) { const int n = (lane >> 3) + 8 * q; const LAS float* sp = scr + (8 * c) * 33 + n; float t[8];
#pragma unroll
            for (int i = 0; i < 8; ++i) t[i] = __builtin_amdgcn_fmed3f(sp[i * 33], -448.f, 448.f);
            int d0 = 0, d1 = 0;
            d0 = __builtin_amdgcn_cvt_pk_fp8_f32(t[0], t[1], d0, false); d0 = __builtin_amdgcn_cvt_pk_fp8_f32(t[2], t[3], d0, true);
            d1 = __builtin_amdgcn_cvt_pk_fp8_f32(t[4], t[5], d1, false); d1 = __builtin_amdgcn_cvt_pk_fp8_f32(t[6], t[7], d1, true);
            *(pg8::u32x2*)((unsigned char*)j.dst + (size_t)n * j.K + 8 * c) = (pg8::u32x2){(unsigned)d0, (unsigned)d1}; }
    } else {
#pragma unroll
        for (int q = 0; q < 4; ++q) { const int n = (lane >> 3) + 8 * q; const LAS float* sp = scr + (8 * c) * 33 + n;
            pg8::u32x4 o; o.x = pk2(sp[0 * 33], sp[1 * 33]); o.y = pk2(sp[2 * 33], sp[3 * 33]); o.z = pk2(sp[4 * 33], sp[5 * 33]); o.w = pk2(sp[6 * 33], sp[7 * 33]);
            *(pg8::u32x4*)(j.dst + (size_t)n * j.K + 8 * c) = o; }
    }
    asm volatile("s_waitcnt lgkmcnt(0)" ::: "memory");
}
__device__ __forceinline__ ConvJob conv_job(const P& p, int it) {
    constexpr int I0 = 16 * 109, I1 = 6 * 24, I2 = 4 * 32, I3 = 8 * 32, I4 = 8 * 32, I5 = 16 * 32, I6 = 16 * 32, I7 = 4 * 32, I8 = 16 * 16, I9 = 4 * 32, IGU = 16 * 16, IDN = 4 * 32;
    int r = it;
    if (r < I0) return conv_mk<1024, INW, 1>(p.w_in, p.g_mix, WSP(bf16_t, WS_WIN), r); r -= I0;
    if (r < I1) return conv_mk<384, 768, 0>(p.w_uq, p.g_cq, WSP(bf16_t, WS_WUQ), r); r -= I1;
    if (r < I2) return conv_mk<256, 1024, 0>(p.w_ukv, p.g_ckv, WSP(bf16_t, WS_WUKV), r); r -= I2;
    if (r < I7) return conv_mk<256, 1024, 0>(p.w_ple_proj, nullptr, WSP(bf16_t, WS_WPP), r); r -= I7;
    if (r < I3) return conv_mk<512, 1024, 0>(p.w_br_mla, nullptr, WSP(bf16_t, WS_WBRM), r); r -= I3;
    if (r < I4) return conv_mk<512, 1024, 0>(p.w_br_swa, nullptr, WSP(bf16_t, WS_WBRS), r); r -= I4;
    if (r < I5) return conv_mk<1024, 1024, 0>(p.w_out, nullptr, WSP(bf16_t, WS_WOUT), r); r -= I5;
    if (r < I6) return conv_mk8<1024, 1024, 0>(p.w_ple_gate, p.g_ple, WSP(unsigned char, WS_WPG), r, pg8::WGU_SC); r -= I6;
    if (r < I8) return conv_mk8<1024, 512, 2>(p.w_sh_gu, p.g_moe, WSP(unsigned char, WS_WGU) + (size_t)NE * 512 * 1024, r, pg8::WGU_SC); r -= I8;
    if (r < I9) return conv_mk8<256, 1024, 0>(p.w_sh_down, nullptr, WSP(unsigned char, WS_WDN) + (size_t)NE * 1024 * 256, r, pg8::WDN_SC); r -= I9;
    if (r < 64 * IGU) { const int e = r / IGU; return conv_mk8<1024, 512, 2>(p.w_exp_gu + (size_t)e * 1024 * 512, p.g_moe, WSP(unsigned char, WS_WGU) + (size_t)e * 512 * 1024, r % IGU, pg8::WGU_SC); } r -= 64 * IGU;
    { const int e = r / IDN; return conv_mk8<256, 1024, 0>(p.w_exp_down + (size_t)e * 256 * 1024, nullptr, WSP(unsigned char, WS_WDN) + (size_t)e * 1024 * 256, r % IDN, pg8::WDN_SC); }
}
constexpr int CONV_EARLY = 16 * 109 + 6 * 24 + 4 * 32 + 4 * 32;
constexpr int CONV_NITEMS = 16 * 109 + 6 * 24 + 4 * 32 + 8 * 32 + 8 * 32 + 16 * 32 + 16 * 32 + 4 * 32 + 16 * 16 + 4 * 32 + 64 * 256 + 64 * 128;
__device__ __forceinline__ void st_wconv(const P& p, int gw, int ngw, int lane, LAS float* scr) {
    constexpr int NITEMS = CONV_EARLY;
    if (gw < NITEMS) {
        ConvJob cur = conv_job(p, gw); f32x4_t v[8], w[8]; conv_load(cur, lane, v);
        for (int it = gw; it < NITEMS; it += ngw) {
            const bool more = it + ngw < NITEMS; ConvJob nx = cur;
            if (more) { nx = conv_job(p, it + ngw); conv_load(nx, lane, w); }
            conv_finish(cur, lane, v, scr);
            if (more) { cur = nx;
#pragma unroll
                for (int i = 0; i < 8; ++i) v[i] = w[i]; }
        }
    }
    { unsigned* zp = (unsigned*)(WSP(bf16_t, WS_WIN) + (size_t)416 * 1024); const int n = 96 * 1024 / 2;
      for (int i = gw * 64 + lane; i < n; i += ngw * 64) zp[i] = 0u; }
}
__device__ __forceinline__ void fs_g1(const P& p, LAS unsigned char* lds, const int wv) {
    pg8::G1Sched S; S.init(WSP(bf16_t, WS_HB), D_, WSP(bf16_t, WS_WIN), D_, gridDim.x, blockIdx.x);
    pg8::Epi<pg8::EP_Z> E{WSP(bf16_t, WS_Z), NZ, nullptr, 0, p.b_gate, nullptr, nullptr, nullptr, WSP(unsigned, WS_CTL) + CW_DEP};
    pg8::gemm_phase<pg8::Epi<pg8::EP_Z>, pg8::G1Sched, false>(lds, wv, D_, D_, D_, S, E);
}

struct MoeSched {
    const char* A; const char* Bt; size_t astep, bstep, estep; const LAS int* tile_e; const int* ltok; int T, NPN, nwg, G, c; bool gather;
    __device__ __forceinline__ void init(const void* A_, int lda, const void* Bt_, int ldb, int ncols_e, const LAS int* tile_e_, const int* ltok_, int T_, bool gather_, int G_, int c_) {
        A = (const char*)A_; Bt = (const char*)Bt_; astep = (size_t)256 * lda * 2; bstep = (size_t)256 * ldb * 2; estep = (size_t)ncols_e * ldb * 2; tile_e = tile_e_; ltok = ltok_;
        T = T_; NPN = ncols_e / 256; nwg = (T + M_ / 256) * NPN; G = G_; c = c_; gather = gather_; }
    __device__ __forceinline__ bool next(int i, pg8::Unit& u) const {
        const int L = i * G + c; if (L >= nwg) return false;
        int wgid = L; { const int q = nwg / 8, r = nwg % 8, xcd = wgid % 8, off = wgid / 8; wgid = (xcd < r ? xcd * (q + 1) : r * (q + 1) + (xcd - r) * q) + off; }
        const int j = wgid / NPN; u.pn = wgid % NPN;
        int e; if (j < T) { u.pm = j; e = __builtin_amdgcn_readfirstlane(tile_e[j]); } else { u.pm = NSLOT / 256 + (j - T); e = NE; }
        u.Ab = gather ? A : A + (size_t)u.pm * astep; u.Bb = Bt + (size_t)e * estep + (size_t)u.pn * bstep; u.aux = e; return true;
    }
    __device__ __forceinline__ int row(const pg8::Unit& u, int r) const { return ltok[u.pm * 256 + r]; }
    __device__ __forceinline__ const int* rowtab(const pg8::Unit& u) const { return ltok + u.pm * 256; }
    __device__ __forceinline__ void wait(const pg8::Unit&) const {}
};
constexpr size_t WS_TILEE = 5 * MiB;
constexpr int NT = 512;
constexpr int TILEE_LDS = 136 * 1024;
__device__ __forceinline__ void fs_g23(const P& p, LAS unsigned char* lds, const int wv) {
    const int wg = (int)blockIdx.x; constexpr int NEVER = 1 << 20;
    { pg8::DepSched S; S.init(WSP(bf16_t, WS_Z) + ZQ, NZ, WSP(bf16_t, WS_WUQ), 384, M_, 768, NEVER, wg < 192 ? wg : NEVER); S.flag = WSP(unsigned, WS_CTL) + CW_DEP; S.need = 16u;
      pg8::Epi<pg8::EP_BF16> E{WSP(bf16_t, WS_QMR), 768, nullptr, 0, nullptr, nullptr};
      pg8::gemm_phase<pg8::Epi<pg8::EP_BF16>, pg8::DepSched, false>(lds, wv, 384, NZ, 384, S, E); }
    { pg8::DepSched S; S.init(WSP(bf16_t, WS_Z) + ZCKV, NZ, WSP(bf16_t, WS_WUKV), 256, M_, 1024, 128, wg >= 128 ? wg - 128 : NEVER); S.flag = WSP(unsigned, WS_CTL) + CW_DEP + 64; S.need = 8u;
      pg8::Epi<pg8::EP_BF16> E{WSP(bf16_t, WS_KVR), 1024, nullptr, 0, nullptr, nullptr};
      pg8::gemm_phase<pg8::Epi<pg8::EP_BF16>, pg8::DepSched, false>(lds, wv, 256, NZ, 256, S, E); }
}
__device__ __forceinline__ void fs_merge(const P& p, LAS unsigned char* lds, const int wv) {
    { pg8::DenseSched S; S.init(WSP(bf16_t, WS_OM), 512, WSP(bf16_t, WS_WBRM), 512, M_, D_, gridDim.x, blockIdx.x);
      pg8::Epi<pg8::EP_MG1> E{WSP(bf16_t, WS_MG), D_, WSP(bf16_t, WS_Z) + ZGA, NZ, nullptr, nullptr};
      pg8::gemm_phase<pg8::Epi<pg8::EP_MG1>, pg8::DenseSched, false>(lds, wv, 512, 512, 512, S, E); }
    { pg8::DenseSched S; S.init(WSP(bf16_t, WS_OW), 512, WSP(bf16_t, WS_WBRS), 512, M_, D_, gridDim.x, blockIdx.x);
      pg8::Epi<pg8::EP_MG2> E{WSP(bf16_t, WS_MG), D_, WSP(bf16_t, WS_Z) + ZGB, NZ, nullptr, nullptr};
      pg8::gemm_phase<pg8::Epi<pg8::EP_MG2>, pg8::DenseSched, false>(lds, wv, 512, 512, 512, S, E); }
}
__device__ __forceinline__ void fs_out(const P& p, LAS unsigned char* lds, const int wv) {
    pg8::DenseSched S; S.init(WSP(bf16_t, WS_MG), D_, WSP(bf16_t, WS_WOUT), D_, M_, D_, gridDim.x, blockIdx.x);
    pg8::Epi<pg8::EP_RES> E{nullptr, 0, nullptr, 0, p.x, p.out, nullptr, nullptr};
    pg8::gemm_phase<pg8::Epi<pg8::EP_RES>, pg8::DenseSched, false>(lds, wv, D_, D_, D_, S, E);
}
__device__ __forceinline__ void fs_gu(const P& p, LAS unsigned char* lds, const int wv) {
    const int T = __builtin_amdgcn_readfirstlane((int)(WSP(unsigned, WS_CTL)[CW_BASE + NE] / 256u));
    LAS int* te = (LAS int*)(lds + TILEE_LDS);
    for (int i = tid_of(wv); i < NSLOT / 256; i += NT) te[i] = WSP(int, WS_TILEE)[i];
    __syncthreads();
    MoeSched S; S.init(WSP(bf16_t, WS_H2), D_ / 2, WSP(bf16_t, WS_WGU), D_ / 2, 512, te, WSP(int, WS_LTOK), T, true, gridDim.x, blockIdx.x);
    pg8::Epi<pg8::EP_HID> E{WSP(bf16_t, WS_HID), EFF, nullptr, 0, WSP(float, WS_LW), nullptr, WSP(float, WS_LR), nullptr};
    pg8::gemm_phase<pg8::Epi<pg8::EP_HID>, MoeSched, true, true>(lds, wv, D_ / 2, D_ / 2, D_ / 2, S, E);
}
__device__ __forceinline__ void fs_down(const P& p, LAS unsigned char* lds, const int wv) {
    const int T = __builtin_amdgcn_readfirstlane((int)(WSP(unsigned, WS_CTL)[CW_BASE + NE] / 256u));
    LAS int* te = (LAS int*)(lds + TILEE_LDS);
    for (int i = tid_of(wv); i < NSLOT / 256; i += NT) te[i] = WSP(int, WS_TILEE)[i];
    __syncthreads();
    MoeSched S; S.init(WSP(bf16_t, WS_HID), EFF / 2, WSP(bf16_t, WS_WDN), EFF / 2, 1024, te, WSP(int, WS_LTOK), T, false, gridDim.x, blockIdx.x);
    pg8::Epi<pg8::EP_DOWN> E{WSP(bf16_t, WS_Y), D_, nullptr, 0, nullptr, p.out};
    pg8::gemm_phase<pg8::Epi<pg8::EP_DOWN>, MoeSched, false, true>(lds, wv, EFF / 2, EFF / 2, EFF / 2, S, E);
}
__device__ __forceinline__ void fs_pp(const P& p, LAS unsigned char* lds, const int wv) {
    const int wg = (int)blockIdx.x; constexpr int NEVER = 1 << 20;
    if (wg < 128) return;
    pg8::DenseSched S; if (wg >= 192) { S.init(WSP(bf16_t, WS_PB), 256, WSP(bf16_t, WS_WPP), 256, M_, D_, 64, wg - 192); S.lim = 192; } else S.init(WSP(bf16_t, WS_PB), 256, WSP(bf16_t, WS_WPP), 256, M_, D_, NEVER, 192 + (wg - 128));
    pg8::Epi<pg8::EP_BF16> E{WSP(bf16_t, WS_PP), D_, nullptr, 0, nullptr, nullptr};
    pg8::gemm_phase<pg8::Epi<pg8::EP_BF16>, pg8::DenseSched, false>(lds, wv, 256, 256, 256, S, E);
}
__device__ __forceinline__ void fs_ple(const P& p, LAS unsigned char* lds, const int wv) {
    pg8::DenseSched S; S.init(WSP(bf16_t, WS_H3F8), D_ / 2, WSP(bf16_t, WS_WPG), D_ / 2, M_, D_, gridDim.x, blockIdx.x);
    pg8::Epi<pg8::EP_PLE> E{WSP(bf16_t, WS_H3), D_, WSP(bf16_t, WS_PP), D_, p.b_ple, p.out, WSP(float, WS_INV3), nullptr};
    pg8::gemm_phase<pg8::Epi<pg8::EP_PLE>, pg8::DenseSched, false, true>(lds, wv, D_ / 2, D_ / 2, D_ / 2, S, E);
}
namespace fa {
typedef short bf16x8 __attribute__((ext_vector_type(8)));
typedef short s16x4 __attribute__((ext_vector_type(4)));
typedef float f32x16 __attribute__((ext_vector_type(16)));
typedef unsigned u32x4 __attribute__((ext_vector_type(4)));
typedef unsigned u32x2 __attribute__((ext_vector_type(2)));
__device__ __forceinline__ unsigned cvtpk(float lo, float hi) { unsigned r; asm volatile("v_cvt_pk_bf16_f32 %0, %1, %2" : "=v"(r) : "v"(lo), "v"(hi)); return r; }
__device__ __forceinline__ int crow(int r, int hi) { return (r & 3) + 8 * (r >> 2) + 4 * hi; }

struct BgConv { int item, step, ngw; bool loaded; ConvJob job; f32x4_t v[8]; };
__device__ __forceinline__ void conv_finish_(const ConvJob& j, int lane, const f32x4_t (&v)[8], LAS float* scr) { conv_finish(j, lane, v, scr); }
__device__ __forceinline__ void bg_tick(const P& p, BgConv& g, int lane, LAS float* scr) {
    if (g.loaded) { conv_finish(g.job, lane, g.v, scr); g.loaded = false; g.item += g.ngw; }
    else if (g.item < CONV_NITEMS && (g.step & 3) == 0) { g.job = conv_job(p, g.item); conv_load(g.job, lane, g.v); g.loaded = true; }
    ++g.step;
}
template <int DK, bool SWA>
__device__ __forceinline__ void attn_unit(const P& p, LAS unsigned char* lds, const int wv, const int b, const int h, const int qb, const float gmax, BgConv& bg) {
    constexpr int PK = DK * 2 + 16, PV = 136, KBYTES = 64 * PK, BUF = KBYTES + 64 * PV, KS = DK / 16, CPR = DK / 8;
    int tid = tid_of(wv); asm volatile("" : "+v"(tid));
    const int lane = tid & 63, wave = wv, r32 = lane & 31, hi = lane >> 5;
    const int q0w = qb * 256 + wave * 32;
    const bf16_t* Qg = (SWA ? WSP(bf16_t, WS_QS) : WSP(bf16_t, WS_QM)) + ((size_t)(b * 8 + h) * S_ + q0w + r32) * DK;
    const int kvh = SWA ? (b * 2 + h / 4) : (b * 8 + h);
    const bf16_t* Kg = (SWA ? WSP(bf16_t, WS_KS) : WSP(bf16_t, WS_KM)) + (size_t)kvh * S_ * DK;
    const bf16_t* Vg = (SWA ? WSP(bf16_t, WS_VTS) : WSP(bf16_t, WS_VTM)) + (size_t)kvh * 64 * S_;
    bf16x8 qf[KS];
#pragma unroll
    for (int s = 0; s < KS; ++s) qf[s] = *(const bf16x8*)(Qg + 16 * s + 8 * hi);
    int t0 = 0, t1 = S_ / 64;
    if (SWA) { const int kmin = max(0, qb * 256 - 128), kmax = min(S_ - 1, qb * 256 + 255 + 128); t0 = kmin / 64; t1 = kmax / 64 + 1; }
    const int wk0 = q0w - 128, wk1 = q0w + 31 + 128;
    const int qpos = q0w + r32;
    const int kc0 = tid, kc1 = 512 + tid;
    const bool k1on = (64 * CPR > 512) && (tid < 64 * CPR - 512);
    const unsigned kd0 = (unsigned)((kc0 / CPR) * PK + (kc0 % CPR) * 16), kd1 = (unsigned)((kc1 / CPR) * PK + (kc1 % CPR) * 16);
    const int vd = tid >> 3, vp = tid & 7;
    const unsigned vdst = (unsigned)(KBYTES + vd * PV + vp * 16);
    u32x4 ak0, ak1 = {0u, 0u, 0u, 0u}, av, bk0, bk1 = {0u, 0u, 0u, 0u}, bv;
#define FA_LOAD(K0, K1, V, t) do { const int k0_ = (t) * 64; K0 = *(const u32x4*)(Kg + (size_t)k0_ * DK + kc0 * 8); if (k1on) K1 = *(const u32x4*)(Kg + (size_t)k0_ * DK + kc1 * 8); \
        V = *(const u32x4*)(Vg + (size_t)vd * S_ + k0_ + vp * 8); } while (0)
#define FA_WRITE(K0, K1, V, bufo) do { *(LAS u32x4*)(lds + (bufo) + kd0) = K0; if (k1on) *(LAS u32x4*)(lds + (bufo) + kd1) = K1; \
        *(LAS u32x2*)(lds + (bufo) + vdst) = (u32x2){V.x, V.y}; *(LAS u32x2*)(lds + (bufo) + vdst + 8) = (u32x2){V.z, V.w}; } while (0)
    float l_run; f32x16 o0, o1; bf16x8 qx;
#pragma unroll
    for (int r = 0; r < 16; ++r) { o0[r] = 0.f; o1[r] = 0.f; }
    { float q2 = 0.f;
#pragma unroll
      for (int s = 0; s < KS; ++s)
#pragma unroll
          for (int j = 0; j < 8; ++j) { const float x = __uint_as_float((unsigned)(unsigned short)qf[s][j] << 16); q2 += x * x; }
      { auto ra = __builtin_amdgcn_permlane32_swap(__float_as_uint(q2), __float_as_uint(q2), false, false); q2 = __uint_as_float(ra[0]) + __uint_as_float(ra[1]); }
      float m = fminf(sqrtf(q2) * 1.01f * gmax * sqrtf((float)DK), 60.f);
      const float sk = SWA ? p.sink[h] * LOG2E : 0.f;
      if (SWA) m = fmaxf(m, fminf(sk, 60.f));
      const bf16_t hm = f2bf(-m);
      l_run = (SWA && hi == 0) ? exp2f(sk + bf2f(hm)) : 0.f;
      qx = (bf16x8){(short)(hi == 0 ? hm : 0), 0, 0, 0, 0, 0, 0, 0}; }
    if (tid < 64) { const u32x4 one = {0x00003F80u, 0u, 0u, 0u}; *(LAS u32x4*)(lds + tid * PK + DK * 2) = one; *(LAS u32x4*)(lds + BUF + tid * PK + DK * 2) = one; }
    FA_LOAD(ak0, ak1, av, t0); FA_WRITE(ak0, ak1, av, 0);
    if (t0 + 1 < t1) FA_LOAD(ak0, ak1, av, t0 + 1);
    __syncthreads();
    auto tile = [&](const int bufo, const int k0) __attribute__((always_inline)) {
        const bool active = !SWA || !(k0 + 63 < wk0 || k0 > wk1);
        if (active) {
            f32x16 s0, s1;
            { const bf16x8 ka = *(const LAS bf16x8*)(lds + bufo + r32 * PK + DK * 2 + 16 * hi);
              const bf16x8 kb = *(const LAS bf16x8*)(lds + bufo + (32 + r32) * PK + DK * 2 + 16 * hi);
              const f32x16 z = {0.f, 0.f, 0.f, 0.f, 0.f, 0.f, 0.f, 0.f, 0.f, 0.f, 0.f, 0.f, 0.f, 0.f, 0.f, 0.f};
              s0 = __builtin_amdgcn_mfma_f32_32x32x16_bf16(ka, qx, z, 0, 0, 0); s1 = __builtin_amdgcn_mfma_f32_32x32x16_bf16(kb, qx, z, 0, 0, 0); }
#pragma unroll
            for (int s = 0; s < KS; ++s) {
                const bf16x8 ka = *(const LAS bf16x8*)(lds + bufo + r32 * PK + 32 * s + 16 * hi);
                const bf16x8 kb = *(const LAS bf16x8*)(lds + bufo + (32 + r32) * PK + 32 * s + 16 * hi);
                s0 = __builtin_amdgcn_mfma_f32_32x32x16_bf16(ka, qf[s], s0, 0, 0, 0);
                s1 = __builtin_amdgcn_mfma_f32_32x32x16_bf16(kb, qf[s], s1, 0, 0, 0);
            }
            if (SWA && (k0 < q0w + 31 - 128 || k0 + 63 > q0w + 128)) {
#pragma unroll
                for (int r = 0; r < 16; ++r) { const int d0 = k0 + crow(r, hi) - qpos, d1 = d0 + 32;
                    if (d0 > 128 || d0 < -128) s0[r] = -1e30f; if (d1 > 128 || d1 < -128) s1[r] = -1e30f; }
            }
            s16x4 va0[4], va1[4], vc0[4], vc1[4];
#pragma unroll
            for (int i = 0; i < 4; ++i) { const unsigned vo = (unsigned)(bufo + KBYTES + r32 * PV + (32 * (i >> 1) + 16 * (i & 1) + 4 * hi) * 2);
                va0[i] = *(const LAS s16x4*)(lds + vo); va1[i] = *(const LAS s16x4*)(lds + vo + 16); vc0[i] = *(const LAS s16x4*)(lds + vo + 32 * PV); vc1[i] = *(const LAS s16x4*)(lds + vo + 32 * PV + 16); }
            __builtin_amdgcn_sched_barrier(0);
            float ls = 0.f;
#pragma unroll
            for (int r = 0; r < 16; ++r) { s0[r] = __builtin_amdgcn_exp2f(s0[r]); s1[r] = __builtin_amdgcn_exp2f(s1[r]); ls += s0[r] + s1[r]; }
            l_run += ls;
#pragma unroll
            for (int i = 0; i < 4; ++i) {
                u32x4 pw;
                if (i < 2) { pw.x = cvtpk(s0[8 * i + 0], s0[8 * i + 1]); pw.y = cvtpk(s0[8 * i + 2], s0[8 * i + 3]); pw.z = cvtpk(s0[8 * i + 4], s0[8 * i + 5]); pw.w = cvtpk(s0[8 * i + 6], s0[8 * i + 7]); }
                else { const int s2 = i - 2; pw.x = cvtpk(s1[8 * s2 + 0], s1[8 * s2 + 1]); pw.y = cvtpk(s1[8 * s2 + 2], s1[8 * s2 + 3]); pw.z = cvtpk(s1[8 * s2 + 4], s1[8 * s2 + 5]); pw.w = cvtpk(s1[8 * s2 + 6], s1[8 * s2 + 7]); }
                const bf16x8 pf = __builtin_bit_cast(bf16x8, pw);
                const bf16x8 va = (bf16x8){va0[i][0], va0[i][1], va0[i][2], va0[i][3], va1[i][0], va1[i][1], va1[i][2], va1[i][3]};
                const bf16x8 vc = (bf16x8){vc0[i][0], vc0[i][1], vc0[i][2], vc0[i][3], vc1[i][0], vc1[i][1], vc1[i][2], vc1[i][3]};
                o0 = __builtin_amdgcn_mfma_f32_32x32x16_bf16(va, pf, o0, 0, 0, 0);
                o1 = __builtin_amdgcn_mfma_f32_32x32x16_bf16(vc, pf, o1, 0, 0, 0);
            }
        }
    };
    LAS float* bgscr = (LAS float*)(lds + 2 * BUF + 1024) + wave * (64 * 33);
    for (int t = t0; t < t1; t += 2) {
        if (t + 2 < t1) FA_LOAD(bk0, bk1, bv, t + 2);
        tile(0, t * 64);
        if (t + 1 < t1) FA_WRITE(ak0, ak1, av, BUF);
        bg_tick(p, bg, lane, bgscr);
        __syncthreads();
        if (t + 1 < t1) {
            if (t + 3 < t1) FA_LOAD(ak0, ak1, av, t + 3);
            tile(BUF, (t + 1) * 64);
            if (t + 2 < t1) FA_WRITE(bk0, bk1, bv, 0);
            bg_tick(p, bg, lane, bgscr);
            __syncthreads();
        }
    }
#undef FA_LOAD
#undef FA_WRITE
    float lt; { auto rl = __builtin_amdgcn_permlane32_swap(__float_as_uint(l_run), __float_as_uint(l_run), false, false); lt = __uint_as_float(rl[0]) + __uint_as_float(rl[1]); } const float il = 1.f / lt;
    bf16_t* Og = (SWA ? WSP(bf16_t, WS_OW) : WSP(bf16_t, WS_OM)) + (size_t)(b * S_ + qpos) * 512 + h * 64;
#pragma unroll
    for (int g = 0; g < 4; ++g) {
        u32x2 w0, w1;
        w0.x = cvtpk(o0[4 * g + 0] * il, o0[4 * g + 1] * il); w0.y = cvtpk(o0[4 * g + 2] * il, o0[4 * g + 3] * il);
        w1.x = cvtpk(o1[4 * g + 0] * il, o1[4 * g + 1] * il); w1.y = cvtpk(o1[4 * g + 2] * il, o1[4 * g + 3] * il);
        *(u32x2*)(Og + 8 * g + 4 * hi) = w0; *(u32x2*)(Og + 32 + 8 * g + 4 * hi) = w1;
    }
}
}
__device__ __forceinline__ void fs_attn(const P& p, LAS unsigned char* lds, const int wv) {
    const int G = gridDim.x, bx = blockIdx.x; const int vcu = (G % 8 == 0) ? (bx % 8) * (G / 8) + bx / 8 : bx;
    float gm, gs;
    { const int l = tid_of(0); float a = (l < 96) ? fabsf(p.g_kn_mla[l]) : 0.f; if (l + 64 < 96) a = fmaxf(a, fabsf(p.g_kn_mla[l + 64])); float c = (l < 64) ? fabsf(p.g_kn_swa[l]) : 0.f;
      a = wave_max(a); c = wave_max(c); gm = __uint_as_float(__builtin_amdgcn_readfirstlane(__float_as_uint(a))); gs = __uint_as_float(__builtin_amdgcn_readfirstlane(__float_as_uint(c))); }
    fa::BgConv bg; bg.item = CONV_EARLY + bx * (NT / 64) + wv; bg.step = 0; bg.ngw = G * (NT / 64); bg.loaded = false;
    for (int U = vcu; U < 512; U += G) { const int bh = U >> 3, qb = U & 7; fa::attn_unit<96, false>(p, lds, wv, bh >> 3, bh & 7, qb, gm, bg); }
    for (int U = vcu; U < 512; U += G) { const int bh = U >> 3, qb = U & 7; fa::attn_unit<64, true>(p, lds, wv, bh >> 3, bh & 7, qb, gs, bg); }
    { const int lane = tid_of(0); LAS float* scr = (LAS float*)(lds + wv * 16384);
      if (bg.loaded) { fa::conv_finish_(bg.job, lane, bg.v, scr); bg.item += bg.ngw; }
      for (; bg.item < CONV_NITEMS; bg.item += bg.ngw) { bg.job = conv_job(p, bg.item); conv_load(bg.job, lane, bg.v); fa::conv_finish_(bg.job, lane, bg.v, scr); } }
}

__device__ __forceinline__ void st_wrconv(const P& p, size_t gt, size_t ngt) {
    bf16_t* wrh = WSP(bf16_t, WS_WRH); bf16_t* wrl = WSP(bf16_t, WS_WRL);
    for (size_t i = gt; i < (size_t)NE * D_; i += ngt) { const int e = (int)(i >> 10), k = (int)(i & 1023);
        const float v = p.g_moe[k] * p.w_router[(size_t)k * NE + e]; const bf16_t h = f2bf(v); wrh[i] = h; wrl[i] = f2bf(v - bf2f(h)); }
}
__device__ __forceinline__ void st_route(const P& p, int wg, int nwg, int wave, int lane, LAS unsigned char* lds, int cnt_off = 0) {
    typedef short bf16x8 __attribute__((ext_vector_type(8))); typedef float f32x16 __attribute__((ext_vector_type(16)));
    const int r32 = lane & 31, hi = lane >> 5;
    LAS float* part = (LAS float*)lds; LAS float* ssq = (LAS float*)(lds + 131072);
    const bf16_t* WRH = WSP(bf16_t, WS_WRH); const bf16_t* WRL = WSP(bf16_t, WS_WRL);
    int* tope = WSP(int, WS_TOPE); float* topw = WSP(float, WS_TOPW); int* topls = WSP(int, WS_TOPLS); float* rstd2 = WSP(float, WS_RSTD2);
    unsigned char* h2f8 = WSP(unsigned char, WS_H2);
    int* wcnt = WSP(int, WS_WCNT) + cnt_off; int* tcnt = WSP(int, WS_TCNT) + (cnt_off ? 16384 : 0);
    LAS int* cntl = (LAS int*)(lds + 131072 + 2048);
    for (int tile = wg; tile < M_ / 64; tile += nwg) {
        f32x16 acc[2][2];
#pragma unroll
        for (int a = 0; a < 2; ++a)
#pragma unroll
            for (int b = 0; b < 2; ++b)
#pragma unroll
                for (int r = 0; r < 16; ++r) acc[a][b][r] = 0.f;
        float sq[2] = {0.f, 0.f};
        const float* xb = p.out + (size_t)(tile * 64 + r32) * D_ + wave * 128 + 8 * hi;
        const bf16_t* whb = WRH + (size_t)r32 * D_ + wave * 128 + 8 * hi; const bf16_t* wlb = WRL + (size_t)r32 * D_ + wave * 128 + 8 * hi;
#pragma unroll 2
        for (int s = 0; s < 8; ++s) {
            bf16x8 xh[2], xl[2], wh[2], wl[2];
#pragma unroll
            for (int tb = 0; tb < 2; ++tb) {
                const float* xp = xb + (size_t)(32 * tb) * D_ + 16 * s; const f32x4_t a = *(const f32x4_t*)xp, b = *(const f32x4_t*)(xp + 4);
                sq[tb] += (a.x * a.x + a.y * a.y) + (a.z * a.z + a.w * a.w) + (b.x * b.x + b.y * b.y) + (b.z * b.z + b.w * b.w);
                u32x4_t h, l;
                h.x = cvtpk_(a.x, a.y); h.y = cvtpk_(a.z, a.w); h.z = cvtpk_(b.x, b.y); h.w = cvtpk_(b.z, b.w);
                l.x = cvtpk_(a.x - bflo(h.x), a.y - bfhi(h.x)); l.y = cvtpk_(a.z - bflo(h.y), a.w - bfhi(h.y));
                l.z = cvtpk_(b.x - bflo(h.z), b.y - bfhi(h.z)); l.w = cvtpk_(b.z - bflo(h.w), b.w - bfhi(h.w));
                xh[tb] = __builtin_bit_cast(bf16x8, h); xl[tb] = __builtin_bit_cast(bf16x8, l);
            }
#pragma unroll
            for (int eb = 0; eb < 2; ++eb) { wh[eb] = *(const bf16x8*)(whb + (size_t)(32 * eb) * D_ + 16 * s); wl[eb] = *(const bf16x8*)(wlb + (size_t)(32 * eb) * D_ + 16 * s); }
#pragma unroll
            for (int tb = 0; tb < 2; ++tb)
#pragma unroll
                for (int eb = 0; eb < 2; ++eb) {
                    acc[tb][eb] = __builtin_amdgcn_mfma_f32_32x32x16_bf16(xh[tb], wh[eb], acc[tb][eb], 0, 0, 0);
                    acc[tb][eb] = __builtin_amdgcn_mfma_f32_32x32x16_bf16(xh[tb], wl[eb], acc[tb][eb], 0, 0, 0);
                    acc[tb][eb] = __builtin_amdgcn_mfma_f32_32x32x16_bf16(xl[tb], wh[eb], acc[tb][eb], 0, 0, 0);
                }
        }
#pragma unroll
        for (int tb = 0; tb < 2; ++tb) {
#pragma unroll
            for (int eb = 0; eb < 2; ++eb)
#pragma unroll
                for (int r = 0; r < 16; ++r) part[(wave * 64 + 32 * tb + (r & 3) + 8 * (r >> 2) + 4 * hi) * 64 + 32 * eb + r32] = acc[tb][eb][r];
            const float st = sq[tb] + __shfl_xor(sq[tb], 32);
            if (hi == 0) ssq[wave * 64 + 32 * tb + r32] = st;
        }
        __syncthreads();
        int cw = 0;
        for (int tt = 0; tt < 8; ++tt) {
            const int tok = wave * 8 + tt, m = tile * 64 + tok;
            const float* xr = p.out + (size_t)m * D_ + lane * 16;
            const f32x4_t x0 = *(const f32x4_t*)xr, x1v = *(const f32x4_t*)(xr + 4), x2v = *(const f32x4_t*)(xr + 8), x3v = *(const f32x4_t*)(xr + 12);
            float lg = 0.f, ss = 0.f;
#pragma unroll
            for (int w = 0; w < 8; ++w) { lg += part[(w * 64 + tok) * 64 + lane]; ss += ssq[w * 64 + tok]; }
            const float rstd = 1.f / sqrtf(ss * (1.f / D_) + EPS);
            const float score = sigmoidf_(lg * rstd); const float sel = score + p.router_bias[lane];
            float m1 = sel;
            m1 = fmaxf(m1, __shfl_xor(m1, 1)); m1 = fmaxf(m1, __shfl_xor(m1, 2)); m1 = fmaxf(m1, __shfl_xor(m1, 4));
            const unsigned long long eqm = __ballot(sel == m1);
            const int g = lane >> 3; const unsigned gm = (unsigned)((eqm >> (g * 8)) & 0xffull);
            const int first = __ffs((int)gm) - 1;
            float v2 = ((lane & 7) == first) ? -3.0e38f : sel;
            v2 = fmaxf(v2, __shfl_xor(v2, 1)); v2 = fmaxf(v2, __shfl_xor(v2, 2)); v2 = fmaxf(v2, __shfl_xor(v2, 4));
            const float gs = m1 + v2;
            int grank = 0;
#pragma unroll
            for (int j = 0; j < 8; ++j) { const float o = __shfl(gs, j * 8); grank += (o > gs || (o == gs && j < g)) ? 1 : 0; }
            const float msel = (grank < 4) ? sel : -1e30f;
            int rank = 0;
            for (int j = 0; j < 64; ++j) { const float o = __uint_as_float((unsigned)__builtin_amdgcn_readlane((int)__float_as_uint(msel), j)); rank += (o > msel || (o == msel && j < lane)) ? 1 : 0; }
            const bool chosen = rank < TOPK;
            const float wsum = wave_sum(chosen ? score : 0.f);
            if (chosen) { tope[m * TOPK + rank] = lane; topw[m * TOPK + rank] = score / wsum * 2.5f; topls[m * TOPK + rank] = cw; ++cw; }
            if (lane == 0) rstd2[m] = rstd;
            { const float q = rstd * pg8::XN_SC; u32x4_t w; int d;
              d = 0; d = __builtin_amdgcn_cvt_pk_fp8_f32(x0.x * q, x0.y * q, d, false); d = __builtin_amdgcn_cvt_pk_fp8_f32(x0.z * q, x0.w * q, d, true); w.x = (unsigned)d;
              d = 0; d = __builtin_amdgcn_cvt_pk_fp8_f32(x1v.x * q, x1v.y * q, d, false); d = __builtin_amdgcn_cvt_pk_fp8_f32(x1v.z * q, x1v.w * q, d, true); w.y = (unsigned)d;
              d = 0; d = __builtin_amdgcn_cvt_pk_fp8_f32(x2v.x * q, x2v.y * q, d, false); d = __builtin_amdgcn_cvt_pk_fp8_f32(x2v.z * q, x2v.w * q, d, true); w.z = (unsigned)d;
              d = 0; d = __builtin_amdgcn_cvt_pk_fp8_f32(x3v.x * q, x3v.y * q, d, false); d = __builtin_amdgcn_cvt_pk_fp8_f32(x3v.z * q, x3v.w * q, d, true); w.w = (unsigned)d;
              *(u32x4_t*)(h2f8 + (size_t)m * D_ + lane * 16) = w; }
        }
        wcnt[(tile * 8 + wave) * NE + lane] = cw; cntl[wave * 64 + lane] = cw;
        __syncthreads();
        if (wave == 0) { int t = 0;
#pragma unroll
            for (int w = 0; w < 8; ++w) t += cntl[w * 64 + lane];
            tcnt[tile * NE + lane] = t; }
    }
}
__device__ __forceinline__ void st_lists(const P& p, size_t gt, size_t ngt, int tid, int wg, int nwg, LAS unsigned* L) {
    const int* wcnt = WSP(int, WS_WCNT); const int* tcnt = WSP(int, WS_TCNT); unsigned* basew = WSP(unsigned, WS_CTL) + CW_BASE;
    const int* tope = WSP(int, WS_TOPE); const float* topw = WSP(float, WS_TOPW); const int* topls = WSP(int, WS_TOPLS); const float* rstd2 = WSP(float, WS_RSTD2);
    int* pos = WSP(int, WS_POS); int* ltok = WSP(int, WS_LTOK); float* lw = WSP(float, WS_LW); float* lr = WSP(float, WS_LR); int* tile_e = WSP(int, 5 * MiB);
    const int w8 = tid >> 6, e = tid & 63;
    for (int tile = wg; tile < M_ / 64; tile += nwg) {
        __syncthreads();
        { int tot = 0, pre = 0;
#pragma unroll
          for (int i = w8; i < 256; i += 8) { const int v = tcnt[i * NE + e]; tot += v; pre += (i < tile) ? v : 0; }
          L[tid] = (unsigned)tot; L[512 + tid] = (unsigned)pre; }
        __syncthreads();
        if (tid < 64) { unsigned tot = 0, pre = 0;
#pragma unroll
            for (int w = 0; w < 8; ++w) { tot += L[w * 64 + tid]; pre += L[512 + w * 64 + tid]; }
            const unsigned pc = (tot + 255u) & ~255u; unsigned v = pc;
#pragma unroll
            for (int o = 1; o < 64; o <<= 1) { const unsigned t = __shfl_up(v, o); if (tid >= o) v += t; }
            L[1024 + tid] = v - pc; L[1088 + tid] = tot; if (tid == 63) L[1152] = v;
            unsigned run = v - pc + pre;
#pragma unroll
            for (int w = 0; w < 8; ++w) { L[1216 + w * 64 + tid] = run; run += (unsigned)wcnt[(tile * 8 + w) * NE + tid]; } }
        __syncthreads();
        { const int i = tile * 512 + tid; const int ex = tope[i], tok = i >> 3, w = (tok & 63) >> 3;
          const int slot = (int)L[1216 + w * 64 + ex] + topls[i];
          pos[i] = slot; ltok[slot] = tok; lw[slot] = topw[i]; lr[slot] = rstd2[tok]; }
    }
    for (size_t i = gt; i < (size_t)NE * 256; i += ngt) {
        const int ex = (int)(i / 256), j = (int)(i % 256); const unsigned base = L[1024 + ex], n = L[1088 + ex], np = (n + 255u) & ~255u;
        if (n + j < np) { ltok[base + n + j] = 0; lw[base + n + j] = 0.f; lr[base + n + j] = 0.f; }
    }
    if (gt < 64) basew[gt] = L[1024 + gt];
    if (gt == 64) basew[NE] = L[1152];
    for (size_t i = gt; i < (size_t)(NSLOT / 256); i += ngt) { int ex = -1;
        for (int q = 0; q < NE; ++q) { const unsigned b0 = L[1024 + q], b1 = b0 + ((L[1088 + q] + 255u) & ~255u); if ((unsigned)i * 256u >= b0 && (unsigned)i * 256u < b1) ex = q; }
        tile_e[i] = ex; }
    for (size_t i = gt; i < (size_t)M_; i += ngt) { ltok[NSLOT + i] = (int)i; lw[NSLOT + i] = 1.f; lr[NSLOT + i] = rstd2[i]; }
}
__device__ __forceinline__ void st_combine(const P& p, int gw, int ngw, int lane, bool dry = false) {
    typedef float f32x2_t __attribute__((ext_vector_type(2)));
    const int* pos = WSP(int, WS_POS); const unsigned char* Y8 = WSP(unsigned char, WS_Y); bf16_t* h3 = WSP(bf16_t, WS_H3);
    for (int m = gw; m < M_; m += ngw) {
        f32x4_t* xr = (f32x4_t*)(p.out + (size_t)m * D_) + 4 * lane; f32x4_t v[4];
        int ps[TOPK];
#pragma unroll
        for (int k = 0; k < TOPK; ++k) ps[k] = __builtin_amdgcn_readfirstlane(pos[m * TOPK + k]);
#pragma unroll
        for (int j = 0; j < 4; ++j) v[j] = xr[j];
        u32x4_t y[TOPK + 1];
#pragma unroll
        for (int k = 0; k < TOPK + 1; ++k) y[k] = ((const u32x4_t*)(Y8 + (size_t)(k < TOPK ? ps[k] : NSLOT + m) * 1024))[lane];
        f32x4_t acc[4];
#pragma unroll
        for (int j = 0; j < 4; ++j) acc[j] = (f32x4_t){0.f, 0.f, 0.f, 0.f};
#pragma unroll
        for (int k = 0; k < TOPK + 1; ++k)
#pragma unroll
            for (int j = 0; j < 4; ++j) { const int w = (int)y[k][j]; const f32x2_t lo = __builtin_amdgcn_cvt_pk_f32_fp8(w, false), hi = __builtin_amdgcn_cvt_pk_f32_fp8(w, true);
                acc[j].x += lo.x; acc[j].y += lo.y; acc[j].z += hi.x; acc[j].w += hi.y; }
        float s = 0.f;
#pragma unroll
        for (int j = 0; j < 4; ++j) { v[j] = v[j] + acc[j] * (1.f / 16.f); s += (v[j].x * v[j].x + v[j].y * v[j].y) + (v[j].z * v[j].z + v[j].w * v[j].w); }
        s = wave_sum(s); const float rr = sqrtf(s * (1.f / D_) + EPS), r = 1.f / rr;
        if (lane == 0 && !dry) WSP(float, WS_INV3)[m] = rr;
        u32x4_t* o = (u32x4_t*)(h3 + (size_t)m * D_) + 2 * lane;
        o[0] = (u32x4_t){cvtpk_(v[0].x * r, v[0].y * r), cvtpk_(v[0].z * r, v[0].w * r), cvtpk_(v[1].x * r, v[1].y * r), cvtpk_(v[1].z * r, v[1].w * r)};
        o[1] = (u32x4_t){cvtpk_(v[2].x * r, v[2].y * r), cvtpk_(v[2].z * r, v[2].w * r), cvtpk_(v[3].x * r, v[3].y * r), cvtpk_(v[3].z * r, v[3].w * r)};
        { const float q = r * 8.f; u32x4_t w;
#pragma unroll
          for (int j = 0; j < 4; ++j) { int d = 0; d = __builtin_amdgcn_cvt_pk_fp8_f32(v[j].x * q, v[j].y * q, d, false); d = __builtin_amdgcn_cvt_pk_fp8_f32(v[j].z * q, v[j].w * q, d, true); w[j] = (unsigned)d; }
          ((u32x4_t*)(WSP(unsigned char, WS_H3F8) + (size_t)m * D_))[lane] = w; }
    }
}

#ifndef FAST_MASK
#define FAST_MASK 0xffff
#endif
constexpr int LDS_DYN = 144 * 1024;
constexpr int MISC_OFF = 132 * 1024;
constexpr int N_STAGES = 13;
__global__ void __launch_bounds__(NT) k_fwd(P p) {
    extern __shared__ __attribute__((aligned(16))) unsigned char lds[];
    const int wave_s = __builtin_amdgcn_readfirstlane((int)threadIdx.x >> 6);
    const int tid0 = tid_of(wave_s);
    volatile LAS unsigned* misc = (volatile LAS unsigned*)((LAS unsigned char*)lds + MISC_OFF);
    if (tid0 < 16) misc[tid0] = 0u;
    __syncthreads();
    XcdBarrier bar = xcd_barrier_post(WSP(unsigned, WS_CTL) + CW_BAR, misc, wave_s);
    const int lo = p.st_lo, hi = p.st_hi;
#ifdef TIME_STAGE
    unsigned long long* stamps = (unsigned long long*)(p.ws + 5 * MiB + 65536);
    if (blockIdx.x == 0 && tid_of(wave_s) == 0) stamps[0] = __builtin_amdgcn_s_memrealtime();
#define STAMP(k) do { if (blockIdx.x == 0 && tid_of(wave_s) == 0) stamps[(k) + 1] = __builtin_amdgcn_s_memrealtime(); } while (0)
#else
#define STAMP(k) do {} while (0)
#endif
#ifndef DUP_STAGE
#define DUP_STAGE -1
#endif
#ifndef DUP_N
#define DUP_N 1
#endif
#if DUP_STAGE == 0
#define DUPCALL (st_prep(p, gw, ngw, lane), st_rope(p, gt, ngt), st_wrconv(p, gt, ngt), st_wconv(p, gw, ngw, lane, (LAS float*)((LAS unsigned char*)lds + wave * 16384)))
#elif DUP_STAGE == 1
#define DUPCALL fs_g1(p, (LAS unsigned char*)lds, wave_s)
#elif DUP_STAGE == 2
#define DUPCALL
#elif DUP_STAGE == 3
#define DUPCALL st_attn_prep(p, wg, nwg, wave, lane, (bf16_t*)lds)
#elif DUP_STAGE == 4
#define DUPCALL fs_attn(p, (LAS unsigned char*)lds, wave_s)
#elif DUP_STAGE == 5
#define DUPCALL fs_merge(p, (LAS unsigned char*)lds, wave_s)
#elif DUP_STAGE == 6
#define DUPCALL fs_out(p, (LAS unsigned char*)lds, wave_s)
#elif DUP_STAGE == 7
#define DUPCALL st_route(p, wg, nwg, wave, lane, (LAS unsigned char*)lds, 2048)
#elif DUP_STAGE == 8
#define DUPCALL st_lists(p, gt, ngt, tid, wg, nwg, (LAS unsigned*)((LAS unsigned char*)lds))
#elif DUP_STAGE == 9
#define DUPCALL fs_gu(p, (LAS unsigned char*)lds, wave_s)
#elif DUP_STAGE == 11
#define DUPCALL st_combine(p, gw, ngw, lane, true)
#else
#define DUPCALL
#endif
#define RUN(k, call) if (lo <= (k) && (k) < hi) { { int tid = tid_of(wave_s); asm volatile("" : "+v"(tid)); const int lane = tid & 63, wave = tid >> 6; const int wg = blockIdx.x, nwg = gridDim.x; \
        const int gw = wg * (NT / 64) + wave, ngw = nwg * (NT / 64); const size_t gt = (size_t)wg * NT + tid, ngt = (size_t)nwg * NT; \
        (void)lane; (void)wave; (void)wg; (void)nwg; (void)gw; (void)ngw; (void)gt; (void)ngt; \
        if ((k) == DUP_STAGE) { for (int d_ = 0; d_ < DUP_N; ++d_) { DUPCALL; xcd_barrier(bar); } } call; } if ((k) + 1 < hi) xcd_barrier(bar); STAMP(k); }
    RUN(0, (st_prep(p, gw, ngw, lane), st_rope(p, gt, ngt), st_wrconv(p, gt, ngt), st_wconv(p, gw, ngw, lane, (LAS float*)((LAS unsigned char*)lds + wave * 16384))))
    RUN(1, (fs_g1(p, (LAS unsigned char*)lds, wave_s), fs_g23(p, (LAS unsigned char*)lds, wave_s), fs_pp(p, (LAS unsigned char*)lds, wave_s)))
    STAMP(2);
    RUN(3, st_attn_prep(p, wg, nwg, wave, lane, (bf16_t*)lds))
    RUN(4, fs_attn(p, (LAS unsigned char*)lds, wave_s))
    RUN(5, fs_merge(p, (LAS unsigned char*)lds, wave_s))
    RUN(6, fs_out(p, (LAS unsigned char*)lds, wave_s))
    RUN(7, st_route(p, wg, nwg, wave, lane, (LAS unsigned char*)lds))
    RUN(8, st_lists(p, gt, ngt, tid, wg, nwg, (LAS unsigned*)((LAS unsigned char*)lds)))
    RUN(9, fs_gu(p, (LAS unsigned char*)lds, wave_s))
    RUN(10, fs_down(p, (LAS unsigned char*)lds, wave_s))
    RUN(11, st_combine(p, gw, ngw, lane))
    RUN(12, fs_ple(p, (LAS unsigned char*)lds, wave_s))
#undef RUN
#ifdef TIME_STAGE
    xcd_barrier(bar);
    if (tid_of(wave_s) == 0) { const unsigned long long d = __hip_atomic_load(&stamps[TIME_STAGE + 1], __ATOMIC_RELAXED, __HIP_MEMORY_SCOPE_AGENT) - __hip_atomic_load(&stamps[TIME_STAGE], __ATOMIC_RELAXED, __HIP_MEMORY_SCOPE_AGENT);
        const unsigned long long t0 = __builtin_amdgcn_s_memrealtime(); while (__builtin_amdgcn_s_memrealtime() - t0 < 4ull * d) __builtin_amdgcn_s_sleep(8); }
    __syncthreads();
#endif
}

extern "C" void kernel_launch(void* const* d_in, const int* in_sizes, int n_in, void* d_out, int out_size, void* d_ws, size_t ws_size, hipStream_t stream) {
    if (n_in != 29 || ws_size < WS_END) { fprintf(stderr, "kernel_launch: unexpected n_in %d or ws_size %zu\n", n_in, ws_size); return; }
    P p{};
    p.x = (const float*)d_in[0]; p.p = (const float*)d_in[1]; p.pos = (const int*)d_in[2];
#define IN_(name, i) p.name = (const float*)d_in[i]
    IN_(g_mix, 3); IN_(w_in, 4); IN_(b_gate, 5); IN_(g_cq, 6); IN_(w_uq, 7); IN_(g_ckv, 8); IN_(w_ukv, 9); IN_(g_qn_mla, 10); IN_(g_kn_mla, 11);
    IN_(g_qn_swa, 12); IN_(g_kn_swa, 13); IN_(sink, 14); IN_(w_br_mla, 15); IN_(w_br_swa, 16); IN_(w_out, 17); IN_(g_moe, 18); IN_(w_router, 19);
    IN_(router_bias, 20); IN_(w_exp_gu, 21); IN_(w_exp_down, 22); IN_(w_sh_gu, 23); IN_(w_sh_down, 24); IN_(g_ple, 25); IN_(w_ple_gate, 26); IN_(b_ple, 27); IN_(w_ple_proj, 28);
#undef IN_
    p.out = (float*)d_out; p.ws = (unsigned char*)d_ws;
    static int grid = 0;
    if (grid == 0) {
        int dev = 0, cus = 0, per_cu = 0;
        (void)hipGetDevice(&dev); (void)hipDeviceGetAttribute(&cus, hipDeviceAttributeMultiprocessorCount, dev);
        (void)hipFuncSetAttribute((const void*)k_fwd, hipFuncAttributeMaxDynamicSharedMemorySize, LDS_DYN);
        (void)hipOccupancyMaxActiveBlocksPerMultiprocessor(&per_cu, (const void*)k_fwd, NT, LDS_DYN);
        (void)hipGetLastError();
        if (per_cu < 1) { fprintf(stderr, "kernel_launch: occupancy query says %d blocks per CU\n", per_cu); grid = -1; return; }
        grid = cus;
    }
    if (grid < 0) return;
    (void)hipMemsetAsync((char*)d_ws + WS_CTL, 0, CTL_BYTES, stream);
    p.st_lo = 0; p.st_hi = N_STAGES;
    void* args[] = {&p};
    hipError_t e = hipLaunchCooperativeKernel((const void*)k_fwd, dim3(grid), dim3(NT), args, LDS_DYN, stream);
    if (e != hipSuccess) fprintf(stderr, "cooperative launch failed: %s (grid %d)\n", hipGetErrorString(e), grid);
}
```

```cpp
#include <hip/hip_runtime.h>
#include <stdint.h>
#include <cstdio>

constexpr int B_ = 8, S_ = 2048, D_ = 1024, M_ = B_ * S_;
constexpr int NZ = 3584;
constexpr int INW = 3488;
constexpr int ZQ = 0, ZKR = 384, ZCKV = 512, ZQS = 768, ZKS = 1280, ZVS = 1408, ZGA = 1536, ZGB = 2560;
constexpr int NE = 64, TOPK = 8, EFF = 256;
constexpr int NSLOT = M_ * TOPK + NE * 256;
constexpr float EPS = 1e-6f;
constexpr float LOG2E = 1.4426950408889634f;

typedef unsigned short bf16_t;
__device__ __forceinline__ float bf2f(bf16_t v) { return __uint_as_float((unsigned)v << 16); }
__device__ __forceinline__ bf16_t f2bf(float f) { unsigned u = __float_as_uint(f); return (bf16_t)((u + 0x7fffu + ((u >> 16) & 1u)) >> 16); }
__device__ __forceinline__ float sigmoidf_(float v) { return 1.f / (1.f + __expf(-v)); }
__device__ __forceinline__ float wave_sum(float v) {
#pragma unroll
    for (int o = 1; o < 64; o <<= 1) v += __shfl_xor(v, o);
    return v;
}
__device__ __forceinline__ float wave_max(float v) {
#pragma unroll
    for (int o = 1; o < 64; o <<= 1) v = fmaxf(v, __shfl_xor(v, o));
    return v;
}

constexpr size_t MiB = 1u << 20;
constexpr size_t WS_CTL = 0, CTL_BYTES = 64 * 1024;
constexpr size_t WS_TOPE = 1 * MiB, WS_TOPW = WS_TOPE + 512 * 1024, WS_TOPLS = WS_TOPW + 512 * 1024, WS_POS = WS_TOPLS + 512 * 1024;
constexpr size_t WS_LTOK = 3 * MiB, WS_LW = WS_LTOK + 640 * 1024;
constexpr size_t WS_PB = 6 * MiB, WS_WDN = 14 * MiB, WS_WPG = 48 * MiB, WS_WPP = 50 * MiB, WS_WSHDN = 46 * MiB;
constexpr size_t WS_HID = 51 * MiB, WS_HSH = 123 * MiB, WS_R = 131 * MiB;
constexpr size_t WS_WGU = 131 * MiB, WS_WSHGU = 195 * MiB, WS_WIN = 196 * MiB, WS_WUQ = 203 * MiB, WS_WUKV = 204 * MiB, WS_WBRM = 205 * MiB, WS_WBRS = 206 * MiB, WS_WOUT = 207 * MiB;
constexpr size_t WS_Z = 210 * MiB, WS_HB = 322 * MiB, WS_MG = 322 * MiB, WS_QMR = 354 * MiB, WS_OM = 354 * MiB, WS_OW = 370 * MiB, WS_KVR = 378 * MiB;
constexpr size_t WS_QM = 410 * MiB, WS_KM = 434 * MiB, WS_VTM = 458 * MiB, WS_QS = 474 * MiB, WS_KS = 490 * MiB, WS_VTS = 494 * MiB;
constexpr size_t WS_H3F8 = 31 * MiB;
constexpr size_t WS_H2 = 210 * MiB, WS_Y = 131 * MiB, WS_H3 = 419 * MiB, WS_PP = 93 * MiB, WS_END = 498 * MiB;
constexpr size_t WS_WRH = 209 * MiB, WS_WRL = WS_WRH + 128 * 1024, WS_RSTD2 = WS_WRL + 128 * 1024;
constexpr size_t WS_LR = WS_LW + 640 * 1024;
constexpr size_t WS_INV3 = WS_TOPW;
constexpr size_t WS_WCNT = WS_RSTD2 + 64 * 1024;
constexpr size_t WS_TCNT = WS_WCNT + 512 * 1024;
constexpr int CW_CNT = 0;
constexpr int CW_BASE = 64;

struct P {
    const float *x, *p; const int* pos;
    const float *g_mix, *w_in, *b_gate, *g_cq, *w_uq, *g_ckv, *w_ukv, *g_qn_mla, *g_kn_mla, *g_qn_swa, *g_kn_swa, *sink;
    const float *w_br_mla, *w_br_swa, *w_out, *g_moe, *w_router, *router_bias, *w_exp_gu, *w_exp_down, *w_sh_gu, *w_sh_down;
    const float *g_ple, *w_ple_gate, *b_ple, *w_ple_proj;
    float* out; unsigned char* ws; int st_lo; int st_hi;
};
#define WSP(T, off) ((T*)(p.ws + (off)))
__device__ __forceinline__ int tid_of(int wv) { int l; asm volatile("v_mbcnt_lo_u32_b32 %0, -1, 0\n\tv_mbcnt_hi_u32_b32 %0, -1, %0" : "=v"(l)); return wv * 64 + l; }

typedef float f32x4_t __attribute__((ext_vector_type(4)));
typedef unsigned u32x2_t __attribute__((ext_vector_type(2)));
typedef unsigned u32x4_t __attribute__((ext_vector_type(4)));
__device__ __forceinline__ unsigned cvtpk_(float lo, float hi) { unsigned r; asm volatile("v_cvt_pk_bf16_f32 %0, %1, %2" : "=v"(r) : "v"(lo), "v"(hi)); return r; }
__device__ __forceinline__ float bflo(unsigned w) { return __uint_as_float(w << 16); }
__device__ __forceinline__ float bfhi(unsigned w) { return __uint_as_float(w & 0xffff0000u); }
__device__ __forceinline__ void st_prep(const P& p, int gw, int ngw, int lane) {
    bf16_t* hb = WSP(bf16_t, WS_HB); bf16_t* pb = WSP(bf16_t, WS_PB);
    f32x4_t nv[4], npv;
    if (gw < M_) { const f32x4_t* xr = (const f32x4_t*)(p.x + (size_t)gw * D_) + lane;
#pragma unroll
        for (int j = 0; j < 4; ++j) nv[j] = xr[64 * j];
        npv = ((const f32x4_t*)(p.p + (size_t)gw * 256))[lane]; }
    for (int m = gw; m < M_; m += ngw) {
        f32x4_t v[4]; const f32x4_t pv = npv; float s = 0.f;
#pragma unroll
        for (int j = 0; j < 4; ++j) v[j] = nv[j];
        if (m + ngw < M_) { const f32x4_t* xr = (const f32x4_t*)(p.x + (size_t)(m + ngw) * D_) + lane;
#pragma unroll
            for (int j = 0; j < 4; ++j) nv[j] = xr[64 * j];
            npv = ((const f32x4_t*)(p.p + (size_t)(m + ngw) * 256))[lane]; }
#pragma unroll
        for (int j = 0; j < 4; ++j) s += (v[j].x * v[j].x + v[j].y * v[j].y) + (v[j].z * v[j].z + v[j].w * v[j].w);
        s = wave_sum(s); const float r = 1.f / sqrtf(s * (1.f / D_) + EPS);
        u32x2_t* o = (u32x2_t*)(hb + (size_t)m * D_) + lane;
#pragma unroll
        for (int j = 0; j < 4; ++j) o[64 * j] = (u32x2_t){cvtpk_(v[j].x * r, v[j].y * r), cvtpk_(v[j].z * r, v[j].w * r)};
        ((u32x2_t*)(pb + (size_t)m * 256))[lane] = (u32x2_t){cvtpk_(pv.x, pv.y), cvtpk_(pv.z, pv.w)};
    }
}
constexpr size_t WS_CS = 51 * MiB;
__device__ __forceinline__ void st_rope(const P& p, size_t gt, size_t ngt) {
    float* cs = WSP(float, WS_CS);
    for (size_t i = gt; i < (size_t)M_ * 48; i += ngt) { const int m = (int)(i / 48), f = (int)(i % 48);
        const float posf = (float)p.pos[m]; float sv, cv;
        if (f < 16) { sincosf(posf * exp2f(-13.287712379549449f * (float)f * (1.f / 16.f)), &sv, &cv); cs[(size_t)m * 96 + f] = cv; cs[(size_t)m * 96 + 16 + f] = sv; }
        else { const int g = f - 16; sincosf(posf * exp2f(-13.287712379549449f * (float)g * (1.f / 32.f)), &sv, &cv); cs[(size_t)m * 96 + 32 + g] = cv; cs[(size_t)m * 96 + 64 + g] = sv; } }
}
constexpr int VT_PITCH = 72;
typedef float f32x2_t __attribute__((ext_vector_type(2)));
struct P8 { f32x2_t p[4]; };
__device__ __forceinline__ P8 cvp8(const u32x4_t w) { P8 r; r.p[0] = (f32x2_t){bflo(w.x), bfhi(w.x)}; r.p[1] = (f32x2_t){bflo(w.y), bfhi(w.y)}; r.p[2] = (f32x2_t){bflo(w.z), bfhi(w.z)}; r.p[3] = (f32x2_t){bflo(w.w), bfhi(w.w)}; return r; }
__device__ __forceinline__ P8 ldp8(const float* ptr) { const f32x4_t a = *(const f32x4_t*)ptr, b = *(const f32x4_t*)(ptr + 4); P8 r; r.p[0] = (f32x2_t){a.x, a.y}; r.p[1] = (f32x2_t){a.z, a.w}; r.p[2] = (f32x2_t){b.x, b.y}; r.p[3] = (f32x2_t){b.z, b.w}; return r; }
__device__ __forceinline__ P8 f4p8(const f32x4_t a, const f32x4_t b) { P8 r; r.p[0] = (f32x2_t){a.x, a.y}; r.p[1] = (f32x2_t){a.z, a.w}; r.p[2] = (f32x2_t){b.x, b.y}; r.p[3] = (f32x2_t){b.z, b.w}; return r; }
__device__ __forceinline__ void stp8(bf16_t* ptr, const P8& x) { u32x4_t w; w.x = cvtpk_(x.p[0].x, x.p[0].y); w.y = cvtpk_(x.p[1].x, x.p[1].y); w.z = cvtpk_(x.p[2].x, x.p[2].y); w.w = cvtpk_(x.p[3].x, x.p[3].y); *(u32x4_t*)ptr = w; }
__device__ __forceinline__ float ssqp(const P8& x) { f32x2_t a = x.p[0] * x.p[0]; a = x.p[1] * x.p[1] + a; a = x.p[2] * x.p[2] + a; a = x.p[3] * x.p[3] + a; return a.x + a.y; }
template <int CTRL> __device__ __forceinline__ float dppf(float v) { return __uint_as_float((unsigned)__builtin_amdgcn_update_dpp(0, (int)__float_as_uint(v), CTRL, 0xF, 0xF, true)); }
__device__ __forceinline__ float sum8_dpp(float v) { v += dppf<0x141>(v); v += dppf<0xB1>(v); v += dppf<0x4E>(v); return v; }
__device__ __forceinline__ float sum16_dpp(float v) { v += dppf<0x140>(v); return sum8_dpp(v); }
__device__ __forceinline__ float wave_sum_dpp(float v) { v = sum16_dpp(v);
    return __uint_as_float((unsigned)__builtin_amdgcn_readlane((int)__float_as_uint(v), 0)) + __uint_as_float((unsigned)__builtin_amdgcn_readlane((int)__float_as_uint(v), 16))
         + __uint_as_float((unsigned)__builtin_amdgcn_readlane((int)__float_as_uint(v), 32)) + __uint_as_float((unsigned)__builtin_amdgcn_readlane((int)__float_as_uint(v), 48)); }
template <int GL, int PX>
__device__ __forceinline__ void norm_rope(P8& x, bool valid, float pre, float inv_n, const P8& g, const P8& c, const P8& s) {
    float ss = valid ? pre * pre * ssqp(x) : 0.f;
    ss = (GL == 16) ? sum16_dpp(ss) : sum8_dpp(ss);
    const float r = pre * __builtin_amdgcn_rsqf(ss * inv_n + EPS);
    const f32x2_t rr = {r, r};
#pragma unroll
    for (int j = 0; j < 4; ++j) { x.p[j] *= rr * g.p[j];
        f32x2_t o;
        o.x = (PX == 2) ? dppf<0x4E>(x.p[j].x) : dppf<0x1B>(dppf<0x141>(x.p[j].x)); o.y = (PX == 2) ? dppf<0x4E>(x.p[j].y) : dppf<0x1B>(dppf<0x141>(x.p[j].y));
        x.p[j] = x.p[j] * c.p[j] + o * s.p[j]; }
}
__device__ __forceinline__ void st_attn_prep(const P& p, int wg, int nwg, int wave, int lane, bf16_t* lds) {
    const bf16_t* z = WSP(bf16_t, WS_Z); const bf16_t* qmr = WSP(bf16_t, WS_QMR); const bf16_t* kvr = WSP(bf16_t, WS_KVR); const float* cs = WSP(float, WS_CS);
    bf16_t* QM = WSP(bf16_t, WS_QM); bf16_t* KM = WSP(bf16_t, WS_KM); bf16_t* VTM = WSP(bf16_t, WS_VTM);
    bf16_t* QS = WSP(bf16_t, WS_QS); bf16_t* KS = WSP(bf16_t, WS_KS); bf16_t* VTS = WSP(bf16_t, WS_VTS);
    const float sc_m = 0.10206207261596575f * LOG2E;
    const float sc_s = 0.125f * LOG2E;
    const int c16 = lane & 15, h16 = lane >> 4, c8 = lane & 7, h8 = lane >> 3;
    const bool v12 = c16 < 12, rotm = (c16 >= 8) && v12;
    P8 gqm = ldp8(p.g_qn_mla + 8 * (v12 ? c16 : 0)), gqs = ldp8(p.g_qn_swa + 8 * c8);
    const P8 gkm = ldp8(p.g_kn_mla + 8 * (v12 ? c16 : 0)), gks = ldp8(p.g_kn_swa + 8 * c8);
#pragma unroll
    for (int j = 0; j < 4; ++j) { gqm.p[j] *= (f32x2_t){sc_m, sc_m}; gqs.p[j] *= (f32x2_t){sc_s, sc_s}; }
    const unsigned sgm = (c16 >= 10) ? 0u : 0x80000000u, sgs = (c8 >= 4) ? 0u : 0x80000000u;
    for (int tile = wg; tile < M_ / 64; tile += nwg) {
        __syncthreads();
        struct Raw { u32x4_t zq, zkv, qa, qb, ka, kb, vm, qs, ksv; f32x4_t cm0, cm1, sm0, sm1, cw0, cw1, sw0, sw1; };
        auto load_raw = [&](int m) { Raw r; const bf16_t* zr = z + (size_t)m * NZ; const bf16_t* qr = qmr + (size_t)m * 768; const bf16_t* kr = kvr + (size_t)m * 1024;
            r.zq = *(const u32x4_t*)(zr + ZQ + 8 * (lane < 48 ? lane : 0)); r.zkv = *(const u32x4_t*)(zr + ZCKV + 8 * (lane & 31));
            r.qa = *(const u32x4_t*)(qr + h16 * 96 + 8 * (c16 < 12 ? c16 : 0)); r.qb = *(const u32x4_t*)(qr + (4 + h16) * 96 + 8 * (c16 < 12 ? c16 : 0));
            r.ka = (c16 < 8) ? *(const u32x4_t*)(kr + h16 * 128 + 8 * c16) : *(const u32x4_t*)(zr + ZKR + 8 * (c16 & 3));
            r.kb = (c16 < 8) ? *(const u32x4_t*)(kr + (4 + h16) * 128 + 8 * c16) : *(const u32x4_t*)(zr + ZKR + 8 * (c16 & 3));
            r.vm = *(const u32x4_t*)(kr + h8 * 128 + 64 + 8 * c8); r.qs = *(const u32x4_t*)(zr + ZQS + 8 * lane); r.ksv = *(const u32x4_t*)(zr + ZKS + 8 * (lane & 31));
            const float* csr = cs + (size_t)m * 96; const float* cm = csr + 8 * (c16 & 1); const float* cw = csr + 32 + 8 * (c8 & 3);
            r.cm0 = *(const f32x4_t*)cm; r.cm1 = *(const f32x4_t*)(cm + 4); r.sm0 = *(const f32x4_t*)(cm + 16); r.sm1 = *(const f32x4_t*)(cm + 20);
            r.cw0 = *(const f32x4_t*)cw; r.cw1 = *(const f32x4_t*)(cw + 4); r.sw0 = *(const f32x4_t*)(cw + 32); r.sw1 = *(const f32x4_t*)(cw + 36);
            return r; };
        Raw nx = load_raw(tile * 64 + wave * 8);
        for (int tt = 0; tt < 8; ++tt) {
            const int tl = wave * 8 + tt, m = tile * 64 + tl, b = m / S_, s = m % S_;
            const int tls = tl ^ (8 * ((lane >> 1) & 7));
            const Raw cu = nx;
            if (tt < 7) nx = load_raw(m + 1);
            const P8 zq = cvp8(cu.zq), zkv = cvp8(cu.zkv); P8 qa = cvp8(cu.qa), qb = cvp8(cu.qb), ka = cvp8(cu.ka), kb = cvp8(cu.kb), vm = cvp8(cu.vm), qs = cvp8(cu.qs), ks = cvp8(cu.ksv);
            const float rq = __builtin_amdgcn_rsqf(wave_sum_dpp(lane < 48 ? ssqp(zq) : 0.f) * (1.f / 384.f) + EPS);
            const float rkv = __builtin_amdgcn_rsqf(wave_sum_dpp(lane < 32 ? ssqp(zkv) : 0.f) * (1.f / 256.f) + EPS);
            P8 cM = f4p8(cu.cm0, cu.cm1), sM = f4p8(cu.sm0, cu.sm1), cW = f4p8(cu.cw0, cu.cw1), sW = f4p8(cu.sw0, cu.sw1);
#pragma unroll
            for (int j = 0; j < 4; ++j) {
                cM.p[j].x = rotm ? cM.p[j].x : 1.f; cM.p[j].y = rotm ? cM.p[j].y : 1.f;
                sM.p[j].x = rotm ? __uint_as_float(__float_as_uint(sM.p[j].x) ^ sgm) : 0.f; sM.p[j].y = rotm ? __uint_as_float(__float_as_uint(sM.p[j].y) ^ sgm) : 0.f;
                sW.p[j].x = __uint_as_float(__float_as_uint(sW.p[j].x) ^ sgs); sW.p[j].y = __uint_as_float(__float_as_uint(sW.p[j].y) ^ sgs); }
            const float kpre = (c16 < 8) ? rkv : 1.f;
            norm_rope<16, 2>(qa, v12, rq, 1.f / 96.f, gqm, cM, sM);
            norm_rope<16, 2>(qb, v12, rq, 1.f / 96.f, gqm, cM, sM);
            norm_rope<16, 2>(ka, v12, kpre, 1.f / 96.f, gkm, cM, sM);
            norm_rope<16, 2>(kb, v12, kpre, 1.f / 96.f, gkm, cM, sM);
            if (v12) { stp8(QM + ((size_t)(b * 8 + h16) * S_ + s) * 96 + 8 * c16, qa); stp8(QM + ((size_t)(b * 8 + 4 + h16) * S_ + s) * 96 + 8 * c16, qb);
                       stp8(KM + ((size_t)(b * 8 + h16) * S_ + s) * 96 + 8 * c16, ka); stp8(KM + ((size_t)(b * 8 + 4 + h16) * S_ + s) * 96 + 8 * c16, kb); }
            { const f32x2_t rv = {rkv, rkv};
#pragma unroll
              for (int j = 0; j < 4; ++j) { const f32x2_t t = vm.p[j] * rv; const unsigned w = cvtpk_(t.x, t.y);
                  lds[(h8 * 64 + 8 * c8 + 2 * j) * VT_PITCH + tls] = (bf16_t)(w & 0xffffu); lds[(h8 * 64 + 8 * c8 + 2 * j + 1) * VT_PITCH + tls] = (bf16_t)(w >> 16); } }
            norm_rope<8, 4>(qs, true, 1.f, 1.f / 64.f, gqs, cW, sW);
            stp8(QS + ((size_t)(b * 8 + h8) * S_ + s) * 64 + 8 * c8, qs);
            norm_rope<8, 4>(ks, lane < 16, 1.f, 1.f / 64.f, gks, cW, sW);
            if (lane < 16) stp8(KS + ((size_t)(b * 2 + h8) * S_ + s) * 64 + 8 * c8, ks);
            else if (lane < 32) { const unsigned wv[4] = {cu.ksv.x, cu.ksv.y, cu.ksv.z, cu.ksv.w};
#pragma unroll
                for (int j = 0; j < 4; ++j) { lds[(512 + (h8 - 2) * 64 + 8 * c8 + 2 * j) * VT_PITCH + tls] = (bf16_t)(wv[j] & 0xffffu); lds[(512 + (h8 - 2) * 64 + 8 * c8 + 2 * j + 1) * VT_PITCH + tls] = (bf16_t)(wv[j] >> 16); } }
        }
        __syncthreads();
        const int b = (tile * 64) / S_, s0 = (tile * 64) % S_;
        int ln = lane; asm volatile("" : "+v"(ln));
        for (int r0 = wave * 8; r0 < 640; r0 += 64) { const int r = r0 + (ln >> 3), t8 = (ln & 7) * 8;
            const u32x4_t v = *(const u32x4_t*)(lds + r * VT_PITCH + (t8 ^ (8 * ((r >> 4) & 7))));
            if (r < 512) *(u32x4_t*)(VTM + ((size_t)(b * 8 + (r >> 6)) * 64 + (r & 63)) * S_ + s0 + t8) = v;
            else { const int rr = r - 512; *(u32x4_t*)(VTS + ((size_t)(b * 2 + (rr >> 6)) * 64 + (rr & 63)) * S_ + s0 + t8) = v; } }
    }
}

#define LAS __attribute__((address_space(3)))
#define XB_TMO      128
#define XB_XCNT(j)  (256  + 64 * (j))
#define XB_XSUB(j)  (1280 + 64 * (j))
#define XB_XGEN(j)  (2304 + 64 * (j))
#define XB_TOP      3328
#define XB_TOPGEN   3392
#define XCD_BAR_WORDS 3456
#define XB_SPIN_CAP (1u << 18)
__device__ __forceinline__ unsigned xb_ld(unsigned* p)              { return __hip_atomic_load(p, __ATOMIC_RELAXED, __HIP_MEMORY_SCOPE_AGENT); }
__device__ __forceinline__ unsigned xb_add(unsigned* p, unsigned v) { return __hip_atomic_fetch_add(p, v, __ATOMIC_RELAXED, __HIP_MEMORY_SCOPE_AGENT); }
__device__ __forceinline__ unsigned xb_xcc_id() { return (unsigned)__builtin_amdgcn_s_getreg((3 << 11) | 20) & 0xFu; }
#define XB_SPIN(cond, bar) do { unsigned _sp = 0; while (cond) { __builtin_amdgcn_s_sleep(1); \
    if ((++_sp & 255u) == 0u) { if (xb_ld(&(bar)[XB_TMO])) break; if (_sp > XB_SPIN_CAP) { atomicAdd(&(bar)[XB_TMO], 1u); break; } } } } while (0)
struct XcdBarrier { unsigned* bar; unsigned x; volatile LAS unsigned* st; int wv; };
__device__ __forceinline__ XcdBarrier xcd_barrier_post(unsigned* bar, volatile LAS unsigned* st, int wv) {
    XcdBarrier b; b.bar = bar; b.x = xb_xcc_id(); b.st = st; b.wv = wv;
    if (tid_of(wv) == 0) (void)xb_add(&bar[XB_XCNT(b.x)], 1u);
    return b;
}
__device__ __forceinline__ void xcd_barrier_complete(unsigned* bar, unsigned x, unsigned& nloc, unsigned& nx) {
    const unsigned G = gridDim.x * gridDim.y * gridDim.z;
    unsigned sum, cnt, mine, sp = 0u;
    for (;;) {
        sum = 0u; cnt = 0u; mine = 0u;
#pragma unroll
        for (unsigned j = 0; j < 16; ++j) { const unsigned c = xb_ld(&bar[XB_XCNT(j)]); sum += c; cnt += (c > 0u) ? 1u : 0u; mine = (j == x) ? c : mine; }
        if (sum == G) break;
        __builtin_amdgcn_s_sleep(1);
        if ((++sp & 255u) == 0u) { if (xb_ld(&bar[XB_TMO])) break; if (sp > XB_SPIN_CAP) { atomicAdd(&bar[XB_TMO], 1u); break; } }
    }
    nloc = mine > 0u ? mine : 1u; nx = cnt > 0u ? cnt : 1u;
}
__device__ __forceinline__ void xcd_barrier(const XcdBarrier& b) {
    asm volatile("s_waitcnt vmcnt(0)" ::: "memory");
    __syncthreads();
    if (tid_of(b.wv) == 0) {
        unsigned* bar = b.bar;
        __builtin_amdgcn_s_waitcnt(0);
        unsigned nloc = b.st[0], nx = b.st[1];
        if (nloc == 0u) { xcd_barrier_complete(bar, b.x, nloc, nx); b.st[0] = nloc; b.st[1] = nx; }
        const unsigned old = xb_add(&bar[XB_XSUB(b.x)], 1u);
        const unsigned gen = old / nloc;
        if (old + 1u == (gen + 1u) * nloc) {
            __builtin_amdgcn_fence(__ATOMIC_RELEASE, "agent");
            asm volatile("s_waitcnt vmcnt(0)" ::: "memory");
            const unsigned og = xb_add(&bar[XB_TOP], 1u);
            const unsigned tg = og / nx;
            if (og + 1u == (tg + 1u) * nx) xb_add(&bar[XB_TOPGEN], 1u);
            else XB_SPIN(xb_ld(&bar[XB_TOPGEN]) == tg, bar);
            __builtin_amdgcn_fence(__ATOMIC_ACQUIRE, "agent");
            xb_add(&bar[XB_XGEN(b.x)], 1u);
            asm volatile("s_waitcnt vmcnt(0)" ::: "memory");
        } else {
            XB_SPIN(xb_ld(&bar[XB_XGEN(b.x)]) == gen, bar);
            __builtin_amdgcn_fence(__ATOMIC_ACQUIRE, "agent");
            asm volatile("s_waitcnt vmcnt(0)" ::: "memory");
        }
    }
    __syncthreads();
}
constexpr int CW_BAR = 4096;

namespace pg8 {
typedef short bf16x8 __attribute__((ext_vector_type(8)));
typedef float f32x4 __attribute__((ext_vector_type(4)));
typedef unsigned u32x4 __attribute__((ext_vector_type(4)));
typedef unsigned u32x2 __attribute__((ext_vector_type(2)));
constexpr int GTBL_OFF = 128 * 1024;
constexpr int BM = 256, BK = 64, HALF = 128, HTB = HALF * BK * 2, STAGE_BYTES = 8 * HTB, NXCD = 8, WGM = 8;
__host__ __device__ __forceinline__ int lds_byte(int r, int c) { const int st = (r >> 4) * 2 + (c >> 5), rr = r & 15, cc = c & 31, ob = rr * 64 + cc * 2; return st * 1024 + (ob ^ (((ob >> 9) & 1) << 5)); }
__host__ __device__ __forceinline__ void stage_rc(int b, int& R, int& C) { const int st = b / 1024, sb = b % 1024, swz = sb ^ (((sb >> 9) & 1) << 5); R = (st >> 1) * 16 + swz / 64; C = (st & 1) * 32 + (swz % 64) / 2; }
__host__ __device__ __forceinline__ int perm32(int rho) { const int n = rho >> 4, i = rho & 15; return 8 * (i >> 2) + 4 * n + (i & 3); }
__device__ __forceinline__ unsigned cvt_pk_bf16(float lo, float hi) { unsigned r; asm volatile("v_cvt_pk_bf16_f32 %0, %1, %2" : "=v"(r) : "v"(lo), "v"(hi)); return r; }

struct Unit { int pm, pn; const char* Ab; const char* Bb; int aux; };

struct DenseSched {
    const char* A; const char* Bt; size_t astep, bstep;
    int nM, nN, nwg, G, c;
    __device__ __forceinline__ void init(const void* A_, int lda, const void* Bt_, int ldb, int M, int N, int G_, int c_) {
        A = (const char*)A_; Bt = (const char*)Bt_; astep = (size_t)BM * lda * 2; bstep = (size_t)BM * ldb * 2; nM = M / BM; nN = N / BM; nwg = nM * nN; G = G_; c = c_; }
    __device__ __forceinline__ bool next(int i, Unit& u) const {
        const int L = i * G + c; if (L >= nwg) return false;
        int wgid = L; { const int q = nwg / NXCD, r = nwg % NXCD, xcd = wgid % NXCD, off = wgid / NXCD; wgid = (xcd < r ? xcd * (q + 1) : r * (q + 1) + (xcd - r) * q) + off; }
        const int nig = WGM * nN, gid = wgid / nig, fm = gid * WGM, gsz = (nM - fm) < WGM ? (nM - fm) : WGM;
        u.pm = fm + ((wgid % nig) % gsz); u.pn = (wgid % nig) / gsz; u.Ab = A + (size_t)u.pm * astep; u.Bb = Bt + (size_t)u.pn * bstep; u.aux = 0; return true;
    }
    __device__ __forceinline__ int row(const Unit&, int) const { return 0; }
    __device__ __forceinline__ const int* rowtab(const Unit&) const { return nullptr; }
};

typedef int i32x4 __attribute__((ext_vector_type(4)));
typedef int i32x8 __attribute__((ext_vector_type(8)));
template <class Epi, class Sched, bool GATHER, bool F8 = false>
__device__ __forceinline__ void gemm_phase(LAS unsigned char* lds, const int wv, const int K, const int lda, const int ldb, const Sched& S, const Epi& E) {
    int tid = tid_of(wv); asm volatile("" : "+v"(tid));
    const int wid = __builtin_amdgcn_readfirstlane(tid >> 6), lane = tid & 63, wr = wid >> 2, wc = wid & 3, fr = lane & 15, fq = lane >> 4;
    int nt = K / BK; if constexpr (F8) asm volatile("" : "+s"(nt));
    unsigned voffB[2];
#pragma unroll
    for (int i = 0; i < 2; ++i) { int R, C; stage_rc(tid * 16 + i * 8192, R, C);
        const int Rb = Epi::PERM2 ? (64 * (R >> 5) + 16 * ((R & 15) >> 2) + 4 * ((R >> 4) & 1) + (R & 3)) : Epi::PERM ? ((R & ~31) + perm32(R & 31)) : R;
        voffB[i] = (unsigned)(Rb * ldb + C) * 2u; }
    const size_t kstep = (size_t)(BK * 2);
    const size_t hstepB = Epi::PERM2 ? (size_t)8 * ldb * 2 : (size_t)HALF * ldb * 2;
    const size_t hstepA = GATHER ? 0 : (size_t)HALF * lda * 2;
    const unsigned ldsw = (unsigned)wid * 1024u;
    const int aoff = lds_byte(wr * 64 + fr, fq * 8), boff = lds_byte(wc * 32 + fr, fq * 8);
#define PG8_SA(b, h) (((b) * 2 + (h)) * HTB)
#define PG8_SB(b, h) ((4 + (b) * 2 + (h)) * HTB)
#define PG8_STAGE(bufoff, gbase, v0, v1) do { const char* gb_ = (const char*)(gbase); asm volatile("" : "+s"(gb_));     \
        __builtin_amdgcn_global_load_lds((const unsigned*)(gb_ + (v0)), (LAS unsigned*)(lds + (bufoff) + ldsw), 16, 0, 0); \
        __builtin_amdgcn_global_load_lds((const unsigned*)(gb_ + (v1)), (LAS unsigned*)(lds + (bufoff) + ldsw + 8192), 16, 0, 0); } while (0)
#define PG8_STAGEB(bufoff, gbase) PG8_STAGE(bufoff, gbase, voffB[0], voffB[1])
#define PG8_LDA(dst, b, h) do { _Pragma("unroll") for (int m = 0; m < 4; ++m) _Pragma("unroll") for (int k = 0; k < 2; ++k) dst[m][k] = *(const LAS bf16x8*)(lds + PG8_SA(b, h) + aoff + m * 2048 + k * 1024); } while (0)
#define PG8_LDB(dst, b, h) do { _Pragma("unroll") for (int n = 0; n < 2; ++n) _Pragma("unroll") for (int k = 0; k < 2; ++k) dst[n][k] = *(const LAS bf16x8*)(lds + PG8_SB(b, h) + boff + n * 2048 + k * 1024); } while (0)
#define PG8_CAT(x) __builtin_shufflevector(__builtin_bit_cast(i32x4, (x)[0]), __builtin_bit_cast(i32x4, (x)[1]), 0, 1, 2, 3, 4, 5, 6, 7)
#define PG8_MMA(ai, bj, At, Bt) do { __builtin_amdgcn_s_setprio(1); \
        if constexpr (F8) { _Pragma("unroll") for (int m = 0; m < 4; ++m) _Pragma("unroll") for (int n = 0; n < 2; ++n) \
            acc[ai][bj][m][n] = __builtin_amdgcn_mfma_scale_f32_16x16x128_f8f6f4(PG8_CAT(Bt[n]), PG8_CAT(At[m]), acc[ai][bj][m][n], 0, 0, 0, 0, 0, 0); } \
        else { _Pragma("unroll") for (int m = 0; m < 4; ++m) _Pragma("unroll") for (int n = 0; n < 2; ++n) _Pragma("unroll") for (int k = 0; k < 2; ++k) \
            acc[ai][bj][m][n] = __builtin_amdgcn_mfma_f32_16x16x32_bf16(Bt[n][k], At[m][k], acc[ai][bj][m][n], 0, 0, 0); } \
        __builtin_amdgcn_s_setprio(0); } while (0)
#define PG8_WAIT_V(n) asm volatile("s_waitcnt vmcnt(" #n ")" ::: "memory")
#define PG8_WAIT_L(n) asm volatile("s_waitcnt lgkmcnt(" #n ")" ::: "memory")
#define PG8_BAR __builtin_amdgcn_s_barrier()
#define PG8_SCHED __builtin_amdgcn_sched_barrier(0)
    unsigned vc00, vc01, gtb = 0, gcb = 0;
    { int t_ = tid; asm volatile("" : "+v"(t_)); int R0_, C0_, R1_, C1_; stage_rc(t_ * 16, R0_, C0_); stage_rc(t_ * 16 + 8192, R1_, C1_);
      vc00 = (unsigned)(R0_ * lda + C0_) * 2u; vc01 = (unsigned)(R1_ * lda + C1_) * 2u; gtb = (unsigned)R0_ * 4u; gcb = (unsigned)C0_ * 2u; }
    const unsigned rowb = (unsigned)lda * 2u;
#define PG8_STAGEA(bufoff, gbase, half, tpar) do { if constexpr (GATHER) { \
        const LAS int* tp_ = (const LAS int*)(lds + GTBL_OFF + (tpar) * 1024 + (half) * 512 + gtb); const unsigned ra_ = (unsigned)tp_[0], rb_ = (unsigned)tp_[64]; \
        PG8_STAGE(bufoff, gbase, ra_ * rowb + gcb, rb_ * rowb + gcb); } else PG8_STAGE(bufoff, gbase, vc00, vc01); } while (0)
#define PG8_TBLDMA(U, tpar) do { const char* tb_ = (const char*)(S.rowtab(U) + (wid & 3) * 64); asm volatile("" : "+s"(tb_)); \
        __builtin_amdgcn_global_load_lds((const unsigned*)(tb_ + (unsigned)(tid_of(wv) & 63) * 4u), (LAS unsigned*)(lds + GTBL_OFF + (tpar) * 1024 + (wid & 3) * 256), 4, 0, 0); } while (0)
    Unit cur, nxt; int ui = 0;
    if (!S.next(0, cur)) return;
    if constexpr (GATHER) { PG8_TBLDMA(cur, 0); asm volatile("s_waitcnt vmcnt(0)" ::: "memory"); __builtin_amdgcn_s_barrier(); }
    f32x4 acc[2][2][4][2];
#pragma unroll
    for (int a = 0; a < 2; ++a)
#pragma unroll
        for (int b = 0; b < 2; ++b)
#pragma unroll
            for (int m = 0; m < 4; ++m)
#pragma unroll
                for (int n = 0; n < 2; ++n) acc[a][b][m][n] = (f32x4){0.f, 0.f, 0.f, 0.f};
    bf16x8 At[4][2], B0[2][2], B1[2][2];
    const char* cA = cur.Ab; const char* cB = cur.Bb;
    PG8_STAGEB(PG8_SB(0, 0), cB); PG8_STAGEB(PG8_SB(0, 1), cB + hstepB); PG8_STAGEA(PG8_SA(0, 0), cA, 0, 0); PG8_STAGEA(PG8_SA(0, 1), cA + hstepA, 1, 0);
    if (wr == 1) PG8_BAR;
    PG8_WAIT_V(2); PG8_BAR;
    PG8_STAGEB(PG8_SB(1, 0), cB + kstep); PG8_STAGEA(PG8_SA(1, 0), cA + kstep, 0, 0); PG8_STAGEB(PG8_SB(1, 1), cB + hstepB + kstep);
    PG8_WAIT_V(6); PG8_BAR;
    for (;;) {
        const bool has_next = S.next(ui + 1, nxt);
        const char* nA = has_next ? nxt.Ab : cA; const char* nB = has_next ? nxt.Bb : cB;
        const int cpar = ui & 1, npar = has_next ? (cpar ^ 1) : cpar;
        if constexpr (GATHER) { if (has_next) PG8_TBLDMA(nxt, npar); }
        for (int t = 0; t < nt; t += 2) {
            const bool last = (t == nt - 2);
            const char* a1 = cA + (size_t)(t + 1) * kstep;
            const char* a2 = last ? nA : cA + (size_t)(t + 2) * kstep; const char* b2 = last ? nB : cB + (size_t)(t + 2) * kstep;
            const char* a3 = a2 + kstep; const char* b3 = b2 + kstep;
            const int wpar = last ? npar : cpar;
            PG8_LDB(B0, 0, 0); PG8_LDB(B1, 0, 1); PG8_SCHED; PG8_LDA(At, 0, 0); PG8_STAGEA(PG8_SA(1, 1), a1 + hstepA, 1, cpar);
            PG8_WAIT_V(8); PG8_WAIT_L(0); PG8_BAR; PG8_MMA(0, 0, At, B0); PG8_MMA(0, 1, At, B1); PG8_BAR; PG8_SCHED;
            PG8_LDA(At, 0, 1); PG8_STAGEB(PG8_SB(0, 0), b2); PG8_STAGEB(PG8_SB(0, 1), b2 + hstepB); PG8_STAGEA(PG8_SA(0, 0), a2, 0, wpar);
            PG8_WAIT_V(8); PG8_WAIT_L(0); PG8_BAR; PG8_MMA(1, 0, At, B0); PG8_MMA(1, 1, At, B1); PG8_BAR; PG8_SCHED;
            PG8_LDB(B0, 1, 0); PG8_LDB(B1, 1, 1); PG8_SCHED; PG8_LDA(At, 1, 0); PG8_STAGEA(PG8_SA(0, 1), a2 + hstepA, 1, wpar);
            PG8_WAIT_V(8); PG8_WAIT_L(0); PG8_BAR; PG8_MMA(0, 0, At, B0); PG8_MMA(0, 1, At, B1); PG8_BAR; PG8_SCHED;
            PG8_LDA(At, 1, 1); PG8_STAGEB(PG8_SB(1, 0), b3); PG8_STAGEB(PG8_SB(1, 1), b3 + hstepB); PG8_STAGEA(PG8_SA(1, 0), a3, 0, wpar);
            PG8_WAIT_V(8); PG8_WAIT_L(0); PG8_BAR; PG8_MMA(1, 0, At, B0); PG8_MMA(1, 1, At, B1); PG8_BAR; PG8_SCHED;
        }
        if (wr == 0) PG8_BAR;
        { const int le = tid_of(wv) & 63; E(acc, cur, wr, wc, le & 15, le >> 4); }
        if (!has_next) break;
#pragma unroll
        for (int a = 0; a < 2; ++a)
#pragma unroll
            for (int b = 0; b < 2; ++b)
#pragma unroll
                for (int m = 0; m < 4; ++m)
#pragma unroll
                    for (int n = 0; n < 2; ++n) acc[a][b][m][n] = (f32x4){0.f, 0.f, 0.f, 0.f};
        cur = nxt; cA = nA; cB = nB; ++ui;
        if (wr == 1) PG8_BAR;
    }
    PG8_WAIT_V(0);
    PG8_BAR;
#undef PG8_SA
#undef PG8_SB
#undef PG8_STAGE
#undef PG8_STAGEB
#undef PG8_LDA
#undef PG8_LDB
#undef PG8_MMA
#undef PG8_CAT
#undef PG8_WAIT_V
#undef PG8_WAIT_L
#undef PG8_BAR
#undef PG8_SCHED
#undef PG8_STAGEA
#undef PG8_TBLDMA
}

constexpr float HID_SC = 16.f, WDN_SC = 64.f, XN_SC = 8.f, WGU_SC = 128.f;
enum { EP_Z = 0, EP_BF16 = 1, EP_MG1 = 2, EP_MG2 = 3, EP_RES = 4, EP_HID = 5, EP_DOWN = 6, EP_PLE = 7 };
__device__ __forceinline__ float bfl(unsigned w) { return __uint_as_float(w << 16); }
__device__ __forceinline__ float bfh(unsigned w) { return __uint_as_float(w & 0xffff0000u); }
__device__ __forceinline__ float sigm(float v) { return __builtin_amdgcn_rcpf(1.f + __expf(-v)); }
template <int MODE> struct Epi {
    static constexpr bool PERM = !(MODE == EP_RES || MODE == EP_PLE), PERM2 = (MODE == EP_DOWN);
    bf16_t* O; int ldc;
    const bf16_t* aux; int ldaux;
    const float* fin; float* fout; const float* fin2; bf16_t* O2;
    __device__ __forceinline__ void operator()(const f32x4 (&acc)[2][2][4][2], const Unit& u, int wr, int wc, int fr, int fq) const {
        const int row0 = u.pm * BM + wr * 64 + fr;
        if constexpr (MODE == EP_RES) {
            const int col0 = u.pn * BM + wc * 32 + 4 * fq;
            f32x4 xc[4], xn[4];
#pragma unroll
            for (int q = 0; q < 4; ++q) xc[q] = *(const f32x4*)(fin + (size_t)row0 * D_ + col0 + (q >> 1) * HALF + (q & 1) * 16);
#pragma unroll
            for (int g = 0; g < 8; ++g) { const size_t r = (size_t)(row0 + (g >> 2) * HALF + (g & 3) * 16);
                if (g < 7) { const size_t r1 = (size_t)(row0 + ((g + 1) >> 2) * HALF + ((g + 1) & 3) * 16);
#pragma unroll
                    for (int q = 0; q < 4; ++q) xn[q] = *(const f32x4*)(fin + r1 * D_ + col0 + (q >> 1) * HALF + (q & 1) * 16); }
                asm volatile("" ::: "memory");
#pragma unroll
                for (int q = 0; q < 4; ++q) { const f32x4 o = xc[q] + acc[g >> 2][q >> 1][g & 3][q & 1]; *(f32x4*)(fout + r * D_ + col0 + (q >> 1) * HALF + (q & 1) * 16) = o; }
                asm volatile("" ::: "memory");
#pragma unroll
                for (int q = 0; q < 4; ++q) xc[q] = xn[q]; }
        } else if constexpr (MODE == EP_PLE) {
            const int col0 = u.pn * BM + wc * 32 + 4 * fq;
            constexpr float qs = 1.f / (XN_SC * WGU_SC);
            f32x4 bv[4]; u32x2 pc[4], hc[4], pn_[4], hn[4]; float ic, in_ = 0.f;
#pragma unroll
            for (int q = 0; q < 4; ++q) { const int c = col0 + (q >> 1) * HALF + (q & 1) * 16; bv[q] = *(const f32x4*)(fin + c);
                pc[q] = *(const u32x2*)(aux + (size_t)row0 * ldaux + c); hc[q] = *(const u32x2*)(O + (size_t)row0 * D_ + c); }
            ic = fin2[row0];
#pragma unroll
            for (int g = 0; g < 8; ++g) { const size_t r = (size_t)(row0 + (g >> 2) * HALF + (g & 3) * 16);
                if (g < 7) { const size_t r1 = (size_t)(row0 + ((g + 1) >> 2) * HALF + ((g + 1) & 3) * 16);
#pragma unroll
                    for (int q = 0; q < 4; ++q) { const int c = col0 + (q >> 1) * HALF + (q & 1) * 16; pn_[q] = *(const u32x2*)(aux + r1 * ldaux + c); hn[q] = *(const u32x2*)(O + r1 * D_ + c); }
                    in_ = fin2[r1]; }
                asm volatile("" ::: "memory");
#pragma unroll
                for (int q = 0; q < 4; ++q) { const int c = col0 + (q >> 1) * HALF + (q & 1) * 16; const f32x4 a = acc[g >> 2][q >> 1][g & 3][q & 1]; const u32x2 pw = pc[q], hw = hc[q]; f32x4 o;
                    o[0] = bfl(hw.x) * ic + sigm(a[0] * qs + bv[q][0]) * bfl(pw.x); o[1] = bfh(hw.x) * ic + sigm(a[1] * qs + bv[q][1]) * bfh(pw.x);
                    o[2] = bfl(hw.y) * ic + sigm(a[2] * qs + bv[q][2]) * bfl(pw.y); o[3] = bfh(hw.y) * ic + sigm(a[3] * qs + bv[q][3]) * bfh(pw.y);
                    *(f32x4*)(fout + r * D_ + c) = o; }
                asm volatile("" ::: "memory");
#pragma unroll
                for (int q = 0; q < 4; ++q) { pc[q] = pn_[q]; hc[q] = hn[q]; }
                ic = in_; }
        } else if constexpr (MODE == EP_DOWN) {
            unsigned char* Y8 = (unsigned char*)O; const int col0 = u.pn * BM + wc * 64 + 16 * fq;
#pragma unroll
            for (int ai = 0; ai < 2; ++ai)
#pragma unroll
                for (int m = 0; m < 4; ++m) { const size_t r = (size_t)(row0 + ai * HALF + m * 16); u32x4 w;
#pragma unroll
                    for (int bj = 0; bj < 2; ++bj)
#pragma unroll
                        for (int n = 0; n < 2; ++n) { const f32x4 a = acc[ai][bj][m][n] * (16.f / (HID_SC * WDN_SC)); int d = 0;
                            d = __builtin_amdgcn_cvt_pk_fp8_f32(a[0], a[1], d, false); d = __builtin_amdgcn_cvt_pk_fp8_f32(a[2], a[3], d, true); w[2 * bj + n] = (unsigned)d; }
                    *(u32x4*)(Y8 + r * 1024 + col0) = w; }
        } else if constexpr (MODE == EP_HID) {
            const int col0 = u.pn * HALF + wc * 32 + 8 * fq;
#pragma unroll
            for (int ai = 0; ai < 2; ++ai)
#pragma unroll
                for (int m = 0; m < 4; ++m) { const size_t r = (size_t)(row0 + ai * HALF + m * 16); const float w = fin[r]; constexpr float rs = 1.f / (XN_SC * WGU_SC);
                    const f32x4 g0 = acc[ai][0][m][0] * rs, g1 = acc[ai][0][m][1] * rs, u0 = acc[ai][1][m][0] * rs, u1 = acc[ai][1][m][1] * rs;
                    float h[8];
#pragma unroll
                    for (int j = 0; j < 4; ++j) { h[j] = g0[j] * sigm(g0[j]) * u0[j] * w; h[4 + j] = g1[j] * sigm(g1[j]) * u1[j] * w; }
#pragma unroll
                    for (int j = 0; j < 8; ++j) h[j] = __builtin_amdgcn_fmed3f(h[j] * HID_SC, -448.f, 448.f);
                    int d0 = 0, d1 = 0;
                    d0 = __builtin_amdgcn_cvt_pk_fp8_f32(h[0], h[1], d0, false); d0 = __builtin_amdgcn_cvt_pk_fp8_f32(h[2], h[3], d0, true);
                    d1 = __builtin_amdgcn_cvt_pk_fp8_f32(h[4], h[5], d1, false); d1 = __builtin_amdgcn_cvt_pk_fp8_f32(h[6], h[7], d1, true);
                    *(u32x2*)((unsigned char*)O + r * ldc + col0) = (u32x2){(unsigned)d0, (unsigned)d1}; }
        } else if constexpr (MODE == EP_MG1 || MODE == EP_MG2) {
            const int col0 = u.pn * BM + wc * 32 + 8 * fq;
            u32x4 gc[2], gn[2], oc[2], on[2];
#pragma unroll
            for (int bj = 0; bj < 2; ++bj) { gc[bj] = *(const u32x4*)(aux + (size_t)row0 * ldaux + col0 + bj * HALF); if constexpr (MODE == EP_MG2) oc[bj] = *(const u32x4*)(O + (size_t)row0 * ldc + col0 + bj * HALF); }
#pragma unroll
            for (int g = 0; g < 8; ++g) { const size_t r = (size_t)(row0 + (g >> 2) * HALF + (g & 3) * 16);
                if (g < 7) { const size_t r1 = (size_t)(row0 + ((g + 1) >> 2) * HALF + ((g + 1) & 3) * 16);
#pragma unroll
                    for (int bj = 0; bj < 2; ++bj) { gn[bj] = *(const u32x4*)(aux + r1 * ldaux + col0 + bj * HALF); if constexpr (MODE == EP_MG2) on[bj] = *(const u32x4*)(O + r1 * ldc + col0 + bj * HALF); } }
                asm volatile("" ::: "memory");
#pragma unroll
                for (int bj = 0; bj < 2; ++bj) { const int c = col0 + bj * HALF; f32x4 v0 = acc[g >> 2][bj][g & 3][0], v1 = acc[g >> 2][bj][g & 3][1]; const u32x4 gw = gc[bj];
                    v0[0] *= bfl(gw.x); v0[1] *= bfh(gw.x); v0[2] *= bfl(gw.y); v0[3] *= bfh(gw.y); v1[0] *= bfl(gw.z); v1[1] *= bfh(gw.z); v1[2] *= bfl(gw.w); v1[3] *= bfh(gw.w);
                    if constexpr (MODE == EP_MG2) { const u32x4 ow = oc[bj];
                        v0[0] += bfl(ow.x); v0[1] += bfh(ow.x); v0[2] += bfl(ow.y); v0[3] += bfh(ow.y); v1[0] += bfl(ow.z); v1[1] += bfh(ow.z); v1[2] += bfl(ow.w); v1[3] += bfh(ow.w); }
                    u32x4 w; w.x = cvt_pk_bf16(v0[0], v0[1]); w.y = cvt_pk_bf16(v0[2], v0[3]); w.z = cvt_pk_bf16(v1[0], v1[1]); w.w = cvt_pk_bf16(v1[2], v1[3]);
                    *(u32x4*)(O + r * ldc + c) = w; }
                asm volatile("" ::: "memory");
#pragma unroll
                for (int bj = 0; bj < 2; ++bj) { gc[bj] = gn[bj]; if constexpr (MODE == EP_MG2) oc[bj] = on[bj]; } }
        } else {
            const int col0 = u.pn * BM + wc * 32 + 8 * fq;
            const bool act = (MODE == EP_Z) && (u.pn >= ZGA / BM);
#pragma unroll
            for (int ai = 0; ai < 2; ++ai)
#pragma unroll
                for (int m = 0; m < 4; ++m) { const size_t r = (size_t)(row0 + ai * HALF + m * 16);
#pragma unroll
                    for (int bj = 0; bj < 2; ++bj) { const int c = col0 + bj * HALF; f32x4 v0 = acc[ai][bj][m][0], v1 = acc[ai][bj][m][1];
                        if constexpr (MODE == EP_Z) { if (act) { const f32x4 b0 = *(const f32x4*)(fin + c - ZGA), b1 = *(const f32x4*)(fin + c - ZGA + 4);
#pragma unroll
                            for (int j = 0; j < 4; ++j) { v0[j] = sigm(v0[j] + b0[j]); v1[j] = sigm(v1[j] + b1[j]); } } }
                        if constexpr (MODE == EP_MG1 || MODE == EP_MG2) { const u32x4 gw = *(const u32x4*)(aux + r * ldaux + c);
                            v0[0] *= bfl(gw.x); v0[1] *= bfh(gw.x); v0[2] *= bfl(gw.y); v0[3] *= bfh(gw.y); v1[0] *= bfl(gw.z); v1[1] *= bfh(gw.z); v1[2] *= bfl(gw.w); v1[3] *= bfh(gw.w); }
                        if constexpr (MODE == EP_MG2) { const u32x4 ow = *(const u32x4*)(O + r * ldc + c);
                            v0[0] += bfl(ow.x); v0[1] += bfh(ow.x); v0[2] += bfl(ow.y); v0[3] += bfh(ow.y); v1[0] += bfl(ow.z); v1[1] += bfh(ow.z); v1[2] += bfl(ow.w); v1[3] += bfh(ow.w); }
                        { u32x4 w; w.x = cvt_pk_bf16(v0[0], v0[1]); w.y = cvt_pk_bf16(v0[2], v0[3]); w.z = cvt_pk_bf16(v1[0], v1[1]); w.w = cvt_pk_bf16(v1[2], v1[3]);
                            *(u32x4*)(O + r * ldc + c) = w; } }
                    if constexpr (MODE == EP_MG1 || MODE == EP_MG2) asm volatile("" ::: "memory"); }
        }
    }
};
}

__device__ __forceinline__ unsigned pk2(float lo, float hi) { return (unsigned)f2bf(lo) | ((unsigned)f2bf(hi) << 16); }
__device__ __forceinline__ int zdst(int c) {
    if (c < 384) return c;
    if (c < 640) return ZCKV + (c - 384);
    if (c < 672) return ZKR + (c - 640);
    if (c < 1184) return ZQS + (c - 672);
    if (c < 1312) return ZKS + (c - 1184);
    if (c < 1440) return ZVS + (c - 1312);
    if (c < 2464) return ZGA + (c - 1440);
    return ZGB + (c - 2464);
}
__device__ __forceinline__ int gudst(int j) { const int half = j >> 8, jj = j & 255; return ((jj >> 7) << 8) + (half << 7) + (jj & 127); }
struct ConvJob { const float* src; const float* gp; bf16_t* dst; int K, N; float sc; };
template <int K, int N, int MAP>
__device__ __forceinline__ ConvJob conv_mk(const float* W, const float* g, bf16_t* WT, int item) {
    constexpr int nblk = N / 32; const int kb = item / nblk, nb = item % nblk, k0 = 64 * kb, n0 = 32 * nb;
    const int d0 = (MAP == 1) ? zdst(n0) : (MAP == 2) ? gudst(n0) : n0;
    return ConvJob{W + (size_t)k0 * N + n0, g ? g + k0 : nullptr, WT + (size_t)d0 * K + k0, K, N, 0.f};
}
template <int K, int N, int MAP>
__device__ __forceinline__ ConvJob conv_mk8(const float* W, const float* g, unsigned char* WT, int item, float sc) {
    constexpr int nblk = N / 32; const int kb = item / nblk, nb = item % nblk, k0 = 64 * kb, n0 = 32 * nb;
    const int d0 = (MAP == 2) ? gudst(n0) : n0;
    return ConvJob{W + (size_t)k0 * N + n0, g ? g + k0 : nullptr, (bf16_t*)(WT + (size_t)d0 * K + k0), K, N, sc};
}
__device__ __forceinline__ void conv_load(const ConvJob& j, int lane, f32x4_t (&v)[8]) {
    const int kq = lane >> 3, n4 = (lane & 7) * 4; const float* sp = j.src + (size_t)kq * j.N + n4;
#pragma unroll
    for (int i = 0; i < 8; ++i) v[i] = *(const f32x4_t*)(sp + (size_t)(8 * i) * j.N);
}
__device__ __forceinline__ void conv_finish(const ConvJob& j, int lane, const f32x4_t (&v)[8], LAS float* scr) {
    const int kq = lane >> 3, n4 = (lane & 7) * 4;
    const bool f8 = j.sc > 0.f; const float scl = f8 ? j.sc : 1.f;
#pragma unroll
    for (int i = 0; i < 8; ++i) { const int kk = kq + 8 * i; const float gg = (j.gp ? j.gp[kk] : 1.f) * scl; LAS float* d = scr + kk * 33 + n4;
        d[0] = v[i].x * gg; d[1] = v[i].y * gg; d[2] = v[i].z * gg; d[3] = v[i].w * gg; }
    asm volatile("s_waitcnt lgkmcnt(0)" ::: "memory");
    const int c = lane & 7;
    if (f8) {
#pragma unroll
        for (int q = 0; q < 4; ++q) { const int n = (lane >> 3) + 8 * q; const LAS float* sp = scr + (8 * c) * 33 + n; float t[8];
#pragma unroll
            for (int i = 0; i < 8; ++i) t[i] = __builtin_amdgcn_fmed3f(sp[i * 33], -448.f, 448.f);
            int d0 = 0, d1 = 0;
            d0 = __builtin_amdgcn_cvt_pk_fp8_f32(t[0], t[1], d0, false); d0 = __builtin_amdgcn_cvt_pk_fp8_f32(t[2], t[3], d0, true);
            d1 = __builtin_amdgcn_cvt_pk_fp8_f32(t[4], t[5], d1, false); d1 = __builtin_amdgcn_cvt_pk_fp8_f32(t[6], t[7], d1, true);
            *(pg8::u32x2*)((unsigned char*)j.dst + (size_t)n * j.K + 8 * c) = (pg8::u32x2){(unsigned)d0, (unsigned)d1}; }
    } else {
#pragma unroll
        for (int q = 0; q < 4; ++q) { const int n = (lane >> 3) + 8 * q; const LAS float* sp = scr + (8 * c) * 33 + n;
            pg8::u32x4 o; o.x = pk2(sp[0 * 33], sp[1 * 33]); o.y = pk2(sp[2 * 33], sp[3 * 33]); o.z = pk2(sp[4 * 33], sp[5 * 33]); o.w = pk2(sp[6 * 33], sp[7 * 33]);
            *(pg8::u32x4*)(j.dst + (size_t)n * j.K + 8 * c) = o; }
    }
    asm volatile("s_waitcnt lgkmcnt(0)" ::: "memory");
}
__device__ __forceinline__ ConvJob conv_job(const P& p, int it) {
    constexpr int I0 = 16 * 109, I1 = 6 * 24, I2 = 4 * 32, I3 = 8 * 32, I4 = 8 * 32, I5 = 16 * 32, I6 = 16 * 32, I7 = 4 * 32, I8 = 16 * 16, I9 = 4 * 32, IGU = 16 * 16, IDN = 4 * 32;
    int r = it;
    if (r < I0) return conv_mk<1024, INW, 1>(p.w_in, p.g_mix, WSP(bf16_t, WS_WIN), r); r -= I0;
    if (r < I1) return conv_mk<384, 768, 0>(p.w_uq, p.g_cq, WSP(bf16_t, WS_WUQ), r); r -= I1;
    if (r < I2) return conv_mk<256, 1024, 0>(p.w_ukv, p.g_ckv, WSP(bf16_t, WS_WUKV), r); r -= I2;
    if (r < I7) return conv_mk<256, 1024, 0>(p.w_ple_proj, nullptr, WSP(bf16_t, WS_WPP), r); r -= I7;
    if (r < I3) return conv_mk<512, 1024, 0>(p.w_br_mla, nullptr, WSP(bf16_t, WS_WBRM), r); r -= I3;
    if (r < I4) return conv_mk<512, 1024, 0>(p.w_br_swa, nullptr, WSP(bf16_t, WS_WBRS), r); r -= I4;
    if (r < I5) return conv_mk<1024, 1024, 0>(p.w_out, nullptr, WSP(bf16_t, WS_WOUT), r); r -= I5;
    if (r < I6) return conv_mk8<1024, 1024, 0>(p.w_ple_gate, p.g_ple, WSP(unsigned char, WS_WPG), r, pg8::WGU_SC); r -= I6;
    if (r < I8) return conv_mk8<1024, 512, 2>(p.w_sh_gu, p.g_moe, WSP(unsigned char, WS_WGU) + (size_t)NE * 512 * 1024, r, pg8::WGU_SC); r -= I8;
    if (r < I9) return conv_mk8<256, 1024, 0>(p.w_sh_down, nullptr, WSP(unsigned char, WS_WDN) + (size_t)NE * 1024 * 256, r, pg8::WDN_SC); r -= I9;
    if (r < 64 * IGU) { const int e = r / IGU; return conv_mk8<1024, 512, 2>(p.w_exp_gu + (size_t)e * 1024 * 512, p.g_moe, WSP(unsigned char, WS_WGU) + (size_t)e * 512 * 1024, r % IGU, pg8::WGU_SC); } r -= 64 * IGU;
    { const int e = r / IDN; return conv_mk8<256, 1024, 0>(p.w_exp_down + (size_t)e * 256 * 1024, nullptr, WSP(unsigned char, WS_WDN) + (size_t)e * 1024 * 256, r % IDN, pg8::WDN_SC); }
}
constexpr int CONV_EARLY = 16 * 109 + 6 * 24 + 4 * 32 + 4 * 32;
constexpr int CONV_NITEMS = 16 * 109 + 6 * 24 + 4 * 32 + 8 * 32 + 8 * 32 + 16 * 32 + 16 * 32 + 4 * 32 + 16 * 16 + 4 * 32 + 64 * 256 + 64 * 128;
__device__ __forceinline__ void st_wconv(const P& p, int gw, int ngw, int lane, LAS float* scr) {
    constexpr int NITEMS = CONV_EARLY;
    if (gw < NITEMS) {
        ConvJob cur = conv_job(p, gw); f32x4_t v[8], w[8]; conv_load(cur, lane, v);
        for (int it = gw; it < NITEMS; it += ngw) {
            const bool more = it + ngw < NITEMS; ConvJob nx = cur;
            if (more) { nx = conv_job(p, it + ngw); conv_load(nx, lane, w); }
            conv_finish(cur, lane, v, scr);
            if (more) { cur = nx;
#pragma unroll
                for (int i = 0; i < 8; ++i) v[i] = w[i]; }
        }
    }
    { unsigned* zp = (unsigned*)(WSP(bf16_t, WS_WIN) + (size_t)416 * 1024); const int n = 96 * 1024 / 2;
      for (int i = gw * 64 + lane; i < n; i += ngw * 64) zp[i] = 0u; }
}
__device__ __forceinline__ void fs_g1(const P& p, LAS unsigned char* lds, const int wv) {
    pg8::DenseSched S; S.init(WSP(bf16_t, WS_HB), D_, WSP(bf16_t, WS_WIN), D_, M_, NZ, gridDim.x, blockIdx.x);
    pg8::Epi<pg8::EP_Z> E{WSP(bf16_t, WS_Z), NZ, nullptr, 0, p.b_gate, nullptr};
    pg8::gemm_phase<pg8::Epi<pg8::EP_Z>, pg8::DenseSched, false>(lds, wv, D_, D_, D_, S, E);
}

struct MoeSched {
    const char* A; const char* Bt; size_t astep, bstep, estep; const LAS int* tile_e; const int* ltok; int T, NPN, nwg, G, c; bool gather;
    __device__ __forceinline__ void init(const void* A_, int lda, const void* Bt_, int ldb, int ncols_e, const LAS int* tile_e_, const int* ltok_, int T_, bool gather_, int G_, int c_) {
        A = (const char*)A_; Bt = (const char*)Bt_; astep = (size_t)256 * lda * 2; bstep = (size_t)256 * ldb * 2; estep = (size_t)ncols_e * ldb * 2; tile_e = tile_e_; ltok = ltok_;
        T = T_; NPN = ncols_e / 256; nwg = (T + M_ / 256) * NPN; G = G_; c = c_; gather = gather_; }
    __device__ __forceinline__ bool next(int i, pg8::Unit& u) const {
        const int L = i * G + c; if (L >= nwg) return false;
        int wgid = L; { const int q = nwg / 8, r = nwg % 8, xcd = wgid % 8, off = wgid / 8; wgid = (xcd < r ? xcd * (q + 1) : r * (q + 1) + (xcd - r) * q) + off; }
        const int j = wgid / NPN; u.pn = wgid % NPN;
        int e; if (j < T) { u.pm = j; e = __builtin_amdgcn_readfirstlane(tile_e[j]); } else { u.pm = NSLOT / 256 + (j - T); e = NE; }
        u.Ab = gather ? A : A + (size_t)u.pm * astep; u.Bb = Bt + (size_t)e * estep + (size_t)u.pn * bstep; u.aux = e; return true;
    }
    __device__ __forceinline__ int row(const pg8::Unit& u, int r) const { return ltok[u.pm * 256 + r]; }
    __device__ __forceinline__ const int* rowtab(const pg8::Unit& u) const { return ltok + u.pm * 256; }
};
constexpr size_t WS_TILEE = 5 * MiB;
constexpr int NT = 512;
constexpr int TILEE_LDS = 136 * 1024;
__device__ __forceinline__ void fs_g23(const P& p, LAS unsigned char* lds, const int wv) {
    { pg8::DenseSched S; S.init(WSP(bf16_t, WS_Z) + ZQ, NZ, WSP(bf16_t, WS_WUQ), 384, M_, 768, gridDim.x, blockIdx.x);
      pg8::Epi<pg8::EP_BF16> E{WSP(bf16_t, WS_QMR), 768, nullptr, 0, nullptr, nullptr};
      pg8::gemm_phase<pg8::Epi<pg8::EP_BF16>, pg8::DenseSched, false>(lds, wv, 384, NZ, 384, S, E); }
    { pg8::DenseSched S; S.init(WSP(bf16_t, WS_Z) + ZCKV, NZ, WSP(bf16_t, WS_WUKV), 256, M_, 1024, gridDim.x, blockIdx.x);
      pg8::Epi<pg8::EP_BF16> E{WSP(bf16_t, WS_KVR), 1024, nullptr, 0, nullptr, nullptr};
      pg8::gemm_phase<pg8::Epi<pg8::EP_BF16>, pg8::DenseSched, false>(lds, wv, 256, NZ, 256, S, E); }
}
__device__ __forceinline__ void fs_merge(const P& p, LAS unsigned char* lds, const int wv) {
    { pg8::DenseSched S; S.init(WSP(bf16_t, WS_OM), 512, WSP(bf16_t, WS_WBRM), 512, M_, D_, gridDim.x, blockIdx.x);
      pg8::Epi<pg8::EP_MG1> E{WSP(bf16_t, WS_MG), D_, WSP(bf16_t, WS_Z) + ZGA, NZ, nullptr, nullptr};
      pg8::gemm_phase<pg8::Epi<pg8::EP_MG1>, pg8::DenseSched, false>(lds, wv, 512, 512, 512, S, E); }
    { pg8::DenseSched S; S.init(WSP(bf16_t, WS_OW), 512, WSP(bf16_t, WS_WBRS), 512, M_, D_, gridDim.x, blockIdx.x);
      pg8::Epi<pg8::EP_MG2> E{WSP(bf16_t, WS_MG), D_, WSP(bf16_t, WS_Z) + ZGB, NZ, nullptr, nullptr};
      pg8::gemm_phase<pg8::Epi<pg8::EP_MG2>, pg8::DenseSched, false>(lds, wv, 512, 512, 512, S, E); }
}
__device__ __forceinline__ void fs_out(const P& p, LAS unsigned char* lds, const int wv) {
    pg8::DenseSched S; S.init(WSP(bf16_t, WS_MG), D_, WSP(bf16_t, WS_WOUT), D_, M_, D_, gridDim.x, blockIdx.x);
    pg8::Epi<pg8::EP_RES> E{nullptr, 0, nullptr, 0, p.x, p.out, nullptr, nullptr};
    pg8::gemm_phase<pg8::Epi<pg8::EP_RES>, pg8::DenseSched, false>(lds, wv, D_, D_, D_, S, E);
}
__device__ __forceinline__ void fs_gu(const P& p, LAS unsigned char* lds, const int wv) {
    const int T = __builtin_amdgcn_readfirstlane((int)(WSP(unsigned, WS_CTL)[CW_BASE + NE] / 256u));
    LAS int* te = (LAS int*)(lds + TILEE_LDS);
    for (int i = tid_of(wv); i < NSLOT / 256; i += NT) te[i] = WSP(int, WS_TILEE)[i];
    __syncthreads();
    MoeSched S; S.init(WSP(bf16_t, WS_H2), D_ / 2, WSP(bf16_t, WS_WGU), D_ / 2, 512, te, WSP(int, WS_LTOK), T, true, gridDim.x, blockIdx.x);
    pg8::Epi<pg8::EP_HID> E{WSP(bf16_t, WS_HID), EFF, nullptr, 0, WSP(float, WS_LW), nullptr, WSP(float, WS_LR), nullptr};
    pg8::gemm_phase<pg8::Epi<pg8::EP_HID>, MoeSched, true, true>(lds, wv, D_ / 2, D_ / 2, D_ / 2, S, E);
}
__device__ __forceinline__ void fs_down(const P& p, LAS unsigned char* lds, const int wv) {
    const int T = __builtin_amdgcn_readfirstlane((int)(WSP(unsigned, WS_CTL)[CW_BASE + NE] / 256u));
    LAS int* te = (LAS int*)(lds + TILEE_LDS);
    for (int i = tid_of(wv); i < NSLOT / 256; i += NT) te[i] = WSP(int, WS_TILEE)[i];
    __syncthreads();
    MoeSched S; S.init(WSP(bf16_t, WS_HID), EFF / 2, WSP(bf16_t, WS_WDN), EFF / 2, 1024, te, WSP(int, WS_LTOK), T, false, gridDim.x, blockIdx.x);
    pg8::Epi<pg8::EP_DOWN> E{WSP(bf16_t, WS_Y), D_, nullptr, 0, nullptr, p.out};
    pg8::gemm_phase<pg8::Epi<pg8::EP_DOWN>, MoeSched, false, true>(lds, wv, EFF / 2, EFF / 2, EFF / 2, S, E);
}
__device__ __forceinline__ void fs_pp(const P& p, LAS unsigned char* lds, const int wv) {
    const int G = (int)gridDim.x, half = G / 2, c = (int)blockIdx.x - half;
    if (c < 0) return;
    pg8::DenseSched S; S.init(WSP(bf16_t, WS_PB), 256, WSP(bf16_t, WS_WPP), 256, M_, D_, G - half, c);
    pg8::Epi<pg8::EP_BF16> E{WSP(bf16_t, WS_PP), D_, nullptr, 0, nullptr, nullptr};
    pg8::gemm_phase<pg8::Epi<pg8::EP_BF16>, pg8::DenseSched, false>(lds, wv, 256, 256, 256, S, E);
}
__device__ __forceinline__ void fs_ple(const P& p, LAS unsigned char* lds, const int wv) {
    pg8::DenseSched S; S.init(WSP(bf16_t, WS_H3F8), D_ / 2, WSP(bf16_t, WS_WPG), D_ / 2, M_, D_, gridDim.x, blockIdx.x);
    pg8::Epi<pg8::EP_PLE> E{WSP(bf16_t, WS_H3), D_, WSP(bf16_t, WS_PP), D_, p.b_ple, p.out, WSP(float, WS_INV3), nullptr};
    pg8::gemm_phase<pg8::Epi<pg8::EP_PLE>, pg8::DenseSched, false, true>(lds, wv, D_ / 2, D_ / 2, D_ / 2, S, E);
}
namespace fa {
typedef short bf16x8 __attribute__((ext_vector_type(8)));
typedef short s16x4 __attribute__((ext_vector_type(4)));
typedef float f32x16 __attribute__((ext_vector_type(16)));
typedef unsigned u32x4 __attribute__((ext_vector_type(4)));
typedef unsigned u32x2 __attribute__((ext_vector_type(2)));
__device__ __forceinline__ unsigned cvtpk(float lo, float hi) { unsigned r; asm volatile("v_cvt_pk_bf16_f32 %0, %1, %2" : "=v"(r) : "v"(lo), "v"(hi)); return r; }
__device__ __forceinline__ int crow(int r, int hi) { return (r & 3) + 8 * (r >> 2) + 4 * hi; }

struct BgConv { int item, step, ngw; bool loaded; ConvJob job; f32x4_t v[8]; };
__device__ __forceinline__ void conv_finish_(const ConvJob& j, int lane, const f32x4_t (&v)[8], LAS float* scr) { conv_finish(j, lane, v, scr); }
__device__ __forceinline__ void bg_tick(const P& p, BgConv& g, int lane, LAS float* scr) {
    if (g.loaded) { conv_finish(g.job, lane, g.v, scr); g.loaded = false; g.item += g.ngw; }
    else if (g.item < CONV_NITEMS && (g.step & 3) == 0) { g.job = conv_job(p, g.item); conv_load(g.job, lane, g.v); g.loaded = true; }
    ++g.step;
}
template <int DK, bool SWA>
__device__ __forceinline__ void attn_unit(const P& p, LAS unsigned char* lds, const int wv, const int b, const int h, const int qb, const float gmax, BgConv& bg) {
    constexpr int PK = DK * 2 + 16, PV = 136, KBYTES = 64 * PK, BUF = KBYTES + 64 * PV, KS = DK / 16, CPR = DK / 8;
    int tid = tid_of(wv); asm volatile("" : "+v"(tid));
    const int lane = tid & 63, wave = wv, r32 = lane & 31, hi = lane >> 5;
    const int q0w = qb * 256 + wave * 32;
    const bf16_t* Qg = (SWA ? WSP(bf16_t, WS_QS) : WSP(bf16_t, WS_QM)) + ((size_t)(b * 8 + h) * S_ + q0w + r32) * DK;
    const int kvh = SWA ? (b * 2 + h / 4) : (b * 8 + h);
    const bf16_t* Kg = (SWA ? WSP(bf16_t, WS_KS) : WSP(bf16_t, WS_KM)) + (size_t)kvh * S_ * DK;
    const bf16_t* Vg = (SWA ? WSP(bf16_t, WS_VTS) : WSP(bf16_t, WS_VTM)) + (size_t)kvh * 64 * S_;
    bf16x8 qf[KS];
#pragma unroll
    for (int s = 0; s < KS; ++s) qf[s] = *(const bf16x8*)(Qg + 16 * s + 8 * hi);
    int t0 = 0, t1 = S_ / 64;
    if (SWA) { const int kmin = max(0, qb * 256 - 128), kmax = min(S_ - 1, qb * 256 + 255 + 128); t0 = kmin / 64; t1 = kmax / 64 + 1; }
    const int wk0 = q0w - 128, wk1 = q0w + 31 + 128;
    const int qpos = q0w + r32;
    const int kc0 = tid, kc1 = 512 + tid;
    const bool k1on = (64 * CPR > 512) && (tid < 64 * CPR - 512);
    const unsigned kd0 = (unsigned)((kc0 / CPR) * PK + (kc0 % CPR) * 16), kd1 = (unsigned)((kc1 / CPR) * PK + (kc1 % CPR) * 16);
    const int vd = tid >> 3, vp = tid & 7;
    const unsigned vdst = (unsigned)(KBYTES + vd * PV + vp * 16);
    u32x4 ak0, ak1 = {0u, 0u, 0u, 0u}, av, bk0, bk1 = {0u, 0u, 0u, 0u}, bv;
#define FA_LOAD(K0, K1, V, t) do { const int k0_ = (t) * 64; K0 = *(const u32x4*)(Kg + (size_t)k0_ * DK + kc0 * 8); if (k1on) K1 = *(const u32x4*)(Kg + (size_t)k0_ * DK + kc1 * 8); \
        V = *(const u32x4*)(Vg + (size_t)vd * S_ + k0_ + vp * 8); } while (0)
#define FA_WRITE(K0, K1, V, bufo) do { *(LAS u32x4*)(lds + (bufo) + kd0) = K0; if (k1on) *(LAS u32x4*)(lds + (bufo) + kd1) = K1; \
        *(LAS u32x2*)(lds + (bufo) + vdst) = (u32x2){V.x, V.y}; *(LAS u32x2*)(lds + (bufo) + vdst + 8) = (u32x2){V.z, V.w}; } while (0)
    float l_run; f32x16 o0, o1; bf16x8 qx;
#pragma unroll
    for (int r = 0; r < 16; ++r) { o0[r] = 0.f; o1[r] = 0.f; }
    { float q2 = 0.f;
#pragma unroll
      for (int s = 0; s < KS; ++s)
#pragma unroll
          for (int j = 0; j < 8; ++j) { const float x = __uint_as_float((unsigned)(unsigned short)qf[s][j] << 16); q2 += x * x; }
      { auto ra = __builtin_amdgcn_permlane32_swap(__float_as_uint(q2), __float_as_uint(q2), false, false); q2 = __uint_as_float(ra[0]) + __uint_as_float(ra[1]); }
      float m = fminf(sqrtf(q2) * 1.01f * gmax * sqrtf((float)DK), 60.f);
      const float sk = SWA ? p.sink[h] * LOG2E : 0.f;
      if (SWA) m = fmaxf(m, fminf(sk, 60.f));
      const bf16_t hm = f2bf(-m);
      l_run = (SWA && hi == 0) ? exp2f(sk + bf2f(hm)) : 0.f;
      qx = (bf16x8){(short)(hi == 0 ? hm : 0), 0, 0, 0, 0, 0, 0, 0}; }
    if (tid < 64) { const u32x4 one = {0x00003F80u, 0u, 0u, 0u}; *(LAS u32x4*)(lds + tid * PK + DK * 2) = one; *(LAS u32x4*)(lds + BUF + tid * PK + DK * 2) = one; }
    FA_LOAD(ak0, ak1, av, t0); FA_WRITE(ak0, ak1, av, 0);
    if (t0 + 1 < t1) FA_LOAD(ak0, ak1, av, t0 + 1);
    __syncthreads();
    auto tile = [&](const int bufo, const int k0) __attribute__((always_inline)) {
        const bool active = !SWA || !(k0 + 63 < wk0 || k0 > wk1);
        if (active) {
            f32x16 s0, s1;
            { const bf16x8 ka = *(const LAS bf16x8*)(lds + bufo + r32 * PK + DK * 2 + 16 * hi);
              const bf16x8 kb = *(const LAS bf16x8*)(lds + bufo + (32 + r32) * PK + DK * 2 + 16 * hi);
              const f32x16 z = {0.f, 0.f, 0.f, 0.f, 0.f, 0.f, 0.f, 0.f, 0.f, 0.f, 0.f, 0.f, 0.f, 0.f, 0.f, 0.f};
              s0 = __builtin_amdgcn_mfma_f32_32x32x16_bf16(ka, qx, z, 0, 0, 0); s1 = __builtin_amdgcn_mfma_f32_32x32x16_bf16(kb, qx, z, 0, 0, 0); }
#pragma unroll
            for (int s = 0; s < KS; ++s) {
                const bf16x8 ka = *(const LAS bf16x8*)(lds + bufo + r32 * PK + 32 * s + 16 * hi);
                const bf16x8 kb = *(const LAS bf16x8*)(lds + bufo + (32 + r32) * PK + 32 * s + 16 * hi);
                s0 = __builtin_amdgcn_mfma_f32_32x32x16_bf16(ka, qf[s], s0, 0, 0, 0);
                s1 = __builtin_amdgcn_mfma_f32_32x32x16_bf16(kb, qf[s], s1, 0, 0, 0);
            }
            if (SWA && (k0 < q0w + 31 - 128 || k0 + 63 > q0w + 128)) {
#pragma unroll
                for (int r = 0; r < 16; ++r) { const int d0 = k0 + crow(r, hi) - qpos, d1 = d0 + 32;
                    if (d0 > 128 || d0 < -128) s0[r] = -1e30f; if (d1 > 128 || d1 < -128) s1[r] = -1e30f; }
            }
            s16x4 va0[4], va1[4], vc0[4], vc1[4];
#pragma unroll
            for (int i = 0; i < 4; ++i) { const unsigned vo = (unsigned)(bufo + KBYTES + r32 * PV + (32 * (i >> 1) + 16 * (i & 1) + 4 * hi) * 2);
                va0[i] = *(const LAS s16x4*)(lds + vo); va1[i] = *(const LAS s16x4*)(lds + vo + 16); vc0[i] = *(const LAS s16x4*)(lds + vo + 32 * PV); vc1[i] = *(const LAS s16x4*)(lds + vo + 32 * PV + 16); }
            __builtin_amdgcn_sched_barrier(0);
            float ls = 0.f;
#pragma unroll
            for (int r = 0; r < 16; ++r) { s0[r] = __builtin_amdgcn_exp2f(s0[r]); s1[r] = __builtin_amdgcn_exp2f(s1[r]); ls += s0[r] + s1[r]; }
            l_run += ls;
#pragma unroll
            for (int i = 0; i < 4; ++i) {
                u32x4 pw;
                if (i < 2) { pw.x = cvtpk(s0[8 * i + 0], s0[8 * i + 1]); pw.y = cvtpk(s0[8 * i + 2], s0[8 * i + 3]); pw.z = cvtpk(s0[8 * i + 4], s0[8 * i + 5]); pw.w = cvtpk(s0[8 * i + 6], s0[8 * i + 7]); }
                else { const int s2 = i - 2; pw.x = cvtpk(s1[8 * s2 + 0], s1[8 * s2 + 1]); pw.y = cvtpk(s1[8 * s2 + 2], s1[8 * s2 + 3]); pw.z = cvtpk(s1[8 * s2 + 4], s1[8 * s2 + 5]); pw.w = cvtpk(s1[8 * s2 + 6], s1[8 * s2 + 7]); }
                const bf16x8 pf = __builtin_bit_cast(bf16x8, pw);
                const bf16x8 va = (bf16x8){va0[i][0], va0[i][1], va0[i][2], va0[i][3], va1[i][0], va1[i][1], va1[i][2], va1[i][3]};
                const bf16x8 vc = (bf16x8){vc0[i][0], vc0[i][1], vc0[i][2], vc0[i][3], vc1[i][0], vc1[i][1], vc1[i][2], vc1[i][3]};
                o0 = __builtin_amdgcn_mfma_f32_32x32x16_bf16(va, pf, o0, 0, 0, 0);
                o1 = __builtin_amdgcn_mfma_f32_32x32x16_bf16(vc, pf, o1, 0, 0, 0);
            }
        }
    };
    LAS float* bgscr = (LAS float*)(lds + 2 * BUF + 1024) + wave * (64 * 33);
    for (int t = t0; t < t1; t += 2) {
        if (t + 2 < t1) FA_LOAD(bk0, bk1, bv, t + 2);
        tile(0, t * 64);
        if (t + 1 < t1) FA_WRITE(ak0, ak1, av, BUF);
        bg_tick(p, bg, lane, bgscr);
        __syncthreads();
        if (t + 1 < t1) {
            if (t + 3 < t1) FA_LOAD(ak0, ak1, av, t + 3);
            tile(BUF, (t + 1) * 64);
            if (t + 2 < t1) FA_WRITE(bk0, bk1, bv, 0);
            bg_tick(p, bg, lane, bgscr);
            __syncthreads();
        }
    }
#undef FA_LOAD
#undef FA_WRITE
    float lt; { auto rl = __builtin_amdgcn_permlane32_swap(__float_as_uint(l_run), __float_as_uint(l_run), false, false); lt = __uint_as_float(rl[0]) + __uint_as_float(rl[1]); } const float il = 1.f / lt;
    bf16_t* Og = (SWA ? WSP(bf16_t, WS_OW) : WSP(bf16_t, WS_OM)) + (size_t)(b * S_ + qpos) * 512 + h * 64;
#pragma unroll
    for (int g = 0; g < 4; ++g) {
        u32x2 w0, w1;
        w0.x = cvtpk(o0[4 * g + 0] * il, o0[4 * g + 1] * il); w0.y = cvtpk(o0[4 * g + 2] * il, o0[4 * g + 3] * il);
        w1.x = cvtpk(o1[4 * g + 0] * il, o1[4 * g + 1] * il); w1.y = cvtpk(o1[4 * g + 2] * il, o1[4 * g + 3] * il);
        *(u32x2*)(Og + 8 * g + 4 * hi) = w0; *(u32x2*)(Og + 32 + 8 * g + 4 * hi) = w1;
    }
}
}
__device__ __forceinline__ void fs_attn(const P& p, LAS unsigned char* lds, const int wv) {
    const int G = gridDim.x, bx = blockIdx.x; const int vcu = (G % 8 == 0) ? (bx % 8) * (G / 8) + bx / 8 : bx;
    float gm, gs;
    { const int l = tid_of(0); float a = (l < 96) ? fabsf(p.g_kn_mla[l]) : 0.f; if (l + 64 < 96) a = fmaxf(a, fabsf(p.g_kn_mla[l + 64])); float c = (l < 64) ? fabsf(p.g_kn_swa[l]) : 0.f;
      a = wave_max(a); c = wave_max(c); gm = __uint_as_float(__builtin_amdgcn_readfirstlane(__float_as_uint(a))); gs = __uint_as_float(__builtin_amdgcn_readfirstlane(__float_as_uint(c))); }
    fa::BgConv bg; bg.item = CONV_EARLY + bx * (NT / 64) + wv; bg.step = 0; bg.ngw = G * (NT / 64); bg.loaded = false;
    for (int U = vcu; U < 512; U += G) { const int bh = U >> 3, qb = U & 7; fa::attn_unit<96, false>(p, lds, wv, bh >> 3, bh & 7, qb, gm, bg); }
    for (int U = vcu; U < 512; U += G) { const int bh = U >> 3, qb = U & 7; fa::attn_unit<64, true>(p, lds, wv, bh >> 3, bh & 7, qb, gs, bg); }
    { const int lane = tid_of(0); LAS float* scr = (LAS float*)(lds + wv * 16384);
      if (bg.loaded) { fa::conv_finish_(bg.job, lane, bg.v, scr); bg.item += bg.ngw; }
      for (; bg.item < CONV_NITEMS; bg.item += bg.ngw) { bg.job = conv_job(p, bg.item); conv_load(bg.job, lane, bg.v); fa::conv_finish_(bg.job, lane, bg.v, scr); } }
}

__device__ __forceinline__ void st_wrconv(const P& p, size_t gt, size_t ngt) {
    bf16_t* wrh = WSP(bf16_t, WS_WRH); bf16_t* wrl = WSP(bf16_t, WS_WRL);
    for (size_t i = gt; i < (size_t)NE * D_; i += ngt) { const int e = (int)(i >> 10), k = (int)(i & 1023);
        const float v = p.g_moe[k] * p.w_router[(size_t)k * NE + e]; const bf16_t h = f2bf(v); wrh[i] = h; wrl[i] = f2bf(v - bf2f(h)); }
}
__device__ __forceinline__ void st_route(const P& p, int wg, int nwg, int wave, int lane, LAS unsigned char* lds, int cnt_off = 0) {
    typedef short bf16x8 __attribute__((ext_vector_type(8))); typedef float f32x16 __attribute__((ext_vector_type(16)));
    const int r32 = lane & 31, hi = lane >> 5;
    LAS float* part = (LAS float*)lds; LAS float* ssq = (LAS float*)(lds + 131072);
    const bf16_t* WRH = WSP(bf16_t, WS_WRH); const bf16_t* WRL = WSP(bf16_t, WS_WRL);
    int* tope = WSP(int, WS_TOPE); float* topw = WSP(float, WS_TOPW); int* topls = WSP(int, WS_TOPLS); float* rstd2 = WSP(float, WS_RSTD2);
    unsigned char* h2f8 = WSP(unsigned char, WS_H2);
    int* wcnt = WSP(int, WS_WCNT) + cnt_off; int* tcnt = WSP(int, WS_TCNT) + (cnt_off ? 16384 : 0);
    LAS int* cntl = (LAS int*)(lds + 131072 + 2048);
    for (int tile = wg; tile < M_ / 64; tile += nwg) {
        f32x16 acc[2][2];
#pragma unroll
        for (int a = 0; a < 2; ++a)
#pragma unroll
            for (int b = 0; b < 2; ++b)
#pragma unroll
                for (int r = 0; r < 16; ++r) acc[a][b][r] = 0.f;
        float sq[2] = {0.f, 0.f};
        const float* xb = p.out + (size_t)(tile * 64 + r32) * D_ + wave * 128 + 8 * hi;
        const bf16_t* whb = WRH + (size_t)r32 * D_ + wave * 128 + 8 * hi; const bf16_t* wlb = WRL + (size_t)r32 * D_ + wave * 128 + 8 * hi;
#pragma unroll 2
        for (int s = 0; s < 8; ++s) {
            bf16x8 xh[2], xl[2], wh[2], wl[2];
#pragma unroll
            for (int tb = 0; tb < 2; ++tb) {
                const float* xp = xb + (size_t)(32 * tb) * D_ + 16 * s; const f32x4_t a = *(const f32x4_t*)xp, b = *(const f32x4_t*)(xp + 4);
                sq[tb] += (a.x * a.x + a.y * a.y) + (a.z * a.z + a.w * a.w) + (b.x * b.x + b.y * b.y) + (b.z * b.z + b.w * b.w);
                u32x4_t h, l;
                h.x = cvtpk_(a.x, a.y); h.y = cvtpk_(a.z, a.w); h.z = cvtpk_(b.x, b.y); h.w = cvtpk_(b.z, b.w);
                l.x = cvtpk_(a.x - bflo(h.x), a.y - bfhi(h.x)); l.y = cvtpk_(a.z - bflo(h.y), a.w - bfhi(h.y));
                l.z = cvtpk_(b.x - bflo(h.z), b.y - bfhi(h.z)); l.w = cvtpk_(b.z - bflo(h.w), b.w - bfhi(h.w));
                xh[tb] = __builtin_bit_cast(bf16x8, h); xl[tb] = __builtin_bit_cast(bf16x8, l);
            }
#pragma unroll
            for (int eb = 0; eb < 2; ++eb) { wh[eb] = *(const bf16x8*)(whb + (size_t)(32 * eb) * D_ + 16 * s); wl[eb] = *(const bf16x8*)(wlb + (size_t)(32 * eb) * D_ + 16 * s); }
#pragma unroll
            for (int tb = 0; tb < 2; ++tb)
#pragma unroll
                for (int eb = 0; eb < 2; ++eb) {
                    acc[tb][eb] = __builtin_amdgcn_mfma_f32_32x32x16_bf16(xh[tb], wh[eb], acc[tb][eb], 0, 0, 0);
                    acc[tb][eb] = __builtin_amdgcn_mfma_f32_32x32x16_bf16(xh[tb], wl[eb], acc[tb][eb], 0, 0, 0);
                    acc[tb][eb] = __builtin_amdgcn_mfma_f32_32x32x16_bf16(xl[tb], wh[eb], acc[tb][eb], 0, 0, 0);
                }
        }
#pragma unroll
        for (int tb = 0; tb < 2; ++tb) {
#pragma unroll
            for (int eb = 0; eb < 2; ++eb)
#pragma unroll
                for (int r = 0; r < 16; ++r) part[(wave * 64 + 32 * tb + (r & 3) + 8 * (r >> 2) + 4 * hi) * 64 + 32 * eb + r32] = acc[tb][eb][r];
            const float st = sq[tb] + __shfl_xor(sq[tb], 32);
            if (hi == 0) ssq[wave * 64 + 32 * tb + r32] = st;
        }
        __syncthreads();
        int cw = 0;
        for (int tt = 0; tt < 8; ++tt) {
            const int tok = wave * 8 + tt, m = tile * 64 + tok;
            const float* xr = p.out + (size_t)m * D_ + lane * 16;
            const f32x4_t x0 = *(const f32x4_t*)xr, x1v = *(const f32x4_t*)(xr + 4), x2v = *(const f32x4_t*)(xr + 8), x3v = *(const f32x4_t*)(xr + 12);
            float lg = 0.f, ss = 0.f;
#pragma unroll
            for (int w = 0; w < 8; ++w) { lg += part[(w * 64 + tok) * 64 + lane]; ss += ssq[w * 64 + tok]; }
            const float rstd = 1.f / sqrtf(ss * (1.f / D_) + EPS);
            const float score = sigmoidf_(lg * rstd); const float sel = score + p.router_bias[lane];
            float m1 = sel;
            m1 = fmaxf(m1, __shfl_xor(m1, 1)); m1 = fmaxf(m1, __shfl_xor(m1, 2)); m1 = fmaxf(m1, __shfl_xor(m1, 4));
            const unsigned long long eqm = __ballot(sel == m1);
            const int g = lane >> 3; const unsigned gm = (unsigned)((eqm >> (g * 8)) & 0xffull);
            const int first = __ffs((int)gm) - 1;
            float v2 = ((lane & 7) == first) ? -3.0e38f : sel;
            v2 = fmaxf(v2, __shfl_xor(v2, 1)); v2 = fmaxf(v2, __shfl_xor(v2, 2)); v2 = fmaxf(v2, __shfl_xor(v2, 4));
            const float gs = m1 + v2;
            int grank = 0;
#pragma unroll
            for (int j = 0; j < 8; ++j) { const float o = __shfl(gs, j * 8); grank += (o > gs || (o == gs && j < g)) ? 1 : 0; }
            const float msel = (grank < 4) ? sel : -1e30f;
            int rank = 0;
#pragma unroll
            for (int j = 0; j < 64; ++j) { const float o = __uint_as_float((unsigned)__builtin_amdgcn_readlane((int)__float_as_uint(msel), j)); rank += (o > msel) ? 1 : 0; }
            { const bool ch = rank < TOPK; const int nch = __builtin_popcountll(__ballot(ch)); const float sr = wave_sum_dpp(ch ? (float)rank : 0.f);
              if (nch != TOPK || sr != 28.f) { rank = 0;
                  for (int j = 0; j < 64; ++j) { const float o = __uint_as_float((unsigned)__builtin_amdgcn_readlane((int)__float_as_uint(msel), j)); rank += (o > msel || (o == msel && j < lane)) ? 1 : 0; } } }
            const bool chosen = rank < TOPK;
            const float wsum = wave_sum(chosen ? score : 0.f);
            if (chosen) { tope[m * TOPK + rank] = lane; topw[m * TOPK + rank] = score / wsum * 2.5f; topls[m * TOPK + rank] = cw; ++cw; }
            if (lane == 0) rstd2[m] = rstd;
            { const float q = rstd * pg8::XN_SC; u32x4_t w; int d;
              d = 0; d = __builtin_amdgcn_cvt_pk_fp8_f32(x0.x * q, x0.y * q, d, false); d = __builtin_amdgcn_cvt_pk_fp8_f32(x0.z * q, x0.w * q, d, true); w.x = (unsigned)d;
              d = 0; d = __builtin_amdgcn_cvt_pk_fp8_f32(x1v.x * q, x1v.y * q, d, false); d = __builtin_amdgcn_cvt_pk_fp8_f32(x1v.z * q, x1v.w * q, d, true); w.y = (unsigned)d;
              d = 0; d = __builtin_amdgcn_cvt_pk_fp8_f32(x2v.x * q, x2v.y * q, d, false); d = __builtin_amdgcn_cvt_pk_fp8_f32(x2v.z * q, x2v.w * q, d, true); w.z = (unsigned)d;
              d = 0; d = __builtin_amdgcn_cvt_pk_fp8_f32(x3v.x * q, x3v.y * q, d, false); d = __builtin_amdgcn_cvt_pk_fp8_f32(x3v.z * q, x3v.w * q, d, true); w.w = (unsigned)d;
              *(u32x4_t*)(h2f8 + (size_t)m * D_ + lane * 16) = w; }
        }
        wcnt[(tile * 8 + wave) * NE + lane] = cw; cntl[wave * 64 + lane] = cw;
        __syncthreads();
        if (wave == 0) { int t = 0;
#pragma unroll
            for (int w = 0; w < 8; ++w) t += cntl[w * 64 + lane];
            tcnt[tile * NE + lane] = t; }
    }
}
__device__ __forceinline__ void st_lists(const P& p, size_t gt, size_t ngt, int tid, int wg, int nwg, LAS unsigned* L) {
    const int* wcnt = WSP(int, WS_WCNT); const int* tcnt = WSP(int, WS_TCNT); unsigned* basew = WSP(unsigned, WS_CTL) + CW_BASE;
    const int* tope = WSP(int, WS_TOPE); const float* topw = WSP(float, WS_TOPW); const int* topls = WSP(int, WS_TOPLS); const float* rstd2 = WSP(float, WS_RSTD2);
    int* pos = WSP(int, WS_POS); int* ltok = WSP(int, WS_LTOK); float* lw = WSP(float, WS_LW); float* lr = WSP(float, WS_LR); int* tile_e = WSP(int, 5 * MiB);
    const int w8 = tid >> 6, e = tid & 63;
    for (int tile = wg; tile < M_ / 64; tile += nwg) {
        __syncthreads();
        { int tot = 0, pre = 0;
#pragma unroll
          for (int i = w8; i < 256; i += 8) { const int v = tcnt[i * NE + e]; tot += v; pre += (i < tile) ? v : 0; }
          L[tid] = (unsigned)tot; L[512 + tid] = (unsigned)pre; }
        __syncthreads();
        if (tid < 64) { unsigned tot = 0, pre = 0;
#pragma unroll
            for (int w = 0; w < 8; ++w) { tot += L[w * 64 + tid]; pre += L[512 + w * 64 + tid]; }
            const unsigned pc = (tot + 255u) & ~255u; unsigned v = pc;
#pragma unroll
            for (int o = 1; o < 64; o <<= 1) { const unsigned t = __shfl_up(v, o); if (tid >= o) v += t; }
            L[1024 + tid] = v - pc; L[1088 + tid] = tot; if (tid == 63) L[1152] = v;
            unsigned run = v - pc + pre;
#pragma unroll
            for (int w = 0; w < 8; ++w) { L[1216 + w * 64 + tid] = run; run += (unsigned)wcnt[(tile * 8 + w) * NE + tid]; } }
        __syncthreads();
        { const int i = tile * 512 + tid; const int ex = tope[i], tok = i >> 3, w = (tok & 63) >> 3;
          const int slot = (int)L[1216 + w * 64 + ex] + topls[i];
          pos[i] = slot; ltok[slot] = tok; lw[slot] = topw[i]; lr[slot] = rstd2[tok]; }
    }
    for (size_t i = gt; i < (size_t)NE * 256; i += ngt) {
        const int ex = (int)(i / 256), j = (int)(i % 256); const unsigned base = L[1024 + ex], n = L[1088 + ex], np = (n + 255u) & ~255u;
        if (n + j < np) { ltok[base + n + j] = 0; lw[base + n + j] = 0.f; lr[base + n + j] = 0.f; }
    }
    if (gt < 64) basew[gt] = L[1024 + gt];
    if (gt == 64) basew[NE] = L[1152];
    for (size_t i = gt; i < (size_t)(NSLOT / 256); i += ngt) { int ex = -1;
        for (int q = 0; q < NE; ++q) { const unsigned b0 = L[1024 + q], b1 = b0 + ((L[1088 + q] + 255u) & ~255u); if ((unsigned)i * 256u >= b0 && (unsigned)i * 256u < b1) ex = q; }
        tile_e[i] = ex; }
    for (size_t i = gt; i < (size_t)M_; i += ngt) { ltok[NSLOT + i] = (int)i; lw[NSLOT + i] = 1.f; lr[NSLOT + i] = rstd2[i]; }
}
__device__ __forceinline__ void st_combine(const P& p, int gw, int ngw, int lane, bool dry = false) {
    typedef float f32x2_t __attribute__((ext_vector_type(2)));
    const int* pos = WSP(int, WS_POS); const unsigned char* Y8 = WSP(unsigned char, WS_Y); bf16_t* h3 = WSP(bf16_t, WS_H3);
    for (int m = gw; m < M_; m += ngw) {
        f32x4_t* xr = (f32x4_t*)(p.out + (size_t)m * D_) + 4 * lane; f32x4_t v[4];
        int ps[TOPK];
#pragma unroll
        for (int k = 0; k < TOPK; ++k) ps[k] = __builtin_amdgcn_readfirstlane(pos[m * TOPK + k]);
#pragma unroll
        for (int j = 0; j < 4; ++j) v[j] = xr[j];
        u32x4_t y[TOPK + 1];
#pragma unroll
        for (int k = 0; k < TOPK + 1; ++k) y[k] = ((const u32x4_t*)(Y8 + (size_t)(k < TOPK ? ps[k] : NSLOT + m) * 1024))[lane];
        f32x4_t acc[4];
#pragma unroll
        for (int j = 0; j < 4; ++j) acc[j] = (f32x4_t){0.f, 0.f, 0.f, 0.f};
#pragma unroll
        for (int k = 0; k < TOPK + 1; ++k)
#pragma unroll
            for (int j = 0; j < 4; ++j) { const int w = (int)y[k][j]; const f32x2_t lo = __builtin_amdgcn_cvt_pk_f32_fp8(w, false), hi = __builtin_amdgcn_cvt_pk_f32_fp8(w, true);
                acc[j].x += lo.x; acc[j].y += lo.y; acc[j].z += hi.x; acc[j].w += hi.y; }
        float s = 0.f;
#pragma unroll
        for (int j = 0; j < 4; ++j) { v[j] = v[j] + acc[j] * (1.f / 16.f); s += (v[j].x * v[j].x + v[j].y * v[j].y) + (v[j].z * v[j].z + v[j].w * v[j].w); }
        s = wave_sum(s); const float rr = sqrtf(s * (1.f / D_) + EPS), r = 1.f / rr;
        if (lane == 0 && !dry) WSP(float, WS_INV3)[m] = rr;
        u32x4_t* o = (u32x4_t*)(h3 + (size_t)m * D_) + 2 * lane;
        o[0] = (u32x4_t){cvtpk_(v[0].x * r, v[0].y * r), cvtpk_(v[0].z * r, v[0].w * r), cvtpk_(v[1].x * r, v[1].y * r), cvtpk_(v[1].z * r, v[1].w * r)};
        o[1] = (u32x4_t){cvtpk_(v[2].x * r, v[2].y * r), cvtpk_(v[2].z * r, v[2].w * r), cvtpk_(v[3].x * r, v[3].y * r), cvtpk_(v[3].z * r, v[3].w * r)};
        { const float q = r * 8.f; u32x4_t w;
#pragma unroll
          for (int j = 0; j < 4; ++j) { int d = 0; d = __builtin_amdgcn_cvt_pk_fp8_f32(v[j].x * q, v[j].y * q, d, false); d = __builtin_amdgcn_cvt_pk_fp8_f32(v[j].z * q, v[j].w * q, d, true); w[j] = (unsigned)d; }
          ((u32x4_t*)(WSP(unsigned char, WS_H3F8) + (size_t)m * D_))[lane] = w; }
    }
}

#ifndef FAST_MASK
#define FAST_MASK 0xffff
#endif
constexpr int LDS_DYN = 144 * 1024;
constexpr int MISC_OFF = 132 * 1024;
constexpr int N_STAGES = 13;
__global__ void __launch_bounds__(NT) k_fwd(P p) {
    extern __shared__ __attribute__((aligned(16))) unsigned char lds[];
    const int wave_s = __builtin_amdgcn_readfirstlane((int)threadIdx.x >> 6);
    const int tid0 = tid_of(wave_s);
    volatile LAS unsigned* misc = (volatile LAS unsigned*)((LAS unsigned char*)lds + MISC_OFF);
    if (tid0 < 16) misc[tid0] = 0u;
    __syncthreads();
    XcdBarrier bar = xcd_barrier_post(WSP(unsigned, WS_CTL) + CW_BAR, misc, wave_s);
    const int lo = p.st_lo, hi = p.st_hi;
#ifdef TIME_STAGE
    unsigned long long* stamps = (unsigned long long*)(p.ws + 5 * MiB + 65536);
    if (blockIdx.x == 0 && tid_of(wave_s) == 0) stamps[0] = __builtin_amdgcn_s_memrealtime();
#define STAMP(k) do { if (blockIdx.x == 0 && tid_of(wave_s) == 0) stamps[(k) + 1] = __builtin_amdgcn_s_memrealtime(); } while (0)
#else
#define STAMP(k) do {} while (0)
#endif
#ifndef DUP_STAGE
#define DUP_STAGE -1
#endif
#ifndef DUP_N
#define DUP_N 1
#endif
#if DUP_STAGE == 0
#define DUPCALL (st_prep(p, gw, ngw, lane), st_rope(p, gt, ngt), st_wrconv(p, gt, ngt), st_wconv(p, gw, ngw, lane, (LAS float*)((LAS unsigned char*)lds + wave * 16384)))
#elif DUP_STAGE == 1
#define DUPCALL fs_g1(p, (LAS unsigned char*)lds, wave_s)
#elif DUP_STAGE == 2
#define DUPCALL fs_g23(p, (LAS unsigned char*)lds, wave_s)
#elif DUP_STAGE == 3
#define DUPCALL st_attn_prep(p, wg, nwg, wave, lane, (bf16_t*)lds)
#elif DUP_STAGE == 4
#define DUPCALL fs_attn(p, (LAS unsigned char*)lds, wave_s)
#elif DUP_STAGE == 5
#define DUPCALL fs_merge(p, (LAS unsigned char*)lds, wave_s)
#elif DUP_STAGE == 6
#define DUPCALL fs_out(p, (LAS unsigned char*)lds, wave_s)
#elif DUP_STAGE == 7
#define DUPCALL st_route(p, wg, nwg, wave, lane, (LAS unsigned char*)lds, 2048)
#elif DUP_STAGE == 8
#define DUPCALL st_lists(p, gt, ngt, tid, wg, nwg, (LAS unsigned*)((LAS unsigned char*)lds))
#elif DUP_STAGE == 9
#define DUPCALL fs_gu(p, (LAS unsigned char*)lds, wave_s)
#elif DUP_STAGE == 11
#define DUPCALL st_combine(p, gw, ngw, lane, true)
#else
#define DUPCALL
#endif
#define RUN(k, call) if (lo <= (k) && (k) < hi) { { int tid = tid_of(wave_s); asm volatile("" : "+v"(tid)); const int lane = tid & 63, wave = tid >> 6; const int wg = blockIdx.x, nwg = gridDim.x; \
        const int gw = wg * (NT / 64) + wave, ngw = nwg * (NT / 64); const size_t gt = (size_t)wg * NT + tid, ngt = (size_t)nwg * NT; \
        (void)lane; (void)wave; (void)wg; (void)nwg; (void)gw; (void)ngw; (void)gt; (void)ngt; \
        if ((k) == DUP_STAGE) { for (int d_ = 0; d_ < DUP_N; ++d_) { DUPCALL; xcd_barrier(bar); } } call; } if ((k) + 1 < hi) xcd_barrier(bar); STAMP(k); }
    RUN(0, (st_prep(p, gw, ngw, lane), st_rope(p, gt, ngt), st_wrconv(p, gt, ngt), st_wconv(p, gw, ngw, lane, (LAS float*)((LAS unsigned char*)lds + wave * 16384))))
    RUN(1, (fs_g1(p, (LAS unsigned char*)lds, wave_s), fs_pp(p, (LAS unsigned char*)lds, wave_s)))
    RUN(2, fs_g23(p, (LAS unsigned char*)lds, wave_s))
    RUN(3, st_attn_prep(p, wg, nwg, wave, lane, (bf16_t*)lds))
    RUN(4, fs_attn(p, (LAS unsigned char*)lds, wave_s))
    RUN(5, fs_merge(p, (LAS unsigned char*)lds, wave_s))
    RUN(6, fs_out(p, (LAS unsigned char*)lds, wave_s))
    RUN(7, st_route(p, wg, nwg, wave, lane, (LAS unsigned char*)lds))
    RUN(8, st_lists(p, gt, ngt, tid, wg, nwg, (LAS unsigned*)((LAS unsigned char*)lds)))
    RUN(9, fs_gu(p, (LAS unsigned char*)lds, wave_s))
    RUN(10, fs_down(p, (LAS unsigned char*)lds, wave_s))
    RUN(11, st_combine(p, gw, ngw, lane))
    RUN(12, fs_ple(p, (LAS unsigned char*)lds, wave_s))
#undef RUN
#ifdef TIME_STAGE
    xcd_barrier(bar);
    if (tid_of(wave_s) == 0) { const unsigned long long d = __hip_atomic_load(&stamps[TIME_STAGE + 1], __ATOMIC_RELAXED, __HIP_MEMORY_SCOPE_AGENT) - __hip_atomic_load(&stamps[TIME_STAGE], __ATOMIC_RELAXED, __HIP_MEMORY_SCOPE_AGENT);
        const unsigned long long t0 = __builtin_amdgcn_s_memrealtime(); while (__builtin_amdgcn_s_memrealtime() - t0 < 4ull * d) __builtin_amdgcn_s_sleep(8); }
    __syncthreads();
#endif
}

extern "C" void kernel_launch(void* const* d_in, const int* in_sizes, int n_in, void* d_out, int out_size, void* d_ws, size_t ws_size, hipStream_t stream) {
    if (n_in != 29 || ws_size < WS_END) { fprintf(stderr, "kernel_launch: unexpected n_in %d or ws_size %zu\n", n_in, ws_size); return; }
    P p{};
    p.x = (const float*)d_in[0]; p.p = (const float*)d_in[1]; p.pos = (const int*)d_in[2];
#define IN_(name, i) p.name = (const float*)d_in[i]
    IN_(g_mix, 3); IN_(w_in, 4); IN_(b_gate, 5); IN_(g_cq, 6); IN_(w_uq, 7); IN_(g_ckv, 8); IN_(w_ukv, 9); IN_(g_qn_mla, 10); IN_(g_kn_mla, 11);
    IN_(g_qn_swa, 12); IN_(g_kn_swa, 13); IN_(sink, 14); IN_(w_br_mla, 15); IN_(w_br_swa, 16); IN_(w_out, 17); IN_(g_moe, 18); IN_(w_router, 19);
    IN_(router_bias, 20); IN_(w_exp_gu, 21); IN_(w_exp_down, 22); IN_(w_sh_gu, 23); IN_(w_sh_down, 24); IN_(g_ple, 25); IN_(w_ple_gate, 26); IN_(b_ple, 27); IN_(w_ple_proj, 28);
#undef IN_
    p.out = (float*)d_out; p.ws = (unsigned char*)d_ws;
    static int grid = 0;
    if (grid == 0) {
        int dev = 0, cus = 0, per_cu = 0;
        (void)hipGetDevice(&dev); (void)hipDeviceGetAttribute(&cus, hipDeviceAttributeMultiprocessorCount, dev);
        (void)hipFuncSetAttribute((const void*)k_fwd, hipFuncAttributeMaxDynamicSharedMemorySize, LDS_DYN);
        (void)hipOccupancyMaxActiveBlocksPerMultiprocessor(&per_cu, (const void*)k_fwd, NT, LDS_DYN);
        (void)hipGetLastError();
        if (per_cu < 1) { fprintf(stderr, "kernel_launch: occupancy query says %d blocks per CU\n", per_cu); grid = -1; return; }
        grid = cus;
    }
    if (grid < 0) return;
    (void)hipMemsetAsync((char*)d_ws + WS_CTL, 0, CTL_BYTES, stream);
    p.st_lo = 0; p.st_hi = N_STAGES;
    void* args[] = {&p};
    hipError_t e = hipLaunchCooperativeKernel((const void*)k_fwd, dim3(grid), dim3(NT), args, LDS_DYN, stream);
    if (e != hipSuccess) fprintf(stderr, "cooperative launch failed: %s (grid %d)\n", hipGetErrorString(e), grid);
}
```

```cpp
#include <hip/hip_runtime.h>
#include <stdint.h>
#include <cstdio>

constexpr int B_ = 8, S_ = 2048, D_ = 1024, M_ = B_ * S_;
constexpr int NZ = 3584;
constexpr int INW = 3488;
constexpr int ZQ = 0, ZKR = 384, ZCKV = 512, ZQS = 768, ZKS = 1280, ZVS = 1408, ZGA = 1536, ZGB = 2560;
constexpr int NE = 64, TOPK = 8, EFF = 256;
constexpr int NSLOT = M_ * TOPK + NE * 256;
constexpr float EPS = 1e-6f;
constexpr float LOG2E = 1.4426950408889634f;

typedef unsigned short bf16_t;
__device__ __forceinline__ float bf2f(bf16_t v) { return __uint_as_float((unsigned)v << 16); }
__device__ __forceinline__ bf16_t f2bf(float f) { unsigned u = __float_as_uint(f); return (bf16_t)((u + 0x7fffu + ((u >> 16) & 1u)) >> 16); }
__device__ __forceinline__ float sigmoidf_(float v) { return 1.f / (1.f + __expf(-v)); }
__device__ __forceinline__ float wave_sum(float v) {
#pragma unroll
    for (int o = 1; o < 64; o <<= 1) v += __shfl_xor(v, o);
    return v;
}
__device__ __forceinline__ float wave_max(float v) {
#pragma unroll
    for (int o = 1; o < 64; o <<= 1) v = fmaxf(v, __shfl_xor(v, o));
    return v;
}

constexpr size_t MiB = 1u << 20;
constexpr size_t WS_CTL = 0, CTL_BYTES = 64 * 1024;
constexpr size_t WS_TOPE = 1 * MiB, WS_TOPW = WS_TOPE + 512 * 1024, WS_TOPLS = WS_TOPW + 512 * 1024, WS_POS = WS_TOPLS + 512 * 1024;
constexpr size_t WS_LTOK = 3 * MiB, WS_LW = WS_LTOK + 640 * 1024;
constexpr size_t WS_PB = 6 * MiB, WS_WDN = 14 * MiB, WS_WPG = 48 * MiB, WS_WPP = 50 * MiB, WS_WSHDN = 46 * MiB;
constexpr size_t WS_HID = 51 * MiB, WS_HSH = 123 * MiB, WS_R = 131 * MiB;
constexpr size_t WS_WGU = 131 * MiB, WS_WSHGU = 195 * MiB, WS_WIN = 196 * MiB, WS_WUQ = 203 * MiB, WS_WUKV = 204 * MiB, WS_WBRM = 205 * MiB, WS_WBRS = 206 * MiB, WS_WOUT = 207 * MiB;
constexpr size_t WS_Z = 210 * MiB, WS_HB = 322 * MiB, WS_MG = 322 * MiB, WS_QMR = 354 * MiB, WS_OM = 354 * MiB, WS_OW = 370 * MiB, WS_KVR = 378 * MiB;
constexpr size_t WS_QM = 410 * MiB, WS_KM = 434 * MiB, WS_VTM = 458 * MiB, WS_QS = 474 * MiB, WS_KS = 490 * MiB, WS_VTS = 494 * MiB;
constexpr size_t WS_H3F8 = 31 * MiB;
constexpr size_t WS_H2 = 210 * MiB, WS_Y = 131 * MiB, WS_H3 = 419 * MiB, WS_PP = 93 * MiB, WS_END = 498 * MiB;
constexpr size_t WS_WRH = 209 * MiB, WS_WRL = WS_WRH + 128 * 1024, WS_RSTD2 = WS_WRL + 128 * 1024;
constexpr size_t WS_LR = WS_LW + 640 * 1024;
constexpr size_t WS_INV3 = WS_TOPW;
constexpr size_t WS_WCNT = WS_RSTD2 + 64 * 1024;
constexpr size_t WS_TCNT = WS_WCNT + 512 * 1024;
constexpr int CW_CNT = 0;
constexpr int CW_BASE = 64;

struct P {
    const float *x, *p; const int* pos;
    const float *g_mix, *w_in, *b_gate, *g_cq, *w_uq, *g_ckv, *w_ukv, *g_qn_mla, *g_kn_mla, *g_qn_swa, *g_kn_swa, *sink;
    const float *w_br_mla, *w_br_swa, *w_out, *g_moe, *w_router, *router_bias, *w_exp_gu, *w_exp_down, *w_sh_gu, *w_sh_down;
    const float *g_ple, *w_ple_gate, *b_ple, *w_ple_proj;
    float* out; unsigned char* ws; int st_lo; int st_hi;
};
#define WSP(T, off) ((T*)(p.ws + (off)))
__device__ __forceinline__ int tid_of(int wv) { int l; asm volatile("v_mbcnt_lo_u32_b32 %0, -1, 0\n\tv_mbcnt_hi_u32_b32 %0, -1, %0" : "=v"(l)); return wv * 64 + l; }

typedef float f32x4_t __attribute__((ext_vector_type(4)));
typedef unsigned u32x2_t __attribute__((ext_vector_type(2)));
typedef unsigned u32x4_t __attribute__((ext_vector_type(4)));
__device__ __forceinline__ unsigned cvtpk_(float lo, float hi) { unsigned r; asm volatile("v_cvt_pk_bf16_f32 %0, %1, %2" : "=v"(r) : "v"(lo), "v"(hi)); return r; }
__device__ __forceinline__ float bflo(unsigned w) { return __uint_as_float(w << 16); }
__device__ __forceinline__ float bfhi(unsigned w) { return __uint_as_float(w & 0xffff0000u); }
__device__ __forceinline__ void st_prep(const P& p, int gw, int ngw, int lane) {
    bf16_t* hb = WSP(bf16_t, WS_HB); bf16_t* pb = WSP(bf16_t, WS_PB);
    f32x4_t nv[4], npv;
    if (gw < M_) { const f32x4_t* xr = (const f32x4_t*)(p.x + (size_t)gw * D_) + lane;
#pragma unroll
        for (int j = 0; j < 4; ++j) nv[j] = xr[64 * j];
        npv = ((const f32x4_t*)(p.p + (size_t)gw * 256))[lane]; }
    for (int m = gw; m < M_; m += ngw) {
        f32x4_t v[4]; const f32x4_t pv = npv; float s = 0.f;
#pragma unroll
        for (int j = 0; j < 4; ++j) v[j] = nv[j];
        if (m + ngw < M_) { const f32x4_t* xr = (const f32x4_t*)(p.x + (size_t)(m + ngw) * D_) + lane;
#pragma unroll
            for (int j = 0; j < 4; ++j) nv[j] = xr[64 * j];
            npv = ((const f32x4_t*)(p.p + (size_t)(m + ngw) * 256))[lane]; }
#pragma unroll
        for (int j = 0; j < 4; ++j) s += (v[j].x * v[j].x + v[j].y * v[j].y) + (v[j].z * v[j].z + v[j].w * v[j].w);
        s = wave_sum(s); const float r = 1.f / sqrtf(s * (1.f / D_) + EPS);
        u32x2_t* o = (u32x2_t*)(hb + (size_t)m * D_) + lane;
#pragma unroll
        for (int j = 0; j < 4; ++j) o[64 * j] = (u32x2_t){cvtpk_(v[j].x * r, v[j].y * r), cvtpk_(v[j].z * r, v[j].w * r)};
        ((u32x2_t*)(pb + (size_t)m * 256))[lane] = (u32x2_t){cvtpk_(pv.x, pv.y), cvtpk_(pv.z, pv.w)};
    }
}
constexpr size_t WS_CS = 51 * MiB;
__device__ __forceinline__ void st_rope(const P& p, size_t gt, size_t ngt) {
    float* cs = WSP(float, WS_CS);
    for (size_t i = gt; i < (size_t)M_ * 48; i += ngt) { const int m = (int)(i / 48), f = (int)(i % 48);
        const float posf = (float)p.pos[m]; float sv, cv;
        if (f < 16) { float rev = posf * exp2f(-13.287712379549449f * (float)f * (1.f / 16.f)) * 0.15915494309189535f; rev -= floorf(rev); sv = __builtin_amdgcn_sinf(rev); cv = __builtin_amdgcn_cosf(rev);
            cs[(size_t)m * 96 + f] = cv; cs[(size_t)m * 96 + 16 + f] = sv; }
        else { const int g = f - 16; float rev = posf * exp2f(-13.287712379549449f * (float)g * (1.f / 32.f)) * 0.15915494309189535f; rev -= floorf(rev); sv = __builtin_amdgcn_sinf(rev); cv = __builtin_amdgcn_cosf(rev);
            cs[(size_t)m * 96 + 32 + g] = cv; cs[(size_t)m * 96 + 64 + g] = sv; } }
}
constexpr int VT_PITCH = 72;
typedef float f32x2_t __attribute__((ext_vector_type(2)));
struct P8 { f32x2_t p[4]; };
__device__ __forceinline__ P8 cvp8(const u32x4_t w) { P8 r; r.p[0] = (f32x2_t){bflo(w.x), bfhi(w.x)}; r.p[1] = (f32x2_t){bflo(w.y), bfhi(w.y)}; r.p[2] = (f32x2_t){bflo(w.z), bfhi(w.z)}; r.p[3] = (f32x2_t){bflo(w.w), bfhi(w.w)}; return r; }
__device__ __forceinline__ P8 ldp8(const float* ptr) { const f32x4_t a = *(const f32x4_t*)ptr, b = *(const f32x4_t*)(ptr + 4); P8 r; r.p[0] = (f32x2_t){a.x, a.y}; r.p[1] = (f32x2_t){a.z, a.w}; r.p[2] = (f32x2_t){b.x, b.y}; r.p[3] = (f32x2_t){b.z, b.w}; return r; }
__device__ __forceinline__ P8 f4p8(const f32x4_t a, const f32x4_t b) { P8 r; r.p[0] = (f32x2_t){a.x, a.y}; r.p[1] = (f32x2_t){a.z, a.w}; r.p[2] = (f32x2_t){b.x, b.y}; r.p[3] = (f32x2_t){b.z, b.w}; return r; }
__device__ __forceinline__ void stp8(bf16_t* ptr, const P8& x) { u32x4_t w; w.x = cvtpk_(x.p[0].x, x.p[0].y); w.y = cvtpk_(x.p[1].x, x.p[1].y); w.z = cvtpk_(x.p[2].x, x.p[2].y); w.w = cvtpk_(x.p[3].x, x.p[3].y); *(u32x4_t*)ptr = w; }
__device__ __forceinline__ float ssqp(const P8& x) { f32x2_t a = x.p[0] * x.p[0]; a = x.p[1] * x.p[1] + a; a = x.p[2] * x.p[2] + a; a = x.p[3] * x.p[3] + a; return a.x + a.y; }
template <int CTRL> __device__ __forceinline__ float dppf(float v) { return __uint_as_float((unsigned)__builtin_amdgcn_update_dpp(0, (int)__float_as_uint(v), CTRL, 0xF, 0xF, true)); }
__device__ __forceinline__ float sum8_dpp(float v) { v += dppf<0x141>(v); v += dppf<0xB1>(v); v += dppf<0x4E>(v); return v; }
__device__ __forceinline__ float sum16_dpp(float v) { v += dppf<0x140>(v); return sum8_dpp(v); }
__device__ __forceinline__ float wave_sum_dpp(float v) { v = sum16_dpp(v);
    return __uint_as_float((unsigned)__builtin_amdgcn_readlane((int)__float_as_uint(v), 0)) + __uint_as_float((unsigned)__builtin_amdgcn_readlane((int)__float_as_uint(v), 16))
         + __uint_as_float((unsigned)__builtin_amdgcn_readlane((int)__float_as_uint(v), 32)) + __uint_as_float((unsigned)__builtin_amdgcn_readlane((int)__float_as_uint(v), 48)); }
template <int GL, int PX>
__device__ __forceinline__ void norm_rope(P8& x, bool valid, float pre, float inv_n, const P8& g, const P8& c, const P8& s) {
    float ss = valid ? pre * pre * ssqp(x) : 0.f;
    ss = (GL == 16) ? sum16_dpp(ss) : sum8_dpp(ss);
    const float r = pre * __builtin_amdgcn_rsqf(ss * inv_n + EPS);
    const f32x2_t rr = {r, r};
#pragma unroll
    for (int j = 0; j < 4; ++j) { x.p[j] *= rr * g.p[j];
        f32x2_t o;
        o.x = (PX == 2) ? dppf<0x4E>(x.p[j].x) : dppf<0x1B>(dppf<0x141>(x.p[j].x)); o.y = (PX == 2) ? dppf<0x4E>(x.p[j].y) : dppf<0x1B>(dppf<0x141>(x.p[j].y));
        x.p[j] = x.p[j] * c.p[j] + o * s.p[j]; }
}
__device__ __forceinline__ void st_attn_prep(const P& p, int wg, int nwg, int wave, int lane, bf16_t* lds) {
    const bf16_t* z = WSP(bf16_t, WS_Z); const bf16_t* qmr = WSP(bf16_t, WS_QMR); const bf16_t* kvr = WSP(bf16_t, WS_KVR); const float* cs = WSP(float, WS_CS);
    bf16_t* QM = WSP(bf16_t, WS_QM); bf16_t* KM = WSP(bf16_t, WS_KM); bf16_t* VTM = WSP(bf16_t, WS_VTM);
    bf16_t* QS = WSP(bf16_t, WS_QS); bf16_t* KS = WSP(bf16_t, WS_KS); bf16_t* VTS = WSP(bf16_t, WS_VTS);
    const float sc_m = 0.10206207261596575f * LOG2E;
    const float sc_s = 0.125f * LOG2E;
    const int c16 = lane & 15, h16 = lane >> 4, c8 = lane & 7, h8 = lane >> 3;
    const bool v12 = c16 < 12, rotm = (c16 >= 8) && v12;
    P8 gqm = ldp8(p.g_qn_mla + 8 * (v12 ? c16 : 0)), gqs = ldp8(p.g_qn_swa + 8 * c8);
    const P8 gkm = ldp8(p.g_kn_mla + 8 * (v12 ? c16 : 0)), gks = ldp8(p.g_kn_swa + 8 * c8);
#pragma unroll
    for (int j = 0; j < 4; ++j) { gqm.p[j] *= (f32x2_t){sc_m, sc_m}; gqs.p[j] *= (f32x2_t){sc_s, sc_s}; }
    const unsigned sgm = (c16 >= 10) ? 0u : 0x80000000u, sgs = (c8 >= 4) ? 0u : 0x80000000u;
    for (int tile = wg; tile < M_ / 64; tile += nwg) {
        __syncthreads();
        struct Raw { u32x4_t zq, zkv, qa, qb, ka, kb, vm, qs, ksv; f32x4_t cm0, cm1, sm0, sm1, cw0, cw1, sw0, sw1; };
        auto load_raw = [&](int m) { Raw r; const bf16_t* zr = z + (size_t)m * NZ; const bf16_t* qr = qmr + (size_t)m * 768; const bf16_t* kr = kvr + (size_t)m * 1024;
            r.zq = *(const u32x4_t*)(zr + ZQ + 8 * (lane < 48 ? lane : 0)); r.zkv = *(const u32x4_t*)(zr + ZCKV + 8 * (lane & 31));
            r.qa = *(const u32x4_t*)(qr + h16 * 96 + 8 * (c16 < 12 ? c16 : 0)); r.qb = *(const u32x4_t*)(qr + (4 + h16) * 96 + 8 * (c16 < 12 ? c16 : 0));
            r.ka = (c16 < 8) ? *(const u32x4_t*)(kr + h16 * 128 + 8 * c16) : *(const u32x4_t*)(zr + ZKR + 8 * (c16 & 3));
            r.kb = (c16 < 8) ? *(const u32x4_t*)(kr + (4 + h16) * 128 + 8 * c16) : *(const u32x4_t*)(zr + ZKR + 8 * (c16 & 3));
            r.vm = *(const u32x4_t*)(kr + h8 * 128 + 64 + 8 * c8); r.qs = *(const u32x4_t*)(zr + ZQS + 8 * lane); r.ksv = *(const u32x4_t*)(zr + ZKS + 8 * (lane & 31));
            const float* csr = cs + (size_t)m * 96; const float* cm = csr + 8 * (c16 & 1); const float* cw = csr + 32 + 8 * (c8 & 3);
            r.cm0 = *(const f32x4_t*)cm; r.cm1 = *(const f32x4_t*)(cm + 4); r.sm0 = *(const f32x4_t*)(cm + 16); r.sm1 = *(const f32x4_t*)(cm + 20);
            r.cw0 = *(const f32x4_t*)cw; r.cw1 = *(const f32x4_t*)(cw + 4); r.sw0 = *(const f32x4_t*)(cw + 32); r.sw1 = *(const f32x4_t*)(cw + 36);
            return r; };
        Raw nx = load_raw(tile * 64 + wave * 8);
        for (int tt = 0; tt < 8; ++tt) {
            const int tl = wave * 8 + tt, m = tile * 64 + tl, b = m / S_, s = m % S_;
            const int tls = tl ^ (8 * ((lane >> 1) & 7));
            const Raw cu = nx;
            if (tt < 7) nx = load_raw(m + 1);
            const P8 zq = cvp8(cu.zq), zkv = cvp8(cu.zkv); P8 qa = cvp8(cu.qa), qb = cvp8(cu.qb), ka = cvp8(cu.ka), kb = cvp8(cu.kb), vm = cvp8(cu.vm), qs = cvp8(cu.qs), ks = cvp8(cu.ksv);
            const float rq = __builtin_amdgcn_rsqf(wave_sum_dpp(lane < 48 ? ssqp(zq) : 0.f) * (1.f / 384.f) + EPS);
            const float rkv = __builtin_amdgcn_rsqf(wave_sum_dpp(lane < 32 ? ssqp(zkv) : 0.f) * (1.f / 256.f) + EPS);
            P8 cM = f4p8(cu.cm0, cu.cm1), sM = f4p8(cu.sm0, cu.sm1), cW = f4p8(cu.cw0, cu.cw1), sW = f4p8(cu.sw0, cu.sw1);
#pragma unroll
            for (int j = 0; j < 4; ++j) {
                cM.p[j].x = rotm ? cM.p[j].x : 1.f; cM.p[j].y = rotm ? cM.p[j].y : 1.f;
                sM.p[j].x = rotm ? __uint_as_float(__float_as_uint(sM.p[j].x) ^ sgm) : 0.f; sM.p[j].y = rotm ? __uint_as_float(__float_as_uint(sM.p[j].y) ^ sgm) : 0.f;
                sW.p[j].x = __uint_as_float(__float_as_uint(sW.p[j].x) ^ sgs); sW.p[j].y = __uint_as_float(__float_as_uint(sW.p[j].y) ^ sgs); }
            const float kpre = (c16 < 8) ? rkv : 1.f;
            norm_rope<16, 2>(qa, v12, rq, 1.f / 96.f, gqm, cM, sM);
            norm_rope<16, 2>(qb, v12, rq, 1.f / 96.f, gqm, cM, sM);
            norm_rope<16, 2>(ka, v12, kpre, 1.f / 96.f, gkm, cM, sM);
            norm_rope<16, 2>(kb, v12, kpre, 1.f / 96.f, gkm, cM, sM);
            if (v12) { stp8(QM + ((size_t)(b * 8 + h16) * S_ + s) * 96 + 8 * c16, qa); stp8(QM + ((size_t)(b * 8 + 4 + h16) * S_ + s) * 96 + 8 * c16, qb);
                       stp8(KM + ((size_t)(b * 8 + h16) * S_ + s) * 96 + 8 * c16, ka); stp8(KM + ((size_t)(b * 8 + 4 + h16) * S_ + s) * 96 + 8 * c16, kb); }
            { const f32x2_t rv = {rkv, rkv};
#pragma unroll
              for (int j = 0; j < 4; ++j) { const f32x2_t t = vm.p[j] * rv; const unsigned w = cvtpk_(t.x, t.y);
                  lds[(h8 * 64 + 8 * c8 + 2 * j) * VT_PITCH + tls] = (bf16_t)(w & 0xffffu); lds[(h8 * 64 + 8 * c8 + 2 * j + 1) * VT_PITCH + tls] = (bf16_t)(w >> 16); } }
            norm_rope<8, 4>(qs, true, 1.f, 1.f / 64.f, gqs, cW, sW);
            stp8(QS + ((size_t)(b * 8 + h8) * S_ + s) * 64 + 8 * c8, qs);
            norm_rope<8, 4>(ks, lane < 16, 1.f, 1.f / 64.f, gks, cW, sW);
            if (lane < 16) stp8(KS + ((size_t)(b * 2 + h8) * S_ + s) * 64 + 8 * c8, ks);
            else if (lane < 32) { const unsigned wv[4] = {cu.ksv.x, cu.ksv.y, cu.ksv.z, cu.ksv.w};
#pragma unroll
                for (int j = 0; j < 4; ++j) { lds[(512 + (h8 - 2) * 64 + 8 * c8 + 2 * j) * VT_PITCH + tls] = (bf16_t)(wv[j] & 0xffffu); lds[(512 + (h8 - 2) * 64 + 8 * c8 + 2 * j + 1) * VT_PITCH + tls] = (bf16_t)(wv[j] >> 16); } }
        }
        __syncthreads();
        const int b = (tile * 64) / S_, s0 = (tile * 64) % S_;
        int ln = lane; asm volatile("" : "+v"(ln));
        for (int r0 = wave * 8; r0 < 640; r0 += 64) { const int r = r0 + (ln >> 3), t8 = (ln & 7) * 8;
            const u32x4_t v = *(const u32x4_t*)(lds + r * VT_PITCH + (t8 ^ (8 * ((r >> 4) & 7))));
            if (r < 512) *(u32x4_t*)(VTM + ((size_t)(b * 8 + (r >> 6)) * 64 + (r & 63)) * S_ + s0 + t8) = v;
            else { const int rr = r - 512; *(u32x4_t*)(VTS + ((size_t)(b * 2 + (rr >> 6)) * 64 + (rr & 63)) * S_ + s0 + t8) = v; } }
    }
}

#define LAS __attribute__((address_space(3)))
#define XB_TMO      128
#define XB_XCNT(j)  (256  + 64 * (j))
#define XB_XSUB(j)  (1280 + 64 * (j))
#define XB_XGEN(j)  (2304 + 64 * (j))
#define XB_TOP      3328
#define XB_TOPGEN   3392
#define XCD_BAR_WORDS 3456
#define XB_SPIN_CAP (1u << 18)
__device__ __forceinline__ unsigned xb_ld(unsigned* p)              { return __hip_atomic_load(p, __ATOMIC_RELAXED, __HIP_MEMORY_SCOPE_AGENT); }
__device__ __forceinline__ unsigned xb_add(unsigned* p, unsigned v) { return __hip_atomic_fetch_add(p, v, __ATOMIC_RELAXED, __HIP_MEMORY_SCOPE_AGENT); }
__device__ __forceinline__ unsigned xb_xcc_id() { return (unsigned)__builtin_amdgcn_s_getreg((3 << 11) | 20) & 0xFu; }
#define XB_SPIN(cond, bar) do { unsigned _sp = 0; while (cond) { __builtin_amdgcn_s_sleep(1); \
    if ((++_sp & 255u) == 0u) { if (xb_ld(&(bar)[XB_TMO])) break; if (_sp > XB_SPIN_CAP) { atomicAdd(&(bar)[XB_TMO], 1u); break; } } } } while (0)
struct XcdBarrier { unsigned* bar; unsigned x; volatile LAS unsigned* st; int wv; };
__device__ __forceinline__ XcdBarrier xcd_barrier_post(unsigned* bar, volatile LAS unsigned* st, int wv) {
    XcdBarrier b; b.bar = bar; b.x = xb_xcc_id(); b.st = st; b.wv = wv;
    if (tid_of(wv) == 0) (void)xb_add(&bar[XB_XCNT(b.x)], 1u);
    return b;
}
__device__ __forceinline__ void xcd_barrier_complete(unsigned* bar, unsigned x, unsigned& nloc, unsigned& nx) {
    const unsigned G = gridDim.x * gridDim.y * gridDim.z;
    unsigned sum, cnt, mine, sp = 0u;
    for (;;) {
        sum = 0u; cnt = 0u; mine = 0u;
#pragma unroll
        for (unsigned j = 0; j < 16; ++j) { const unsigned c = xb_ld(&bar[XB_XCNT(j)]); sum += c; cnt += (c > 0u) ? 1u : 0u; mine = (j == x) ? c : mine; }
        if (sum == G) break;
        __builtin_amdgcn_s_sleep(1);
        if ((++sp & 255u) == 0u) { if (xb_ld(&bar[XB_TMO])) break; if (sp > XB_SPIN_CAP) { atomicAdd(&bar[XB_TMO], 1u); break; } }
    }
    nloc = mine > 0u ? mine : 1u; nx = cnt > 0u ? cnt : 1u;
}
__device__ __forceinline__ void xcd_barrier(const XcdBarrier& b) {
    asm volatile("s_waitcnt vmcnt(0)" ::: "memory");
    __syncthreads();
    if (tid_of(b.wv) == 0) {
        unsigned* bar = b.bar;
        __builtin_amdgcn_s_waitcnt(0);
        unsigned nloc = b.st[0], nx = b.st[1];
        if (nloc == 0u) { xcd_barrier_complete(bar, b.x, nloc, nx); b.st[0] = nloc; b.st[1] = nx; }
        const unsigned old = xb_add(&bar[XB_XSUB(b.x)], 1u);
        const unsigned gen = old / nloc;
        if (old + 1u == (gen + 1u) * nloc) {
            __builtin_amdgcn_fence(__ATOMIC_RELEASE, "agent");
            asm volatile("s_waitcnt vmcnt(0)" ::: "memory");
            const unsigned og = xb_add(&bar[XB_TOP], 1u);
            const unsigned tg = og / nx;
            if (og + 1u == (tg + 1u) * nx) xb_add(&bar[XB_TOPGEN], 1u);
            else XB_SPIN(xb_ld(&bar[XB_TOPGEN]) == tg, bar);
            __builtin_amdgcn_fence(__ATOMIC_ACQUIRE, "agent");
            xb_add(&bar[XB_XGEN(b.x)], 1u);
            asm volatile("s_waitcnt vmcnt(0)" ::: "memory");
        } else {
            XB_SPIN(xb_ld(&bar[XB_XGEN(b.x)]) == gen, bar);
            __builtin_amdgcn_fence(__ATOMIC_ACQUIRE, "agent");
            asm volatile("s_waitcnt vmcnt(0)" ::: "memory");
        }
    }
    __syncthreads();
}
constexpr int CW_BAR = 4096;

namespace pg8 {
typedef short bf16x8 __attribute__((ext_vector_type(8)));
typedef float f32x4 __attribute__((ext_vector_type(4)));
typedef unsigned u32x4 __attribute__((ext_vector_type(4)));
typedef unsigned u32x2 __attribute__((ext_vector_type(2)));
constexpr int GTBL_OFF = 128 * 1024;
constexpr int BM = 256, BK = 64, HALF = 128, HTB = HALF * BK * 2, STAGE_BYTES = 8 * HTB, NXCD = 8, WGM = 8;
__host__ __device__ __forceinline__ int lds_byte(int r, int c) { const int st = (r >> 4) * 2 + (c >> 5), rr = r & 15, cc = c & 31, ob = rr * 64 + cc * 2; return st * 1024 + (ob ^ (((ob >> 9) & 1) << 5)); }
__host__ __device__ __forceinline__ void stage_rc(int b, int& R, int& C) { const int st = b / 1024, sb = b % 1024, swz = sb ^ (((sb >> 9) & 1) << 5); R = (st >> 1) * 16 + swz / 64; C = (st & 1) * 32 + (swz % 64) / 2; }
__host__ __device__ __forceinline__ int perm32(int rho) { const int n = rho >> 4, i = rho & 15; return 8 * (i >> 2) + 4 * n + (i & 3); }
__device__ __forceinline__ unsigned cvt_pk_bf16(float lo, float hi) { unsigned r; asm volatile("v_cvt_pk_bf16_f32 %0, %1, %2" : "=v"(r) : "v"(lo), "v"(hi)); return r; }

struct Unit { int pm, pn; const char* Ab; const char* Bb; int aux; };

struct DenseSched {
    const char* A; const char* Bt; size_t astep, bstep;
    int nM, nN, nwg, G, c;
    __device__ __forceinline__ void init(const void* A_, int lda, const void* Bt_, int ldb, int M, int N, int G_, int c_) {
        A = (const char*)A_; Bt = (const char*)Bt_; astep = (size_t)BM * lda * 2; bstep = (size_t)BM * ldb * 2; nM = M / BM; nN = N / BM; nwg = nM * nN; G = G_; c = c_; }
    __device__ __forceinline__ bool next(int i, Unit& u) const {
        const int L = i * G + c; if (L >= nwg) return false;
        int wgid = L; { const int q = nwg / NXCD, r = nwg % NXCD, xcd = wgid % NXCD, off = wgid / NXCD; wgid = (xcd < r ? xcd * (q + 1) : r * (q + 1) + (xcd - r) * q) + off; }
        const int nig = WGM * nN, gid = wgid / nig, fm = gid * WGM, gsz = (nM - fm) < WGM ? (nM - fm) : WGM;
        u.pm = fm + ((wgid % nig) % gsz); u.pn = (wgid % nig) / gsz; u.Ab = A + (size_t)u.pm * astep; u.Bb = Bt + (size_t)u.pn * bstep; u.aux = 0; return true;
    }
    __device__ __forceinline__ int row(const Unit&, int) const { return 0; }
    __device__ __forceinline__ const int* rowtab(const Unit&) const { return nullptr; }
};

typedef int i32x4 __attribute__((ext_vector_type(4)));
typedef int i32x8 __attribute__((ext_vector_type(8)));
template <class Epi, class Sched, bool GATHER, bool F8 = false>
__device__ __forceinline__ void gemm_phase(LAS unsigned char* lds, const int wv, const int K, const int lda, const int ldb, const Sched& S, const Epi& E) {
    int tid = tid_of(wv); asm volatile("" : "+v"(tid));
    const int wid = __builtin_amdgcn_readfirstlane(tid >> 6), lane = tid & 63, wr = wid >> 2, wc = wid & 3, fr = lane & 15, fq = lane >> 4;
    int nt = K / BK; if constexpr (F8) asm volatile("" : "+s"(nt));
    unsigned voffB[2];
#pragma unroll
    for (int i = 0; i < 2; ++i) { int R, C; stage_rc(tid * 16 + i * 8192, R, C);
        const int Rb = Epi::PERM2 ? (64 * (R >> 5) + 16 * ((R & 15) >> 2) + 4 * ((R >> 4) & 1) + (R & 3)) : Epi::PERM ? ((R & ~31) + perm32(R & 31)) : R;
        voffB[i] = (unsigned)(Rb * ldb + C) * 2u; }
    const size_t kstep = (size_t)(BK * 2);
    const size_t hstepB = Epi::PERM2 ? (size_t)8 * ldb * 2 : (size_t)HALF * ldb * 2;
    const size_t hstepA = GATHER ? 0 : (size_t)HALF * lda * 2;
    const unsigned ldsw = (unsigned)wid * 1024u;
    const int aoff = lds_byte(wr * 64 + fr, fq * 8), boff = lds_byte(wc * 32 + fr, fq * 8);
#define PG8_SA(b, h) (((b) * 2 + (h)) * HTB)
#define PG8_SB(b, h) ((4 + (b) * 2 + (h)) * HTB)
#define PG8_STAGE(bufoff, gbase, v0, v1) do { const char* gb_ = (const char*)(gbase); asm volatile("" : "+s"(gb_));     \
        __builtin_amdgcn_global_load_lds((const unsigned*)(gb_ + (v0)), (LAS unsigned*)(lds + (bufoff) + ldsw), 16, 0, 0); \
        __builtin_amdgcn_global_load_lds((const unsigned*)(gb_ + (v1)), (LAS unsigned*)(lds + (bufoff) + ldsw + 8192), 16, 0, 0); } while (0)
#define PG8_STAGEB(bufoff, gbase) PG8_STAGE(bufoff, gbase, voffB[0], voffB[1])
#define PG8_LDA(dst, b, h) do { _Pragma("unroll") for (int m = 0; m < 4; ++m) _Pragma("unroll") for (int k = 0; k < 2; ++k) dst[m][k] = *(const LAS bf16x8*)(lds + PG8_SA(b, h) + aoff + m * 2048 + k * 1024); } while (0)
#define PG8_LDB(dst, b, h) do { _Pragma("unroll") for (int n = 0; n < 2; ++n) _Pragma("unroll") for (int k = 0; k < 2; ++k) dst[n][k] = *(const LAS bf16x8*)(lds + PG8_SB(b, h) + boff + n * 2048 + k * 1024); } while (0)
#define PG8_CAT(x) __builtin_shufflevector(__builtin_bit_cast(i32x4, (x)[0]), __builtin_bit_cast(i32x4, (x)[1]), 0, 1, 2, 3, 4, 5, 6, 7)
#define PG8_MMA(ai, bj, At, Bt) do { __builtin_amdgcn_s_setprio(1); \
        if constexpr (F8) { _Pragma("unroll") for (int m = 0; m < 4; ++m) _Pragma("unroll") for (int n = 0; n < 2; ++n) \
            acc[ai][bj][m][n] = __builtin_amdgcn_mfma_scale_f32_16x16x128_f8f6f4(PG8_CAT(Bt[n]), PG8_CAT(At[m]), acc[ai][bj][m][n], 0, 0, 0, 0, 0, 0); } \
        else { _Pragma("unroll") for (int m = 0; m < 4; ++m) _Pragma("unroll") for (int n = 0; n < 2; ++n) _Pragma("unroll") for (int k = 0; k < 2; ++k) \
            acc[ai][bj][m][n] = __builtin_amdgcn_mfma_f32_16x16x32_bf16(Bt[n][k], At[m][k], acc[ai][bj][m][n], 0, 0, 0); } \
        __builtin_amdgcn_s_setprio(0); } while (0)
#define PG8_WAIT_V(n) asm volatile("s_waitcnt vmcnt(" #n ")" ::: "memory")
#define PG8_WAIT_L(n) asm volatile("s_waitcnt lgkmcnt(" #n ")" ::: "memory")
#define PG8_BAR __builtin_amdgcn_s_barrier()
#define PG8_SCHED __builtin_amdgcn_sched_barrier(0)
    unsigned vc00, vc01, gtb = 0, gcb = 0;
    { int t_ = tid; asm volatile("" : "+v"(t_)); int R0_, C0_, R1_, C1_; stage_rc(t_ * 16, R0_, C0_); stage_rc(t_ * 16 + 8192, R1_, C1_);
      vc00 = (unsigned)(R0_ * lda + C0_) * 2u; vc01 = (unsigned)(R1_ * lda + C1_) * 2u; gtb = (unsigned)R0_ * 4u; gcb = (unsigned)C0_ * 2u; }
    const unsigned rowb = (unsigned)lda * 2u;
#define PG8_STAGEA(bufoff, gbase, half, tpar) do { if constexpr (GATHER) { \
        const LAS int* tp_ = (const LAS int*)(lds + GTBL_OFF + (tpar) * 1024 + (half) * 512 + gtb); const unsigned ra_ = (unsigned)tp_[0], rb_ = (unsigned)tp_[64]; \
        PG8_STAGE(bufoff, gbase, ra_ * rowb + gcb, rb_ * rowb + gcb); } else PG8_STAGE(bufoff, gbase, vc00, vc01); } while (0)
#define PG8_TBLDMA(U, tpar) do { const char* tb_ = (const char*)(S.rowtab(U) + (wid & 3) * 64); asm volatile("" : "+s"(tb_)); \
        __builtin_amdgcn_global_load_lds((const unsigned*)(tb_ + (unsigned)(tid_of(wv) & 63) * 4u), (LAS unsigned*)(lds + GTBL_OFF + (tpar) * 1024 + (wid & 3) * 256), 4, 0, 0); } while (0)
    Unit cur, nxt; int ui = 0;
    if (!S.next(0, cur)) return;
    if constexpr (GATHER) { PG8_TBLDMA(cur, 0); asm volatile("s_waitcnt vmcnt(0)" ::: "memory"); __builtin_amdgcn_s_barrier(); }
    f32x4 acc[2][2][4][2];
#pragma unroll
    for (int a = 0; a < 2; ++a)
#pragma unroll
        for (int b = 0; b < 2; ++b)
#pragma unroll
            for (int m = 0; m < 4; ++m)
#pragma unroll
                for (int n = 0; n < 2; ++n) acc[a][b][m][n] = (f32x4){0.f, 0.f, 0.f, 0.f};
    bf16x8 At[4][2], B0[2][2], B1[2][2];
    const char* cA = cur.Ab; const char* cB = cur.Bb;
    PG8_STAGEB(PG8_SB(0, 0), cB); PG8_STAGEB(PG8_SB(0, 1), cB + hstepB); PG8_STAGEA(PG8_SA(0, 0), cA, 0, 0); PG8_STAGEA(PG8_SA(0, 1), cA + hstepA, 1, 0);
    if (wr == 1) PG8_BAR;
    PG8_WAIT_V(2); PG8_BAR;
    PG8_STAGEB(PG8_SB(1, 0), cB + kstep); PG8_STAGEA(PG8_SA(1, 0), cA + kstep, 0, 0); PG8_STAGEB(PG8_SB(1, 1), cB + hstepB + kstep);
    PG8_WAIT_V(6); PG8_BAR;
    for (;;) {
        const bool has_next = S.next(ui + 1, nxt);
        const char* nA = has_next ? nxt.Ab : cA; const char* nB = has_next ? nxt.Bb : cB;
        const int cpar = ui & 1, npar = has_next ? (cpar ^ 1) : cpar;
        if constexpr (GATHER) { if (has_next) PG8_TBLDMA(nxt, npar); }
        for (int t = 0; t < nt; t += 2) {
            const bool last = (t == nt - 2);
            const char* a1 = cA + (size_t)(t + 1) * kstep;
            const char* a2 = last ? nA : cA + (size_t)(t + 2) * kstep; const char* b2 = last ? nB : cB + (size_t)(t + 2) * kstep;
            const char* a3 = a2 + kstep; const char* b3 = b2 + kstep;
            const int wpar = last ? npar : cpar;
            PG8_LDB(B0, 0, 0); PG8_LDB(B1, 0, 1); PG8_SCHED; PG8_LDA(At, 0, 0); PG8_STAGEA(PG8_SA(1, 1), a1 + hstepA, 1, cpar);
            PG8_WAIT_V(8); PG8_WAIT_L(0); PG8_BAR; PG8_MMA(0, 0, At, B0); PG8_MMA(0, 1, At, B1); PG8_BAR; PG8_SCHED;
            PG8_LDA(At, 0, 1); PG8_STAGEB(PG8_SB(0, 0), b2); PG8_STAGEB(PG8_SB(0, 1), b2 + hstepB); PG8_STAGEA(PG8_SA(0, 0), a2, 0, wpar);
            PG8_WAIT_V(8); PG8_WAIT_L(0); PG8_BAR; PG8_MMA(1, 0, At, B0); PG8_MMA(1, 1, At, B1); PG8_BAR; PG8_SCHED;
            PG8_LDB(B0, 1, 0); PG8_LDB(B1, 1, 1); PG8_SCHED; PG8_LDA(At, 1, 0); PG8_STAGEA(PG8_SA(0, 1), a2 + hstepA, 1, wpar);
            PG8_WAIT_V(8); PG8_WAIT_L(0); PG8_BAR; PG8_MMA(0, 0, At, B0); PG8_MMA(0, 1, At, B1); PG8_BAR; PG8_SCHED;
            PG8_LDA(At, 1, 1); PG8_STAGEB(PG8_SB(1, 0), b3); PG8_STAGEB(PG8_SB(1, 1), b3 + hstepB); PG8_STAGEA(PG8_SA(1, 0), a3, 0, wpar);
            PG8_WAIT_V(8); PG8_WAIT_L(0); PG8_BAR; PG8_MMA(1, 0, At, B0); PG8_MMA(1, 1, At, B1); PG8_BAR; PG8_SCHED;
        }
        if (wr == 0) PG8_BAR;
        { const int le = tid_of(wv) & 63; E(acc, cur, wr, wc, le & 15, le >> 4); }
        if (!has_next) break;
#pragma unroll
        for (int a = 0; a < 2; ++a)
#pragma unroll
            for (int b = 0; b < 2; ++b)
#pragma unroll
                for (int m = 0; m < 4; ++m)
#pragma unroll
                    for (int n = 0; n < 2; ++n) acc[a][b][m][n] = (f32x4){0.f, 0.f, 0.f, 0.f};
        cur = nxt; cA = nA; cB = nB; ++ui;
        if (wr == 1) PG8_BAR;
    }
    PG8_WAIT_V(0);
    PG8_BAR;
#undef PG8_SA
#undef PG8_SB
#undef PG8_STAGE
#undef PG8_STAGEB
#undef PG8_LDA
#undef PG8_LDB
#undef PG8_MMA
#undef PG8_CAT
#undef PG8_WAIT_V
#undef PG8_WAIT_L
#undef PG8_BAR
#undef PG8_SCHED
#undef PG8_STAGEA
#undef PG8_TBLDMA
}

constexpr float HID_SC = 16.f, WDN_SC = 64.f, XN_SC = 8.f, WGU_SC = 128.f;
enum { EP_Z = 0, EP_BF16 = 1, EP_MG1 = 2, EP_MG2 = 3, EP_RES = 4, EP_HID = 5, EP_DOWN = 6, EP_PLE = 7 };
__device__ __forceinline__ float bfl(unsigned w) { return __uint_as_float(w << 16); }
__device__ __forceinline__ float bfh(unsigned w) { return __uint_as_float(w & 0xffff0000u); }
__device__ __forceinline__ float sigm(float v) { return __builtin_amdgcn_rcpf(1.f + __expf(-v)); }
template <int MODE> struct Epi {
    static constexpr bool PERM = !(MODE == EP_RES || MODE == EP_PLE), PERM2 = (MODE == EP_DOWN);
    bf16_t* O; int ldc;
    const bf16_t* aux; int ldaux;
    const float* fin; float* fout; const float* fin2; bf16_t* O2;
    __device__ __forceinline__ void operator()(const f32x4 (&acc)[2][2][4][2], const Unit& u, int wr, int wc, int fr, int fq) const {
        const int row0 = u.pm * BM + wr * 64 + fr;
        if constexpr (MODE == EP_RES) {
            const int col0 = u.pn * BM + wc * 32 + 4 * fq;
            f32x4 xc[4], xn[4];
#pragma unroll
            for (int q = 0; q < 4; ++q) xc[q] = *(const f32x4*)(fin + (size_t)row0 * D_ + col0 + (q >> 1) * HALF + (q & 1) * 16);
#pragma unroll
            for (int g = 0; g < 8; ++g) { const size_t r = (size_t)(row0 + (g >> 2) * HALF + (g & 3) * 16);
                if (g < 7) { const size_t r1 = (size_t)(row0 + ((g + 1) >> 2) * HALF + ((g + 1) & 3) * 16);
#pragma unroll
                    for (int q = 0; q < 4; ++q) xn[q] = *(const f32x4*)(fin + r1 * D_ + col0 + (q >> 1) * HALF + (q & 1) * 16); }
                asm volatile("" ::: "memory");
#pragma unroll
                for (int q = 0; q < 4; ++q) { const f32x4 o = xc[q] + acc[g >> 2][q >> 1][g & 3][q & 1]; *(f32x4*)(fout + r * D_ + col0 + (q >> 1) * HALF + (q & 1) * 16) = o; }
                asm volatile("" ::: "memory");
#pragma unroll
                for (int q = 0; q < 4; ++q) xc[q] = xn[q]; }
        } else if constexpr (MODE == EP_PLE) {
            const int col0 = u.pn * BM + wc * 32 + 4 * fq;
            constexpr float qs = 1.f / (XN_SC * WGU_SC);
            f32x4 bv[4]; u32x2 pc[4], hc[4], pn_[4], hn[4]; float ic, in_ = 0.f;
#pragma unroll
            for (int q = 0; q < 4; ++q) { const int c = col0 + (q >> 1) * HALF + (q & 1) * 16; bv[q] = *(const f32x4*)(fin + c);
                pc[q] = *(const u32x2*)(aux + (size_t)row0 * ldaux + c); hc[q] = *(const u32x2*)(O + (size_t)row0 * D_ + c); }
            ic = fin2[row0];
#pragma unroll
            for (int g = 0; g < 8; ++g) { const size_t r = (size_t)(row0 + (g >> 2) * HALF + (g & 3) * 16);
                if (g < 7) { const size_t r1 = (size_t)(row0 + ((g + 1) >> 2) * HALF + ((g + 1) & 3) * 16);
#pragma unroll
                    for (int q = 0; q < 4; ++q) { const int c = col0 + (q >> 1) * HALF + (q & 1) * 16; pn_[q] = *(const u32x2*)(aux + r1 * ldaux + c); hn[q] = *(const u32x2*)(O + r1 * D_ + c); }
                    in_ = fin2[r1]; }
                asm volatile("" ::: "memory");
#pragma unroll
                for (int q = 0; q < 4; ++q) { const int c = col0 + (q >> 1) * HALF + (q & 1) * 16; const f32x4 a = acc[g >> 2][q >> 1][g & 3][q & 1]; const u32x2 pw = pc[q], hw = hc[q]; f32x4 o;
                    o[0] = bfl(hw.x) * ic + sigm(a[0] * qs + bv[q][0]) * bfl(pw.x); o[1] = bfh(hw.x) * ic + sigm(a[1] * qs + bv[q][1]) * bfh(pw.x);
                    o[2] = bfl(hw.y) * ic + sigm(a[2] * qs + bv[q][2]) * bfl(pw.y); o[3] = bfh(hw.y) * ic + sigm(a[3] * qs + bv[q][3]) * bfh(pw.y);
                    *(f32x4*)(fout + r * D_ + c) = o; }
                asm volatile("" ::: "memory");
#pragma unroll
                for (int q = 0; q < 4; ++q) { pc[q] = pn_[q]; hc[q] = hn[q]; }
                ic = in_; }
        } else if constexpr (MODE == EP_DOWN) {
            unsigned char* Y8 = (unsigned char*)O; const int col0 = u.pn * BM + wc * 64 + 16 * fq;
#pragma unroll
            for (int ai = 0; ai < 2; ++ai)
#pragma unroll
                for (int m = 0; m < 4; ++m) { const size_t r = (size_t)(row0 + ai * HALF + m * 16); u32x4 w;
#pragma unroll
                    for (int bj = 0; bj < 2; ++bj)
#pragma unroll
                        for (int n = 0; n < 2; ++n) { const f32x4 a = acc[ai][bj][m][n] * (16.f / (HID_SC * WDN_SC)); int d = 0;
                            d = __builtin_amdgcn_cvt_pk_fp8_f32(a[0], a[1], d, false); d = __builtin_amdgcn_cvt_pk_fp8_f32(a[2], a[3], d, true); w[2 * bj + n] = (unsigned)d; }
                    *(u32x4*)(Y8 + r * 1024 + col0) = w; }
        } else if constexpr (MODE == EP_HID) {
            const int col0 = u.pn * HALF + wc * 32 + 8 * fq;
#pragma unroll
            for (int ai = 0; ai < 2; ++ai)
#pragma unroll
                for (int m = 0; m < 4; ++m) { const size_t r = (size_t)(row0 + ai * HALF + m * 16); const float w = fin[r]; constexpr float rs = 1.f / (XN_SC * WGU_SC);
                    const f32x4 g0 = acc[ai][0][m][0] * rs, g1 = acc[ai][0][m][1] * rs, u0 = acc[ai][1][m][0] * rs, u1 = acc[ai][1][m][1] * rs;
                    float h[8];
#pragma unroll
                    for (int j = 0; j < 4; ++j) { h[j] = g0[j] * sigm(g0[j]) * u0[j] * w; h[4 + j] = g1[j] * sigm(g1[j]) * u1[j] * w; }
#pragma unroll
                    for (int j = 0; j < 8; ++j) h[j] = __builtin_amdgcn_fmed3f(h[j] * HID_SC, -448.f, 448.f);
                    int d0 = 0, d1 = 0;
                    d0 = __builtin_amdgcn_cvt_pk_fp8_f32(h[0], h[1], d0, false); d0 = __builtin_amdgcn_cvt_pk_fp8_f32(h[2], h[3], d0, true);
                    d1 = __builtin_amdgcn_cvt_pk_fp8_f32(h[4], h[5], d1, false); d1 = __builtin_amdgcn_cvt_pk_fp8_f32(h[6], h[7], d1, true);
                    *(u32x2*)((unsigned char*)O + r * ldc + col0) = (u32x2){(unsigned)d0, (unsigned)d1}; }
        } else if constexpr (MODE == EP_MG1 || MODE == EP_MG2) {
            const int col0 = u.pn * BM + wc * 32 + 8 * fq;
            u32x4 gc[2], gn[2], oc[2], on[2];
#pragma unroll
            for (int bj = 0; bj < 2; ++bj) { gc[bj] = *(const u32x4*)(aux + (size_t)row0 * ldaux + col0 + bj * HALF); if constexpr (MODE == EP_MG2) oc[bj] = *(const u32x4*)(O + (size_t)row0 * ldc + col0 + bj * HALF); }
#pragma unroll
            for (int g = 0; g < 8; ++g) { const size_t r = (size_t)(row0 + (g >> 2) * HALF + (g & 3) * 16);
                if (g < 7) { const size_t r1 = (size_t)(row0 + ((g + 1) >> 2) * HALF + ((g + 1) & 3) * 16);
#pragma unroll
                    for (int bj = 0; bj < 2; ++bj) { gn[bj] = *(const u32x4*)(aux + r1 * ldaux + col0 + bj * HALF); if constexpr (MODE == EP_MG2) on[bj] = *(const u32x4*)(O + r1 * ldc + col0 + bj * HALF); } }
                asm volatile("" ::: "memory");
#pragma unroll
                for (int bj = 0; bj < 2; ++bj) { const int c = col0 + bj * HALF; f32x4 v0 = acc[g >> 2][bj][g & 3][0], v1 = acc[g >> 2][bj][g & 3][1]; const u32x4 gw = gc[bj];
                    v0[0] *= bfl(gw.x); v0[1] *= bfh(gw.x); v0[2] *= bfl(gw.y); v0[3] *= bfh(gw.y); v1[0] *= bfl(gw.z); v1[1] *= bfh(gw.z); v1[2] *= bfl(gw.w); v1[3] *= bfh(gw.w);
                    if constexpr (MODE == EP_MG2) { const u32x4 ow = oc[bj];
                        v0[0] += bfl(ow.x); v0[1] += bfh(ow.x); v0[2] += bfl(ow.y); v0[3] += bfh(ow.y); v1[0] += bfl(ow.z); v1[1] += bfh(ow.z); v1[2] += bfl(ow.w); v1[3] += bfh(ow.w); }
                    u32x4 w; w.x = cvt_pk_bf16(v0[0], v0[1]); w.y = cvt_pk_bf16(v0[2], v0[3]); w.z = cvt_pk_bf16(v1[0], v1[1]); w.w = cvt_pk_bf16(v1[2], v1[3]);
                    *(u32x4*)(O + r * ldc + c) = w; }
                asm volatile("" ::: "memory");
#pragma unroll
                for (int bj = 0; bj < 2; ++bj) { gc[bj] = gn[bj]; if constexpr (MODE == EP_MG2) oc[bj] = on[bj]; } }
        } else {
            const int col0 = u.pn * BM + wc * 32 + 8 * fq;
            const bool act = (MODE == EP_Z) && (u.pn >= ZGA / BM);
#pragma unroll
            for (int ai = 0; ai < 2; ++ai)
#pragma unroll
                for (int m = 0; m < 4; ++m) { const size_t r = (size_t)(row0 + ai * HALF + m * 16);
#pragma unroll
                    for (int bj = 0; bj < 2; ++bj) { const int c = col0 + bj * HALF; f32x4 v0 = acc[ai][bj][m][0], v1 = acc[ai][bj][m][1];
                        if constexpr (MODE == EP_Z) { if (act) { const f32x4 b0 = *(const f32x4*)(fin + c - ZGA), b1 = *(const f32x4*)(fin + c - ZGA + 4);
#pragma unroll
                            for (int j = 0; j < 4; ++j) { v0[j] = sigm(v0[j] + b0[j]); v1[j] = sigm(v1[j] + b1[j]); } } }
                        if constexpr (MODE == EP_MG1 || MODE == EP_MG2) { const u32x4 gw = *(const u32x4*)(aux + r * ldaux + c);
                            v0[0] *= bfl(gw.x); v0[1] *= bfh(gw.x); v0[2] *= bfl(gw.y); v0[3] *= bfh(gw.y); v1[0] *= bfl(gw.z); v1[1] *= bfh(gw.z); v1[2] *= bfl(gw.w); v1[3] *= bfh(gw.w); }
                        if constexpr (MODE == EP_MG2) { const u32x4 ow = *(const u32x4*)(O + r * ldc + c);
                            v0[0] += bfl(ow.x); v0[1] += bfh(ow.x); v0[2] += bfl(ow.y); v0[3] += bfh(ow.y); v1[0] += bfl(ow.z); v1[1] += bfh(ow.z); v1[2] += bfl(ow.w); v1[3] += bfh(ow.w); }
                        { u32x4 w; w.x = cvt_pk_bf16(v0[0], v0[1]); w.y = cvt_pk_bf16(v0[2], v0[3]); w.z = cvt_pk_bf16(v1[0], v1[1]); w.w = cvt_pk_bf16(v1[2], v1[3]);
                            *(u32x4*)(O + r * ldc + c) = w; } }
                    if constexpr (MODE == EP_MG1 || MODE == EP_MG2) asm volatile("" ::: "memory"); }
        }
    }
};
}

__device__ __forceinline__ unsigned pk2(float lo, float hi) { return (unsigned)f2bf(lo) | ((unsigned)f2bf(hi) << 16); }
__device__ __forceinline__ int zdst(int c) {
    if (c < 384) return c;
    if (c < 640) return ZCKV + (c - 384);
    if (c < 672) return ZKR + (c - 640);
    if (c < 1184) return ZQS + (c - 672);
    if (c < 1312) return ZKS + (c - 1184);
    if (c < 1440) return ZVS + (c - 1312);
    if (c < 2464) return ZGA + (c - 1440);
    return ZGB + (c - 2464);
}
__device__ __forceinline__ int gudst(int j) { const int half = j >> 8, jj = j & 255; return ((jj >> 7) << 8) + (half << 7) + (jj & 127); }
struct ConvJob { const float* src; const float* gp; bf16_t* dst; int K, N; float sc; };
template <int K, int N, int MAP>
__device__ __forceinline__ ConvJob conv_mk(const float* W, const float* g, bf16_t* WT, int item) {
    constexpr int nblk = N / 32; const int kb = item / nblk, nb = item % nblk, k0 = 64 * kb, n0 = 32 * nb;
    const int d0 = (MAP == 1) ? zdst(n0) : (MAP == 2) ? gudst(n0) : n0;
    return ConvJob{W + (size_t)k0 * N + n0, g ? g + k0 : nullptr, WT + (size_t)d0 * K + k0, K, N, 0.f};
}
template <int K, int N, int MAP>
__device__ __forceinline__ ConvJob conv_mk8(const float* W, const float* g, unsigned char* WT, int item, float sc) {
    constexpr int nblk = N / 32; const int kb = item / nblk, nb = item % nblk, k0 = 64 * kb, n0 = 32 * nb;
    const int d0 = (MAP == 2) ? gudst(n0) : n0;
    return ConvJob{W + (size_t)k0 * N + n0, g ? g + k0 : nullptr, (bf16_t*)(WT + (size_t)d0 * K + k0), K, N, sc};
}
__device__ __forceinline__ void conv_load(const ConvJob& j, int lane, f32x4_t (&v)[8]) {
    const int kq = lane >> 3, n4 = (lane & 7) * 4; const float* sp = j.src + (size_t)kq * j.N + n4;
#pragma unroll
    for (int i = 0; i < 8; ++i) v[i] = *(const f32x4_t*)(sp + (size_t)(8 * i) * j.N);
}
__device__ __forceinline__ void conv_finish(const ConvJob& j, int lane, const f32x4_t (&v)[8], LAS float* scr) {
    const int kq = lane >> 3, n4 = (lane & 7) * 4;
    const bool f8 = j.sc > 0.f; const float scl = f8 ? j.sc : 1.f;
#pragma unroll
    for (int i = 0; i < 8; ++i) { const int kk = kq + 8 * i; const float gg = (j.gp ? j.gp[kk] : 1.f) * scl; LAS float* d = scr + kk * 33 + n4;
        d[0] = v[i].x * gg; d[1] = v[i].y * gg; d[2] = v[i].z * gg; d[3] = v[i].w * gg; }
    asm volatile("s_waitcnt lgkmcnt(0)" ::: "memory");
    const int c = lane & 7;
    if (f8) {
#pragma unroll
        for (int q = 0; q < 4; ++q) { const int n = (lane >> 3) + 8 * q; const LAS float* sp = scr + (8 * c) * 33 + n; float t[8];
#pragma unroll
            for (int i = 0; i < 8; ++i) t[i] = __builtin_amdgcn_fmed3f(sp[i * 33], -448.f, 448.f);
            int d0 = 0, d1 = 0;
            d0 = __builtin_amdgcn_cvt_pk_fp8_f32(t[0], t[1], d0, false); d0 = __builtin_amdgcn_cvt_pk_fp8_f32(t[2], t[3], d0, true);
            d1 = __builtin_amdgcn_cvt_pk_fp8_f32(t[4], t[5], d1, false); d1 = __builtin_amdgcn_cvt_pk_fp8_f32(t[6], t[7], d1, true);
            *(pg8::u32x2*)((unsigned char*)j.dst + (size_t)n * j.K + 8 * c) = (pg8::u32x2){(unsigned)d0, (unsigned)d1}; }
    } else {
#pragma unroll
        for (int q = 0; q < 4; ++q) { const int n = (lane >> 3) + 8 * q; const LAS float* sp = scr + (8 * c) * 33 + n;
            pg8::u32x4 o; o.x = pk2(sp[0 * 33], sp[1 * 33]); o.y = pk2(sp[2 * 33], sp[3 * 33]); o.z = pk2(sp[4 * 33], sp[5 * 33]); o.w = pk2(sp[6 * 33], sp[7 * 33]);
            *(pg8::u32x4*)(j.dst + (size_t)n * j.K + 8 * c) = o; }
    }
    asm volatile("s_waitcnt lgkmcnt(0)" ::: "memory");
}
__device__ __forceinline__ ConvJob conv_job(const P& p, int it) {
    constexpr int I0 = 16 * 109, I1 = 6 * 24, I2 = 4 * 32, I3 = 8 * 32, I4 = 8 * 32, I5 = 16 * 32, I6 = 16 * 32, I7 = 4 * 32, I8 = 16 * 16, I9 = 4 * 32, IGU = 16 * 16, IDN = 4 * 32;
    int r = it;
    if (r < I0) return conv_mk<1024, INW, 1>(p.w_in, p.g_mix, WSP(bf16_t, WS_WIN), r); r -= I0;
    if (r < I1) return conv_mk<384, 768, 0>(p.w_uq, p.g_cq, WSP(bf16_t, WS_WUQ), r); r -= I1;
    if (r < I2) return conv_mk<256, 1024, 0>(p.w_ukv, p.g_ckv, WSP(bf16_t, WS_WUKV), r); r -= I2;
    if (r < I7) return conv_mk<256, 1024, 0>(p.w_ple_proj, nullptr, WSP(bf16_t, WS_WPP), r); r -= I7;
    if (r < I3) return conv_mk<512, 1024, 0>(p.w_br_mla, nullptr, WSP(bf16_t, WS_WBRM), r); r -= I3;
    if (r < I4) return conv_mk<512, 1024, 0>(p.w_br_swa, nullptr, WSP(bf16_t, WS_WBRS), r); r -= I4;
    if (r < I5) return conv_mk<1024, 1024, 0>(p.w_out, nullptr, WSP(bf16_t, WS_WOUT), r); r -= I5;
    if (r < I6) return conv_mk8<1024, 1024, 0>(p.w_ple_gate, p.g_ple, WSP(unsigned char, WS_WPG), r, pg8::WGU_SC); r -= I6;
    if (r < I8) return conv_mk8<1024, 512, 2>(p.w_sh_gu, p.g_moe, WSP(unsigned char, WS_WGU) + (size_t)NE * 512 * 1024, r, pg8::WGU_SC); r -= I8;
    if (r < I9) return conv_mk8<256, 1024, 0>(p.w_sh_down, nullptr, WSP(unsigned char, WS_WDN) + (size_t)NE * 1024 * 256, r, pg8::WDN_SC); r -= I9;
    if (r < 64 * IGU) { const int e = r / IGU; return conv_mk8<1024, 512, 2>(p.w_exp_gu + (size_t)e * 1024 * 512, p.g_moe, WSP(unsigned char, WS_WGU) + (size_t)e * 512 * 1024, r % IGU, pg8::WGU_SC); } r -= 64 * IGU;
    { const int e = r / IDN; return conv_mk8<256, 1024, 0>(p.w_exp_down + (size_t)e * 256 * 1024, nullptr, WSP(unsigned char, WS_WDN) + (size_t)e * 1024 * 256, r % IDN, pg8::WDN_SC); }
}
constexpr int CONV_EARLY = 16 * 109 + 6 * 24 + 4 * 32 + 4 * 32;
constexpr int CONV_NITEMS = 16 * 109 + 6 * 24 + 4 * 32 + 8 * 32 + 8 * 32 + 16 * 32 + 16 * 32 + 4 * 32 + 16 * 16 + 4 * 32 + 64 * 256 + 64 * 128;
__device__ __forceinline__ void st_wconv(const P& p, int gw, int ngw, int lane, LAS float* scr) {
    constexpr int NITEMS = CONV_EARLY;
    if (gw < NITEMS) {
        ConvJob cur = conv_job(p, gw); f32x4_t v[8], w[8]; conv_load(cur, lane, v);
        for (int it = gw; it < NITEMS; it += ngw) {
            const bool more = it + ngw < NITEMS; ConvJob nx = cur;
            if (more) { nx = conv_job(p, it + ngw); conv_load(nx, lane, w); }
            conv_finish(cur, lane, v, scr);
            if (more) { cur = nx;
#pragma unroll
                for (int i = 0; i < 8; ++i) v[i] = w[i]; }
        }
    }
    { unsigned* zp = (unsigned*)(WSP(bf16_t, WS_WIN) + (size_t)416 * 1024); const int n = 96 * 1024 / 2;
      for (int i = gw * 64 + lane; i < n; i += ngw * 64) zp[i] = 0u; }
}
__device__ __forceinline__ void fs_g1(const P& p, LAS unsigned char* lds, const int wv) {
    pg8::DenseSched S; S.init(WSP(bf16_t, WS_HB), D_, WSP(bf16_t, WS_WIN), D_, M_, NZ, gridDim.x, blockIdx.x);
    pg8::Epi<pg8::EP_Z> E{WSP(bf16_t, WS_Z), NZ, nullptr, 0, p.b_gate, nullptr};
    pg8::gemm_phase<pg8::Epi<pg8::EP_Z>, pg8::DenseSched, false>(lds, wv, D_, D_, D_, S, E);
}

struct MoeSched {
    const char* A; const char* Bt; size_t astep, bstep, estep; const LAS int* tile_e; const int* ltok; int T, NPN, nwg, G, c; bool gather;
    __device__ __forceinline__ void init(const void* A_, int lda, const void* Bt_, int ldb, int ncols_e, const LAS int* tile_e_, const int* ltok_, int T_, bool gather_, int G_, int c_) {
        A = (const char*)A_; Bt = (const char*)Bt_; astep = (size_t)256 * lda * 2; bstep = (size_t)256 * ldb * 2; estep = (size_t)ncols_e * ldb * 2; tile_e = tile_e_; ltok = ltok_;
        T = T_; NPN = ncols_e / 256; nwg = (T + M_ / 256) * NPN; G = G_; c = c_; gather = gather_; }
    __device__ __forceinline__ bool next(int i, pg8::Unit& u) const {
        const int L = i * G + c; if (L >= nwg) return false;
        int wgid = L; { const int q = nwg / 8, r = nwg % 8, xcd = wgid % 8, off = wgid / 8; wgid = (xcd < r ? xcd * (q + 1) : r * (q + 1) + (xcd - r) * q) + off; }
        const int j = wgid / NPN; u.pn = wgid % NPN;
        int e; if (j < T) { u.pm = j; e = __builtin_amdgcn_readfirstlane(tile_e[j]); } else { u.pm = NSLOT / 256 + (j - T); e = NE; }
        u.Ab = gather ? A : A + (size_t)u.pm * astep; u.Bb = Bt + (size_t)e * estep + (size_t)u.pn * bstep; u.aux = e; return true;
    }
    __device__ __forceinline__ int row(const pg8::Unit& u, int r) const { return ltok[u.pm * 256 + r]; }
    __device__ __forceinline__ const int* rowtab(const pg8::Unit& u) const { return ltok + u.pm * 256; }
};
constexpr size_t WS_TILEE = 5 * MiB;
constexpr int NT = 512;
constexpr int TILEE_LDS = 136 * 1024;
__device__ __forceinline__ void fs_g23(const P& p, LAS unsigned char* lds, const int wv) {
    { pg8::DenseSched S; S.init(WSP(bf16_t, WS_Z) + ZQ, NZ, WSP(bf16_t, WS_WUQ), 384, M_, 768, gridDim.x, blockIdx.x);
      pg8::Epi<pg8::EP_BF16> E{WSP(bf16_t, WS_QMR), 768, nullptr, 0, nullptr, nullptr};
      pg8::gemm_phase<pg8::Epi<pg8::EP_BF16>, pg8::DenseSched, false>(lds, wv, 384, NZ, 384, S, E); }
    { pg8::DenseSched S; S.init(WSP(bf16_t, WS_Z) + ZCKV, NZ, WSP(bf16_t, WS_WUKV), 256, M_, 1024, gridDim.x, blockIdx.x);
      pg8::Epi<pg8::EP_BF16> E{WSP(bf16_t, WS_KVR), 1024, nullptr, 0, nullptr, nullptr};
      pg8::gemm_phase<pg8::Epi<pg8::EP_BF16>, pg8::DenseSched, false>(lds, wv, 256, NZ, 256, S, E); }
}
__device__ __forceinline__ void fs_merge(const P& p, LAS unsigned char* lds, const int wv) {
    { pg8::DenseSched S; S.init(WSP(bf16_t, WS_OM), 512, WSP(bf16_t, WS_WBRM), 512, M_, D_, gridDim.x, blockIdx.x);
      pg8::Epi<pg8::EP_MG1> E{WSP(bf16_t, WS_MG), D_, WSP(bf16_t, WS_Z) + ZGA, NZ, nullptr, nullptr};
      pg8::gemm_phase<pg8::Epi<pg8::EP_MG1>, pg8::DenseSched, false>(lds, wv, 512, 512, 512, S, E); }
    { pg8::DenseSched S; S.init(WSP(bf16_t, WS_OW), 512, WSP(bf16_t, WS_WBRS), 512, M_, D_, gridDim.x, blockIdx.x);
      pg8::Epi<pg8::EP_MG2> E{WSP(bf16_t, WS_MG), D_, WSP(bf16_t, WS_Z) + ZGB, NZ, nullptr, nullptr};
      pg8::gemm_phase<pg8::Epi<pg8::EP_MG2>, pg8::DenseSched, false>(lds, wv, 512, 512, 512, S, E); }
}
__device__ __forceinline__ void fs_out(const P& p, LAS unsigned char* lds, const int wv) {
    pg8::DenseSched S; S.init(WSP(bf16_t, WS_MG), D_, WSP(bf16_t, WS_WOUT), D_, M_, D_, gridDim.x, blockIdx.x);
    pg8::Epi<pg8::EP_RES> E{nullptr, 0, nullptr, 0, p.x, p.out, nullptr, nullptr};
    pg8::gemm_phase<pg8::Epi<pg8::EP_RES>, pg8::DenseSched, false>(lds, wv, D_, D_, D_, S, E);
}
__device__ __forceinline__ void fs_gu(const P& p, LAS unsigned char* lds, const int wv) {
    const int T = __builtin_amdgcn_readfirstlane((int)(WSP(unsigned, WS_CTL)[CW_BASE + NE] / 256u));
    LAS int* te = (LAS int*)(lds + TILEE_LDS);
    for (int i = tid_of(wv); i < NSLOT / 256; i += NT) te[i] = WSP(int, WS_TILEE)[i];
    __syncthreads();
    MoeSched S; S.init(WSP(bf16_t, WS_H2), D_ / 2, WSP(bf16_t, WS_WGU), D_ / 2, 512, te, WSP(int, WS_LTOK), T, true, gridDim.x, blockIdx.x);
    pg8::Epi<pg8::EP_HID> E{WSP(bf16_t, WS_HID), EFF, nullptr, 0, WSP(float, WS_LW), nullptr, WSP(float, WS_LR), nullptr};
    pg8::gemm_phase<pg8::Epi<pg8::EP_HID>, MoeSched, true, true>(lds, wv, D_ / 2, D_ / 2, D_ / 2, S, E);
}
__device__ __forceinline__ void fs_down(const P& p, LAS unsigned char* lds, const int wv) {
    const int T = __builtin_amdgcn_readfirstlane((int)(WSP(unsigned, WS_CTL)[CW_BASE + NE] / 256u));
    LAS int* te = (LAS int*)(lds + TILEE_LDS);
    for (int i = tid_of(wv); i < NSLOT / 256; i += NT) te[i] = WSP(int, WS_TILEE)[i];
    __syncthreads();
    MoeSched S; S.init(WSP(bf16_t, WS_HID), EFF / 2, WSP(bf16_t, WS_WDN), EFF / 2, 1024, te, WSP(int, WS_LTOK), T, false, gridDim.x, blockIdx.x);
    pg8::Epi<pg8::EP_DOWN> E{WSP(bf16_t, WS_Y), D_, nullptr, 0, nullptr, p.out};
    pg8::gemm_phase<pg8::Epi<pg8::EP_DOWN>, MoeSched, false, true>(lds, wv, EFF / 2, EFF / 2, EFF / 2, S, E);
}
__device__ __forceinline__ void fs_pp(const P& p, LAS unsigned char* lds, const int wv) {
    const int G = (int)gridDim.x, half = G / 2, c = (int)blockIdx.x - half;
    if (c < 0) return;
    pg8::DenseSched S; S.init(WSP(bf16_t, WS_PB), 256, WSP(bf16_t, WS_WPP), 256, M_, D_, G - half, c);
    pg8::Epi<pg8::EP_BF16> E{WSP(bf16_t, WS_PP), D_, nullptr, 0, nullptr, nullptr};
    pg8::gemm_phase<pg8::Epi<pg8::EP_BF16>, pg8::DenseSched, false>(lds, wv, 256, 256, 256, S, E);
}
__device__ __forceinline__ void fs_ple(const P& p, LAS unsigned char* lds, const int wv) {
    pg8::DenseSched S; S.init(WSP(bf16_t, WS_H3F8), D_ / 2, WSP(bf16_t, WS_WPG), D_ / 2, M_, D_, gridDim.x, blockIdx.x);
    pg8::Epi<pg8::EP_PLE> E{WSP(bf16_t, WS_H3), D_, WSP(bf16_t, WS_PP), D_, p.b_ple, p.out, WSP(float, WS_INV3), nullptr};
    pg8::gemm_phase<pg8::Epi<pg8::EP_PLE>, pg8::DenseSched, false, true>(lds, wv, D_ / 2, D_ / 2, D_ / 2, S, E);
}
namespace fa {
typedef short bf16x8 __attribute__((ext_vector_type(8)));
typedef short s16x4 __attribute__((ext_vector_type(4)));
typedef float f32x16 __attribute__((ext_vector_type(16)));
typedef unsigned u32x4 __attribute__((ext_vector_type(4)));
typedef unsigned u32x2 __attribute__((ext_vector_type(2)));
__device__ __forceinline__ unsigned cvtpk(float lo, float hi) { unsigned r; asm volatile("v_cvt_pk_bf16_f32 %0, %1, %2" : "=v"(r) : "v"(lo), "v"(hi)); return r; }
__device__ __forceinline__ int crow(int r, int hi) { return (r & 3) + 8 * (r >> 2) + 4 * hi; }

struct BgConv { int item, step, ngw; bool loaded; ConvJob job; f32x4_t v[8]; };
__device__ __forceinline__ void conv_finish_(const ConvJob& j, int lane, const f32x4_t (&v)[8], LAS float* scr) { conv_finish(j, lane, v, scr); }
__device__ __forceinline__ void bg_tick(const P& p, BgConv& g, int lane, LAS float* scr) {
    if (g.loaded) { conv_finish(g.job, lane, g.v, scr); g.loaded = false; g.item += g.ngw; }
    else if (g.item < CONV_NITEMS && (g.step & 3) == 0) { g.job = conv_job(p, g.item); conv_load(g.job, lane, g.v); g.loaded = true; }
    ++g.step;
}
template <int DK, bool SWA>
__device__ __forceinline__ void attn_unit(const P& p, LAS unsigned char* lds, const int wv, const int b, const int h, const int qb, const float gmax, BgConv& bg) {
    constexpr int PK = DK * 2 + 16, PV = 136, KBYTES = 64 * PK, BUF = KBYTES + 64 * PV, KS = DK / 16, CPR = DK / 8;
    int tid = tid_of(wv); asm volatile("" : "+v"(tid));
    const int lane = tid & 63, wave = wv, r32 = lane & 31, hi = lane >> 5;
    const int q0w = qb * 256 + wave * 32;
    const bf16_t* Qg = (SWA ? WSP(bf16_t, WS_QS) : WSP(bf16_t, WS_QM)) + ((size_t)(b * 8 + h) * S_ + q0w + r32) * DK;
    const int kvh = SWA ? (b * 2 + h / 4) : (b * 8 + h);
    const bf16_t* Kg = (SWA ? WSP(bf16_t, WS_KS) : WSP(bf16_t, WS_KM)) + (size_t)kvh * S_ * DK;
    const bf16_t* Vg = (SWA ? WSP(bf16_t, WS_VTS) : WSP(bf16_t, WS_VTM)) + (size_t)kvh * 64 * S_;
    bf16x8 qf[KS];
#pragma unroll
    for (int s = 0; s < KS; ++s) qf[s] = *(const bf16x8*)(Qg + 16 * s + 8 * hi);
    int t0 = 0, t1 = S_ / 64;
    if (SWA) { const int kmin = max(0, qb * 256 - 128), kmax = min(S_ - 1, qb * 256 + 255 + 128); t0 = kmin / 64; t1 = kmax / 64 + 1; }
    const int wk0 = q0w - 128, wk1 = q0w + 31 + 128;
    const int qpos = q0w + r32;
    const int kc0 = tid, kc1 = 512 + tid;
    const bool k1on = (64 * CPR > 512) && (tid < 64 * CPR - 512);
    const unsigned kd0 = (unsigned)((kc0 / CPR) * PK + (kc0 % CPR) * 16), kd1 = (unsigned)((kc1 / CPR) * PK + (kc1 % CPR) * 16);
    const int vd = tid >> 3, vp = tid & 7;
    const unsigned vdst = (unsigned)(KBYTES + vd * PV + vp * 16);
    u32x4 ak0, ak1 = {0u, 0u, 0u, 0u}, av, bk0, bk1 = {0u, 0u, 0u, 0u}, bv;
#define FA_LOAD(K0, K1, V, t) do { const int k0_ = (t) * 64; K0 = *(const u32x4*)(Kg + (size_t)k0_ * DK + kc0 * 8); if (k1on) K1 = *(const u32x4*)(Kg + (size_t)k0_ * DK + kc1 * 8); \
        V = *(const u32x4*)(Vg + (size_t)vd * S_ + k0_ + vp * 8); } while (0)
#define FA_WRITE(K0, K1, V, bufo) do { *(LAS u32x4*)(lds + (bufo) + kd0) = K0; if (k1on) *(LAS u32x4*)(lds + (bufo) + kd1) = K1; \
        *(LAS u32x2*)(lds + (bufo) + vdst) = (u32x2){V.x, V.y}; *(LAS u32x2*)(lds + (bufo) + vdst + 8) = (u32x2){V.z, V.w}; } while (0)
    float l_run; f32x16 o0, o1; bf16x8 qx;
#pragma unroll
    for (int r = 0; r < 16; ++r) { o0[r] = 0.f; o1[r] = 0.f; }
    { float q2 = 0.f;
#pragma unroll
      for (int s = 0; s < KS; ++s)
#pragma unroll
          for (int j = 0; j < 8; ++j) { const float x = __uint_as_float((unsigned)(unsigned short)qf[s][j] << 16); q2 += x * x; }
      { auto ra = __builtin_amdgcn_permlane32_swap(__float_as_uint(q2), __float_as_uint(q2), false, false); q2 = __uint_as_float(ra[0]) + __uint_as_float(ra[1]); }
      float m = fminf(sqrtf(q2) * 1.01f * gmax * sqrtf((float)DK), 60.f);
      const float sk = SWA ? p.sink[h] * LOG2E : 0.f;
      if (SWA) m = fmaxf(m, fminf(sk, 60.f));
      const bf16_t hm = f2bf(-m);
      l_run = (SWA && hi == 0) ? exp2f(sk + bf2f(hm)) : 0.f;
      qx = (bf16x8){(short)(hi == 0 ? hm : 0), 0, 0, 0, 0, 0, 0, 0}; }
    if (tid < 64) { const u32x4 one = {0x00003F80u, 0u, 0u, 0u}; *(LAS u32x4*)(lds + tid * PK + DK * 2) = one; *(LAS u32x4*)(lds + BUF + tid * PK + DK * 2) = one; }
    FA_LOAD(ak0, ak1, av, t0); FA_WRITE(ak0, ak1, av, 0);
    if (t0 + 1 < t1) FA_LOAD(ak0, ak1, av, t0 + 1);
    __syncthreads();
    auto tile = [&](const int bufo, const int k0) __attribute__((always_inline)) {
        const bool active = !SWA || !(k0 + 63 < wk0 || k0 > wk1);
        if (active) {
            f32x16 s0, s1;
            { const bf16x8 ka = *(const LAS bf16x8*)(lds + bufo + r32 * PK + DK * 2 + 16 * hi);
              const bf16x8 kb = *(const LAS bf16x8*)(lds + bufo + (32 + r32) * PK + DK * 2 + 16 * hi);
              const f32x16 z = {0.f, 0.f, 0.f, 0.f, 0.f, 0.f, 0.f, 0.f, 0.f, 0.f, 0.f, 0.f, 0.f, 0.f, 0.f, 0.f};
              s0 = __builtin_amdgcn_mfma_f32_32x32x16_bf16(ka, qx, z, 0, 0, 0); s1 = __builtin_amdgcn_mfma_f32_32x32x16_bf16(kb, qx, z, 0, 0, 0); }
#pragma unroll
            for (int s = 0; s < KS; ++s) {
                const bf16x8 ka = *(const LAS bf16x8*)(lds + bufo + r32 * PK + 32 * s + 16 * hi);
                const bf16x8 kb = *(const LAS bf16x8*)(lds + bufo + (32 + r32) * PK + 32 * s + 16 * hi);
                s0 = __builtin_amdgcn_mfma_f32_32x32x16_bf16(ka, qf[s], s0, 0, 0, 0);
                s1 = __builtin_amdgcn_mfma_f32_32x32x16_bf16(kb, qf[s], s1, 0, 0, 0);
            }
            if (SWA && (k0 < q0w + 31 - 128 || k0 + 63 > q0w + 128)) {
#pragma unroll
                for (int r = 0; r < 16; ++r) { const int d0 = k0 + crow(r, hi) - qpos, d1 = d0 + 32;
                    if (d0 > 128 || d0 < -128) s0[r] = -1e30f; if (d1 > 128 || d1 < -128) s1[r] = -1e30f; }
            }
            s16x4 va0[4], va1[4], vc0[4], vc1[4];
#pragma unroll
            for (int i = 0; i < 4; ++i) { const unsigned vo = (unsigned)(bufo + KBYTES + r32 * PV + (32 * (i >> 1) + 16 * (i & 1) + 4 * hi) * 2);
                va0[i] = *(const LAS s16x4*)(lds + vo); va1[i] = *(const LAS s16x4*)(lds + vo + 16); vc0[i] = *(const LAS s16x4*)(lds + vo + 32 * PV); vc1[i] = *(const LAS s16x4*)(lds + vo + 32 * PV + 16); }
            __builtin_amdgcn_sched_barrier(0);
            float ls = 0.f;
#pragma unroll
            for (int r = 0; r < 16; ++r) { s0[r] = __builtin_amdgcn_exp2f(s0[r]); s1[r] = __builtin_amdgcn_exp2f(s1[r]); ls += s0[r] + s1[r]; }
            l_run += ls;
#pragma unroll
            for (int i = 0; i < 4; ++i) {
                u32x4 pw;
                if (i < 2) { pw.x = cvtpk(s0[8 * i + 0], s0[8 * i + 1]); pw.y = cvtpk(s0[8 * i + 2], s0[8 * i + 3]); pw.z = cvtpk(s0[8 * i + 4], s0[8 * i + 5]); pw.w = cvtpk(s0[8 * i + 6], s0[8 * i + 7]); }
                else { const int s2 = i - 2; pw.x = cvtpk(s1[8 * s2 + 0], s1[8 * s2 + 1]); pw.y = cvtpk(s1[8 * s2 + 2], s1[8 * s2 + 3]); pw.z = cvtpk(s1[8 * s2 + 4], s1[8 * s2 + 5]); pw.w = cvtpk(s1[8 * s2 + 6], s1[8 * s2 + 7]); }
                const bf16x8 pf = __builtin_bit_cast(bf16x8, pw);
                const bf16x8 va = (bf16x8){va0[i][0], va0[i][1], va0[i][2], va0[i][3], va1[i][0], va1[i][1], va1[i][2], va1[i][3]};
                const bf16x8 vc = (bf16x8){vc0[i][0], vc0[i][1], vc0[i][2], vc0[i][3], vc1[i][0], vc1[i][1], vc1[i][2], vc1[i][3]};
                o0 = __builtin_amdgcn_mfma_f32_32x32x16_bf16(va, pf, o0, 0, 0, 0);
                o1 = __builtin_amdgcn_mfma_f32_32x32x16_bf16(vc, pf, o1, 0, 0, 0);
            }
        }
    };
    LAS float* bgscr = (LAS float*)(lds + 2 * BUF + 1024) + wave * (64 * 33);
    for (int t = t0; t < t1; t += 2) {
        if (t + 2 < t1) FA_LOAD(bk0, bk1, bv, t + 2);
        tile(0, t * 64);
        if (t + 1 < t1) FA_WRITE(ak0, ak1, av, BUF);
        bg_tick(p, bg, lane, bgscr);
        __syncthreads();
        if (t + 1 < t1) {
            if (t + 3 < t1) FA_LOAD(ak0, ak1, av, t + 3);
            tile(BUF, (t + 1) * 64);
            if (t + 2 < t1) FA_WRITE(bk0, bk1, bv, 0);
            bg_tick(p, bg, lane, bgscr);
            __syncthreads();
        }
    }
#undef FA_LOAD
#undef FA_WRITE
    float lt; { auto rl = __builtin_amdgcn_permlane32_swap(__float_as_uint(l_run), __float_as_uint(l_run), false, false); lt = __uint_as_float(rl[0]) + __uint_as_float(rl[1]); } const float il = 1.f / lt;
    bf16_t* Og = (SWA ? WSP(bf16_t, WS_OW) : WSP(bf16_t, WS_OM)) + (size_t)(b * S_ + qpos) * 512 + h * 64;
#pragma unroll
    for (int g = 0; g < 4; ++g) {
        u32x2 w0, w1;
        w0.x = cvtpk(o0[4 * g + 0] * il, o0[4 * g + 1] * il); w0.y = cvtpk(o0[4 * g + 2] * il, o0[4 * g + 3] * il);
        w1.x = cvtpk(o1[4 * g + 0] * il, o1[4 * g + 1] * il); w1.y = cvtpk(o1[4 * g + 2] * il, o1[4 * g + 3] * il);
        *(u32x2*)(Og + 8 * g + 4 * hi) = w0; *(u32x2*)(Og + 32 + 8 * g + 4 * hi) = w1;
    }
}
}
__device__ __forceinline__ void fs_attn(const P& p, LAS unsigned char* lds, const int wv) {
    const int G = gridDim.x, bx = blockIdx.x; const int vcu = (G % 8 == 0) ? (bx % 8) * (G / 8) + bx / 8 : bx;
    float gm, gs;
    { const int l = tid_of(0); float a = (l < 96) ? fabsf(p.g_kn_mla[l]) : 0.f; if (l + 64 < 96) a = fmaxf(a, fabsf(p.g_kn_mla[l + 64])); float c = (l < 64) ? fabsf(p.g_kn_swa[l]) : 0.f;
      a = wave_max(a); c = wave_max(c); gm = __uint_as_float(__builtin_amdgcn_readfirstlane(__float_as_uint(a))); gs = __uint_as_float(__builtin_amdgcn_readfirstlane(__float_as_uint(c))); }
    fa::BgConv bg; bg.item = CONV_EARLY + bx * (NT / 64) + wv; bg.step = 0; bg.ngw = G * (NT / 64); bg.loaded = false;
    for (int U = vcu; U < 512; U += G) { const int bh = U >> 3, qb = U & 7; fa::attn_unit<96, false>(p, lds, wv, bh >> 3, bh & 7, qb, gm, bg); }
    for (int U = vcu; U < 512; U += G) { const int bh = U >> 3, qb = U & 7; fa::attn_unit<64, true>(p, lds, wv, bh >> 3, bh & 7, qb, gs, bg); }
    { const int lane = tid_of(0); LAS float* scr = (LAS float*)(lds + wv * 16384);
      if (bg.loaded) { fa::conv_finish_(bg.job, lane, bg.v, scr); bg.item += bg.ngw; }
      for (; bg.item < CONV_NITEMS; bg.item += bg.ngw) { bg.job = conv_job(p, bg.item); conv_load(bg.job, lane, bg.v); fa::conv_finish_(bg.job, lane, bg.v, scr); } }
}

__device__ __forceinline__ void st_wrconv(const P& p, size_t gt, size_t ngt) {
    bf16_t* wrh = WSP(bf16_t, WS_WRH); bf16_t* wrl = WSP(bf16_t, WS_WRL);
    for (size_t i = gt; i < (size_t)NE * D_; i += ngt) { const int e = (int)(i >> 10), k = (int)(i & 1023);
        const float v = p.g_moe[k] * p.w_router[(size_t)k * NE + e]; const bf16_t h = f2bf(v); wrh[i] = h; wrl[i] = f2bf(v - bf2f(h)); }
}
__device__ __forceinline__ void st_route(const P& p, int wg, int nwg, int wave, int lane, LAS unsigned char* lds, int cnt_off = 0) {
    typedef short bf16x8 __attribute__((ext_vector_type(8))); typedef float f32x16 __attribute__((ext_vector_type(16)));
    const int r32 = lane & 31, hi = lane >> 5;
    LAS float* part = (LAS float*)lds; LAS float* ssq = (LAS float*)(lds + 131072);
    const bf16_t* WRH = WSP(bf16_t, WS_WRH); const bf16_t* WRL = WSP(bf16_t, WS_WRL);
    int* tope = WSP(int, WS_TOPE); float* topw = WSP(float, WS_TOPW); int* topls = WSP(int, WS_TOPLS); float* rstd2 = WSP(float, WS_RSTD2);
    unsigned char* h2f8 = WSP(unsigned char, WS_H2);
    int* wcnt = WSP(int, WS_WCNT) + cnt_off; int* tcnt = WSP(int, WS_TCNT) + (cnt_off ? 16384 : 0);
    LAS int* cntl = (LAS int*)(lds + 131072 + 2048);
    for (int tile = wg; tile < M_ / 64; tile += nwg) {
        f32x16 acc[2][2];
#pragma unroll
        for (int a = 0; a < 2; ++a)
#pragma unroll
            for (int b = 0; b < 2; ++b)
#pragma unroll
                for (int r = 0; r < 16; ++r) acc[a][b][r] = 0.f;
        float sq[2] = {0.f, 0.f};
        const float* xb = p.out + (size_t)(tile * 64 + r32) * D_ + wave * 128 + 8 * hi;
        const bf16_t* whb = WRH + (size_t)r32 * D_ + wave * 128 + 8 * hi; const bf16_t* wlb = WRL + (size_t)r32 * D_ + wave * 128 + 8 * hi;
#pragma unroll 2
        for (int s = 0; s < 8; ++s) {
            bf16x8 xh[2], xl[2], wh[2], wl[2];
#pragma unroll
            for (int tb = 0; tb < 2; ++tb) {
                const float* xp = xb + (size_t)(32 * tb) * D_ + 16 * s; const f32x4_t a = *(const f32x4_t*)xp, b = *(const f32x4_t*)(xp + 4);
                sq[tb] += (a.x * a.x + a.y * a.y) + (a.z * a.z + a.w * a.w) + (b.x * b.x + b.y * b.y) + (b.z * b.z + b.w * b.w);
                u32x4_t h, l;
                h.x = cvtpk_(a.x, a.y); h.y = cvtpk_(a.z, a.w); h.z = cvtpk_(b.x, b.y); h.w = cvtpk_(b.z, b.w);
                l.x = cvtpk_(a.x - bflo(h.x), a.y - bfhi(h.x)); l.y = cvtpk_(a.z - bflo(h.y), a.w - bfhi(h.y));
                l.z = cvtpk_(b.x - bflo(h.z), b.y - bfhi(h.z)); l.w = cvtpk_(b.z - bflo(h.w), b.w - bfhi(h.w));
                xh[tb] = __builtin_bit_cast(bf16x8, h); xl[tb] = __builtin_bit_cast(bf16x8, l);
            }
#pragma unroll
            for (int eb = 0; eb < 2; ++eb) { wh[eb] = *(const bf16x8*)(whb + (size_t)(32 * eb) * D_ + 16 * s); wl[eb] = *(const bf16x8*)(wlb + (size_t)(32 * eb) * D_ + 16 * s); }
#pragma unroll
            for (int tb = 0; tb < 2; ++tb)
#pragma unroll
                for (int eb = 0; eb < 2; ++eb) {
                    acc[tb][eb] = __builtin_amdgcn_mfma_f32_32x32x16_bf16(xh[tb], wh[eb], acc[tb][eb], 0, 0, 0);
                    acc[tb][eb] = __builtin_amdgcn_mfma_f32_32x32x16_bf16(xh[tb], wl[eb], acc[tb][eb], 0, 0, 0);
                    acc[tb][eb] = __builtin_amdgcn_mfma_f32_32x32x16_bf16(xl[tb], wh[eb], acc[tb][eb], 0, 0, 0);
                }
        }
#pragma unroll
        for (int tb = 0; tb < 2; ++tb) {
#pragma unroll
            for (int eb = 0; eb < 2; ++eb)
#pragma unroll
                for (int r = 0; r < 16; ++r) part[(wave * 64 + 32 * tb + (r & 3) + 8 * (r >> 2) + 4 * hi) * 64 + 32 * eb + r32] = acc[tb][eb][r];
            const float st = sq[tb] + __shfl_xor(sq[tb], 32);
            if (hi == 0) ssq[wave * 64 + 32 * tb + r32] = st;
        }
        __syncthreads();
        int cw = 0;
        for (int tt = 0; tt < 8; ++tt) {
            const int tok = wave * 8 + tt, m = tile * 64 + tok;
            const float* xr = p.out + (size_t)m * D_ + lane * 16;
            const f32x4_t x0 = *(const f32x4_t*)xr, x1v = *(const f32x4_t*)(xr + 4), x2v = *(const f32x4_t*)(xr + 8), x3v = *(const f32x4_t*)(xr + 12);
            float lg = 0.f, ss = 0.f;
#pragma unroll
            for (int w = 0; w < 8; ++w) { lg += part[(w * 64 + tok) * 64 + lane]; ss += ssq[w * 64 + tok]; }
            const float rstd = 1.f / sqrtf(ss * (1.f / D_) + EPS);
            const float score = sigmoidf_(lg * rstd); const float sel = score + p.router_bias[lane];
            float m1 = sel;
            m1 = fmaxf(m1, __shfl_xor(m1, 1)); m1 = fmaxf(m1, __shfl_xor(m1, 2)); m1 = fmaxf(m1, __shfl_xor(m1, 4));
            const unsigned long long eqm = __ballot(sel == m1);
            const int g = lane >> 3; const unsigned gm = (unsigned)((eqm >> (g * 8)) & 0xffull);
            const int first = __ffs((int)gm) - 1;
            float v2 = ((lane & 7) == first) ? -3.0e38f : sel;
            v2 = fmaxf(v2, __shfl_xor(v2, 1)); v2 = fmaxf(v2, __shfl_xor(v2, 2)); v2 = fmaxf(v2, __shfl_xor(v2, 4));
            const float gs = m1 + v2;
            int grank = 0;
#pragma unroll
            for (int j = 0; j < 8; ++j) { const float o = __shfl(gs, j * 8); grank += (o > gs || (o == gs && j < g)) ? 1 : 0; }
            const float msel = (grank < 4) ? sel : -1e30f;
            int rank = 0;
#pragma unroll
            for (int j = 0; j < 64; ++j) { const float o = __uint_as_float((unsigned)__builtin_amdgcn_readlane((int)__float_as_uint(msel), j)); rank += (o > msel) ? 1 : 0; }
            { const bool ch = rank < TOPK; const int nch = __builtin_popcountll(__ballot(ch)); const float sr = wave_sum_dpp(ch ? (float)rank : 0.f);
              if (nch != TOPK || sr != 28.f) { rank = 0;
                  for (int j = 0; j < 64; ++j) { const float o = __uint_as_float((unsigned)__builtin_amdgcn_readlane((int)__float_as_uint(msel), j)); rank += (o > msel || (o == msel && j < lane)) ? 1 : 0; } } }
            const bool chosen = rank < TOPK;
            const float wsum = wave_sum(chosen ? score : 0.f);
            if (chosen) { tope[m * TOPK + rank] = lane; topw[m * TOPK + rank] = score / wsum * 2.5f; topls[m * TOPK + rank] = cw; ++cw; }
            if (lane == 0) rstd2[m] = rstd;
            { const float q = rstd * pg8::XN_SC; u32x4_t w; int d;
              d = 0; d = __builtin_amdgcn_cvt_pk_fp8_f32(x0.x * q, x0.y * q, d, false); d = __builtin_amdgcn_cvt_pk_fp8_f32(x0.z * q, x0.w * q, d, true); w.x = (unsigned)d;
              d = 0; d = __builtin_amdgcn_cvt_pk_fp8_f32(x1v.x * q, x1v.y * q, d, false); d = __builtin_amdgcn_cvt_pk_fp8_f32(x1v.z * q, x1v.w * q, d, true); w.y = (unsigned)d;
              d = 0; d = __builtin_amdgcn_cvt_pk_fp8_f32(x2v.x * q, x2v.y * q, d, false); d = __builtin_amdgcn_cvt_pk_fp8_f32(x2v.z * q, x2v.w * q, d, true); w.z = (unsigned)d;
              d = 0; d = __builtin_amdgcn_cvt_pk_fp8_f32(x3v.x * q, x3v.y * q, d, false); d = __builtin_amdgcn_cvt_pk_fp8_f32(x3v.z * q, x3v.w * q, d, true); w.w = (unsigned)d;
              *(u32x4_t*)(h2f8 + (size_t)m * D_ + lane * 16) = w; }
        }
        wcnt[(tile * 8 + wave) * NE + lane] = cw; cntl[wave * 64 + lane] = cw;
        __syncthreads();
        if (wave == 0) { int t = 0;
#pragma unroll
            for (int w = 0; w < 8; ++w) t += cntl[w * 64 + lane];
            tcnt[tile * NE + lane] = t; }
    }
}
__device__ __forceinline__ void st_lists(const P& p, size_t gt, size_t ngt, int tid, int wg, int nwg, LAS unsigned* L) {
    const int* wcnt = WSP(int, WS_WCNT); const int* tcnt = WSP(int, WS_TCNT); unsigned* basew = WSP(unsigned, WS_CTL) + CW_BASE;
    const int* tope = WSP(int, WS_TOPE); const float* topw = WSP(float, WS_TOPW); const int* topls = WSP(int, WS_TOPLS); const float* rstd2 = WSP(float, WS_RSTD2);
    int* pos = WSP(int, WS_POS); int* ltok = WSP(int, WS_LTOK); float* lw = WSP(float, WS_LW); float* lr = WSP(float, WS_LR); int* tile_e = WSP(int, 5 * MiB);
    const int w8 = tid >> 6, e = tid & 63;
    for (int tile = wg; tile < M_ / 64; tile += nwg) {
        __syncthreads();
        { int tot = 0, pre = 0;
#pragma unroll
          for (int i = w8; i < 256; i += 8) { const int v = tcnt[i * NE + e]; tot += v; pre += (i < tile) ? v : 0; }
          L[tid] = (unsigned)tot; L[512 + tid] = (unsigned)pre; }
        __syncthreads();
        if (tid < 64) { unsigned tot = 0, pre = 0;
#pragma unroll
            for (int w = 0; w < 8; ++w) { tot += L[w * 64 + tid]; pre += L[512 + w * 64 + tid]; }
            const unsigned pc = (tot + 255u) & ~255u; unsigned v = pc;
#pragma unroll
            for (int o = 1; o < 64; o <<= 1) { const unsigned t = __shfl_up(v, o); if (tid >= o) v += t; }
            L[1024 + tid] = v - pc; L[1088 + tid] = tot; if (tid == 63) L[1152] = v;
            unsigned run = v - pc + pre;
#pragma unroll
            for (int w = 0; w < 8; ++w) { L[1216 + w * 64 + tid] = run; run += (unsigned)wcnt[(tile * 8 + w) * NE + tid]; } }
        __syncthreads();
        { const int i = tile * 512 + tid; const int ex = tope[i], tok = i >> 3, w = (tok & 63) >> 3;
          const int slot = (int)L[1216 + w * 64 + ex] + topls[i];
          pos[i] = slot; ltok[slot] = tok; lw[slot] = topw[i]; lr[slot] = rstd2[tok]; }
    }
    for (size_t i = gt; i < (size_t)NE * 256; i += ngt) {
        const int ex = (int)(i / 256), j = (int)(i % 256); const unsigned base = L[1024 + ex], n = L[1088 + ex], np = (n + 255u) & ~255u;
        if (n + j < np) { ltok[base + n + j] = 0; lw[base + n + j] = 0.f; lr[base + n + j] = 0.f; }
    }
    if (gt < 64) basew[gt] = L[1024 + gt];
    if (gt == 64) basew[NE] = L[1152];
    for (size_t i = gt; i < (size_t)(NSLOT / 256); i += ngt) { int ex = -1;
        for (int q = 0; q < NE; ++q) { const unsigned b0 = L[1024 + q], b1 = b0 + ((L[1088 + q] + 255u) & ~255u); if ((unsigned)i * 256u >= b0 && (unsigned)i * 256u < b1) ex = q; }
        tile_e[i] = ex; }
    for (size_t i = gt; i < (size_t)M_; i += ngt) { ltok[NSLOT + i] = (int)i; lw[NSLOT + i] = 1.f; lr[NSLOT + i] = rstd2[i]; }
}
__device__ __forceinline__ void st_combine(const P& p, int gw, int ngw, int lane, bool dry = false) {
    typedef float f32x2_t __attribute__((ext_vector_type(2)));
    const int* pos = WSP(int, WS_POS); const unsigned char* Y8 = WSP(unsigned char, WS_Y); bf16_t* h3 = WSP(bf16_t, WS_H3);
    for (int m = gw; m < M_; m += ngw) {
        f32x4_t* xr = (f32x4_t*)(p.out + (size_t)m * D_) + 4 * lane; f32x4_t v[4];
        int ps[TOPK];
#pragma unroll
        for (int k = 0; k < TOPK; ++k) ps[k] = __builtin_amdgcn_readfirstlane(pos[m * TOPK + k]);
#pragma unroll
        for (int j = 0; j < 4; ++j) v[j] = xr[j];
        u32x4_t y[TOPK + 1];
#pragma unroll
        for (int k = 0; k < TOPK + 1; ++k) y[k] = ((const u32x4_t*)(Y8 + (size_t)(k < TOPK ? ps[k] : NSLOT + m) * 1024))[lane];
        f32x4_t acc[4];
#pragma unroll
        for (int j = 0; j < 4; ++j) acc[j] = (f32x4_t){0.f, 0.f, 0.f, 0.f};
#pragma unroll
        for (int k = 0; k < TOPK + 1; ++k)
#pragma unroll
            for (int j = 0; j < 4; ++j) { const int w = (int)y[k][j]; const f32x2_t lo = __builtin_amdgcn_cvt_pk_f32_fp8(w, false), hi = __builtin_amdgcn_cvt_pk_f32_fp8(w, true);
                acc[j].x += lo.x; acc[j].y += lo.y; acc[j].z += hi.x; acc[j].w += hi.y; }
        float s = 0.f;
#pragma unroll
        for (int j = 0; j < 4; ++j) { v[j] = v[j] + acc[j] * (1.f / 16.f); s += (v[j].x * v[j].x + v[j].y * v[j].y) + (v[j].z * v[j].z + v[j].w * v[j].w); }
        s = wave_sum(s); const float rr = sqrtf(s * (1.f / D_) + EPS), r = 1.f / rr;
        if (lane == 0 && !dry) WSP(float, WS_INV3)[m] = rr;
        u32x4_t* o = (u32x4_t*)(h3 + (size_t)m * D_) + 2 * lane;
        o[0] = (u32x4_t){cvtpk_(v[0].x * r, v[0].y * r), cvtpk_(v[0].z * r, v[0].w * r), cvtpk_(v[1].x * r, v[1].y * r), cvtpk_(v[1].z * r, v[1].w * r)};
        o[1] = (u32x4_t){cvtpk_(v[2].x * r, v[2].y * r), cvtpk_(v[2].z * r, v[2].w * r), cvtpk_(v[3].x * r, v[3].y * r), cvtpk_(v[3].z * r, v[3].w * r)};
        { const float q = r * 8.f; u32x4_t w;
#pragma unroll
          for (int j = 0; j < 4; ++j) { int d = 0; d = __builtin_amdgcn_cvt_pk_fp8_f32(v[j].x * q, v[j].y * q, d, false); d = __builtin_amdgcn_cvt_pk_fp8_f32(v[j].z * q, v[j].w * q, d, true); w[j] = (unsigned)d; }
          ((u32x4_t*)(WSP(unsigned char, WS_H3F8) + (size_t)m * D_))[lane] = w; }
    }
}

#ifndef FAST_MASK
#define FAST_MASK 0xffff
#endif
constexpr int LDS_DYN = 144 * 1024;
constexpr int MISC_OFF = 132 * 1024;
constexpr int N_STAGES = 13;
__global__ void __launch_bounds__(NT) k_fwd(P p) {
    extern __shared__ __attribute__((aligned(16))) unsigned char lds[];
    const int wave_s = __builtin_amdgcn_readfirstlane((int)threadIdx.x >> 6);
    const int tid0 = tid_of(wave_s);
    volatile LAS unsigned* misc = (volatile LAS unsigned*)((LAS unsigned char*)lds + MISC_OFF);
    if (tid0 < 16) misc[tid0] = 0u;
    __syncthreads();
    XcdBarrier bar = xcd_barrier_post(WSP(unsigned, WS_CTL) + CW_BAR, misc, wave_s);
    const int lo = p.st_lo, hi = p.st_hi;
#ifdef TIME_STAGE
    unsigned long long* stamps = (unsigned long long*)(p.ws + 5 * MiB + 65536);
    if (blockIdx.x == 0 && tid_of(wave_s) == 0) stamps[0] = __builtin_amdgcn_s_memrealtime();
#define STAMP(k) do { if (blockIdx.x == 0 && tid_of(wave_s) == 0) stamps[(k) + 1] = __builtin_amdgcn_s_memrealtime(); } while (0)
#else
#define STAMP(k) do {} while (0)
#endif
#ifndef DUP_STAGE
#define DUP_STAGE -1
#endif
#ifndef DUP_N
#define DUP_N 1
#endif
#if DUP_STAGE == 0
#define DUPCALL (st_prep(p, gw, ngw, lane), st_rope(p, gt, ngt), st_wrconv(p, gt, ngt), st_wconv(p, gw, ngw, lane, (LAS float*)((LAS unsigned char*)lds + wave * 16384)))
#elif DUP_STAGE == 1
#define DUPCALL fs_g1(p, (LAS unsigned char*)lds, wave_s)
#elif DUP_STAGE == 2
#define DUPCALL fs_g23(p, (LAS unsigned char*)lds, wave_s)
#elif DUP_STAGE == 3
#define DUPCALL st_attn_prep(p, wg, nwg, wave, lane, (bf16_t*)lds)
#elif DUP_STAGE == 4
#define DUPCALL fs_attn(p, (LAS unsigned char*)lds, wave_s)
#elif DUP_STAGE == 5
#define DUPCALL fs_merge(p, (LAS unsigned char*)lds, wave_s)
#elif DUP_STAGE == 6
#define DUPCALL fs_out(p, (LAS unsigned char*)lds, wave_s)
#elif DUP_STAGE == 7
#define DUPCALL st_route(p, wg, nwg, wave, lane, (LAS unsigned char*)lds, 2048)
#elif DUP_STAGE == 8
#define DUPCALL st_lists(p, gt, ngt, tid, wg, nwg, (LAS unsigned*)((LAS unsigned char*)lds))
#elif DUP_STAGE == 9
#define DUPCALL fs_gu(p, (LAS unsigned char*)lds, wave_s)
#elif DUP_STAGE == 11
#define DUPCALL st_combine(p, gw, ngw, lane, true)
#else
#define DUPCALL
#endif
#define RUN(k, call) if (lo <= (k) && (k) < hi) { { int tid = tid_of(wave_s); asm volatile("" : "+v"(tid)); const int lane = tid & 63, wave = tid >> 6; const int wg = blockIdx.x, nwg = gridDim.x; \
        const int gw = wg * (NT / 64) + wave, ngw = nwg * (NT / 64); const size_t gt = (size_t)wg * NT + tid, ngt = (size_t)nwg * NT; \
        (void)lane; (void)wave; (void)wg; (void)nwg; (void)gw; (void)ngw; (void)gt; (void)ngt; \
        if ((k) == DUP_STAGE) { for (int d_ = 0; d_ < DUP_N; ++d_) { DUPCALL; xcd_barrier(bar); } } call; } if ((k) + 1 < hi) xcd_barrier(bar); STAMP(k); }
    RUN(0, (st_prep(p, gw, ngw, lane), st_rope(p, gt, ngt), st_wrconv(p, gt, ngt), st_wconv(p, gw, ngw, lane, (LAS float*)((LAS unsigned char*)lds + wave * 16384))))
    RUN(1, (fs_g1(p, (LAS unsigned char*)lds, wave_s), fs_pp(p, (LAS unsigned char*)lds, wave_s)))
    RUN(2, fs_g23(p, (LAS unsigned char*)lds, wave_s))
    RUN(3, st_attn_prep(p, wg, nwg, wave, lane, (bf16_t*)lds))
    RUN(4, fs_attn(p, (LAS unsigned char*)lds, wave_s))
    RUN(5, fs_merge(p, (LAS unsigned char*)lds, wave_s))
    RUN(6, fs_out(p, (LAS unsigned char*)lds, wave_s))
    RUN(7, st_route(p, wg, nwg, wave, lane, (LAS unsigned char*)lds))
    RUN(8, st_lists(p, gt, ngt, tid, wg, nwg, (LAS unsigned*)((LAS unsigned char*)lds)))
    RUN(9, fs_gu(p, (LAS unsigned char*)lds, wave_s))
    RUN(10, fs_down(p, (LAS unsigned char*)lds, wave_s))
    RUN(11, st_combine(p, gw, ngw, lane))
    RUN(12, fs_ple(p, (LAS unsigned char*)lds, wave_s))
#undef RUN
#ifdef TIME_STAGE
    xcd_barrier(bar);
    if (tid_of(wave_s) == 0) { const unsigned long long d = __hip_atomic_load(&stamps[TIME_STAGE + 1], __ATOMIC_RELAXED, __HIP_MEMORY_SCOPE_AGENT) - __hip_atomic_load(&stamps[TIME_STAGE], __ATOMIC_RELAXED, __HIP_MEMORY_SCOPE_AGENT);
        const unsigned long long t0 = __builtin_amdgcn_s_memrealtime(); while (__builtin_amdgcn_s_memrealtime() - t0 < 4ull * d) __builtin_amdgcn_s_sleep(8); }
    __syncthreads();
#endif
}

extern "C" void kernel_launch(void* const* d_in, const int* in_sizes, int n_in, void* d_out, int out_size, void* d_ws, size_t ws_size, hipStream_t stream) {
    if (n_in != 29 || ws_size < WS_END) { fprintf(stderr, "kernel_launch: unexpected n_in %d or ws_size %zu\n", n_in, ws_size); return; }
    P p{};
    p.x = (const float*)d_in[0]; p.p = (const float*)d_in[1]; p.pos = (const int*)d_in[2];
#define IN_(name, i) p.name = (const float*)d_in[i]
    IN_(g_mix, 3); IN_(w_in, 4); IN_(b_gate, 5); IN_(g_cq, 6); IN_(w_uq, 7); IN_(g_ckv, 8); IN_(w_ukv, 9); IN_(g_qn_mla, 10); IN_(g_kn_mla, 11);
    IN_(g_qn_swa, 12); IN_(g_kn_swa, 13); IN_(sink, 14); IN_(w_br_mla, 15); IN_(w_br_swa, 16); IN_(w_out, 17); IN_(g_moe, 18); IN_(w_router, 19);
    IN_(router_bias, 20); IN_(w_exp_gu, 21); IN_(w_exp_down, 22); IN_(w_sh_gu, 23); IN_(w_sh_down, 24); IN_(g_ple, 25); IN_(w_ple_gate, 26); IN_(b_ple, 27); IN_(w_ple_proj, 28);
#undef IN_
    p.out = (float*)d_out; p.ws = (unsigned char*)d_ws;
    static int grid = 0;
    if (grid == 0) {
        int dev = 0, cus = 0, per_cu = 0;
        (void)hipGetDevice(&dev); (void)hipDeviceGetAttribute(&cus, hipDeviceAttributeMultiprocessorCount, dev);
        (void)hipFuncSetAttribute((const void*)k_fwd, hipFuncAttributeMaxDynamicSharedMemorySize, LDS_DYN);
        (void)hipOccupancyMaxActiveBlocksPerMultiprocessor(&per_cu, (const void*)k_fwd, NT, LDS_DYN);
        (void)hipGetLastError();
        if (per_cu < 1) { fprintf(stderr, "kernel_launch: occupancy query says %d blocks per CU\n", per_cu); grid = -1; return; }
        grid = cus;
    }
    if (grid < 0) return;
    (void)hipMemsetAsync((char*)d_ws + WS_CTL, 0, CTL_BYTES, stream);
    p.st_lo = 0; p.st_hi = N_STAGES;
    void* args[] = {&p};
    hipError_t e = hipLaunchCooperativeKernel((const void*)k_fwd, dim3(grid), dim3(NT), args, LDS_DYN, stream);
    if (e != hipSuccess) fprintf(stderr, "cooperative launch failed: %s (grid %d)\n", hipGetErrorString(e), grid);
}
```

```cpp
#include <hip/hip_runtime.h>
#include <stdint.h>
#include <cstdio>

constexpr int B_ = 8, S_ = 2048, D_ = 1024, M_ = B_ * S_;
constexpr int NZ = 3584;
constexpr int INW = 3488;
constexpr int ZQ = 0, ZKR = 384, ZCKV = 512, ZQS = 768, ZKS = 1280, ZVS = 1408, ZGA = 1536, ZGB = 2560;
constexpr int NE = 64, TOPK = 8, EFF = 256;
constexpr int NSLOT = M_ * TOPK + NE * 256;
constexpr float EPS = 1e-6f;
constexpr float LOG2E = 1.4426950408889634f;

typedef unsigned short bf16_t;
__device__ __forceinline__ float bf2f(bf16_t v) { return __uint_as_float((unsigned)v << 16); }
__device__ __forceinline__ bf16_t f2bf(float f) { unsigned u = __float_as_uint(f); return (bf16_t)((u + 0x7fffu + ((u >> 16) & 1u)) >> 16); }
__device__ __forceinline__ float sigmoidf_(float v) { return 1.f / (1.f + __expf(-v)); }
__device__ __forceinline__ float wave_sum(float v) {
#pragma unroll
    for (int o = 1; o < 64; o <<= 1) v += __shfl_xor(v, o);
    return v;
}
__device__ __forceinline__ float wave_max(float v) {
#pragma unroll
    for (int o = 1; o < 64; o <<= 1) v = fmaxf(v, __shfl_xor(v, o));
    return v;
}

constexpr size_t MiB = 1u << 20;
constexpr size_t WS_CTL = 0, CTL_BYTES = 64 * 1024;
constexpr size_t WS_TOPE = 1 * MiB, WS_TOPW = WS_TOPE + 512 * 1024, WS_TOPLS = WS_TOPW + 512 * 1024, WS_POS = WS_TOPLS + 512 * 1024;
constexpr size_t WS_LTOK = 3 * MiB, WS_LW = WS_LTOK + 640 * 1024;
constexpr size_t WS_PB = 6 * MiB, WS_WDN = 14 * MiB, WS_WPG = 48 * MiB, WS_WPP = 50 * MiB, WS_WSHDN = 46 * MiB;
constexpr size_t WS_HID = 51 * MiB, WS_HSH = 123 * MiB, WS_R = 131 * MiB;
constexpr size_t WS_WGU = 131 * MiB, WS_WSHGU = 195 * MiB, WS_WIN = 196 * MiB, WS_WUQ = 203 * MiB, WS_WUKV = 204 * MiB, WS_WBRM = 205 * MiB, WS_WBRS = 206 * MiB, WS_WOUT = 207 * MiB;
constexpr size_t WS_Z = 210 * MiB, WS_HB = 322 * MiB, WS_MG = 322 * MiB, WS_QMR = 354 * MiB, WS_OM = 354 * MiB, WS_OW = 370 * MiB, WS_KVR = 378 * MiB;
constexpr size_t WS_QM = 410 * MiB, WS_KM = 434 * MiB, WS_VTM = 458 * MiB, WS_QS = 474 * MiB, WS_KS = 490 * MiB, WS_VTS = 494 * MiB;
constexpr size_t WS_H3F8 = 31 * MiB;
constexpr size_t WS_H2 = 210 * MiB, WS_Y = 131 * MiB, WS_H3 = 419 * MiB, WS_PP = 93 * MiB, WS_END = 498 * MiB;
constexpr size_t WS_WRH = 209 * MiB, WS_WRL = WS_WRH + 128 * 1024, WS_RSTD2 = WS_WRL + 128 * 1024;
constexpr size_t WS_LR = WS_LW + 640 * 1024;
constexpr size_t WS_INV3 = WS_TOPW;
constexpr size_t WS_WCNT = WS_RSTD2 + 64 * 1024;
constexpr size_t WS_TCNT = WS_WCNT + 512 * 1024;
constexpr int CW_CNT = 0;
constexpr int CW_BASE = 64;

struct P {
    const float *x, *p; const int* pos;
    const float *g_mix, *w_in, *b_gate, *g_cq, *w_uq, *g_ckv, *w_ukv, *g_qn_mla, *g_kn_mla, *g_qn_swa, *g_kn_swa, *sink;
    const float *w_br_mla, *w_br_swa, *w_out, *g_moe, *w_router, *router_bias, *w_exp_gu, *w_exp_down, *w_sh_gu, *w_sh_down;
    const float *g_ple, *w_ple_gate, *b_ple, *w_ple_proj;
    float* out; unsigned char* ws; int st_lo; int st_hi;
};
#define WSP(T, off) ((T*)(p.ws + (off)))
__device__ __forceinline__ int tid_of(int wv) { int l; asm volatile("v_mbcnt_lo_u32_b32 %0, -1, 0\n\tv_mbcnt_hi_u32_b32 %0, -1, %0" : "=v"(l)); return wv * 64 + l; }

typedef float f32x4_t __attribute__((ext_vector_type(4)));
typedef unsigned u32x2_t __attribute__((ext_vector_type(2)));
typedef unsigned u32x4_t __attribute__((ext_vector_type(4)));
__device__ __forceinline__ unsigned cvtpk_(float lo, float hi) { unsigned r; asm volatile("v_cvt_pk_bf16_f32 %0, %1, %2" : "=v"(r) : "v"(lo), "v"(hi)); return r; }
__device__ __forceinline__ float bflo(unsigned w) { return __uint_as_float(w << 16); }
__device__ __forceinline__ float bfhi(unsigned w) { return __uint_as_float(w & 0xffff0000u); }
__device__ __forceinline__ void st_prep(const P& p, int gw, int ngw, int lane) {
    bf16_t* hb = WSP(bf16_t, WS_HB); bf16_t* pb = WSP(bf16_t, WS_PB);
    f32x4_t nv[4], npv;
    if (gw < M_) { const f32x4_t* xr = (const f32x4_t*)(p.x + (size_t)gw * D_) + lane;
#pragma unroll
        for (int j = 0; j < 4; ++j) nv[j] = xr[64 * j];
        npv = ((const f32x4_t*)(p.p + (size_t)gw * 256))[lane]; }
    for (int m = gw; m < M_; m += ngw) {
        f32x4_t v[4]; const f32x4_t pv = npv; float s = 0.f;
#pragma unroll
        for (int j = 0; j < 4; ++j) v[j] = nv[j];
        if (m + ngw < M_) { const f32x4_t* xr = (const f32x4_t*)(p.x + (size_t)(m + ngw) * D_) + lane;
#pragma unroll
            for (int j = 0; j < 4; ++j) nv[j] = xr[64 * j];
            npv = ((const f32x4_t*)(p.p + (size_t)(m + ngw) * 256))[lane]; }
#pragma unroll
        for (int j = 0; j < 4; ++j) s += (v[j].x * v[j].x + v[j].y * v[j].y) + (v[j].z * v[j].z + v[j].w * v[j].w);
        s = wave_sum(s); const float r = 1.f / sqrtf(s * (1.f / D_) + EPS);
        u32x2_t* o = (u32x2_t*)(hb + (size_t)m * D_) + lane;
#pragma unroll
        for (int j = 0; j < 4; ++j) o[64 * j] = (u32x2_t){cvtpk_(v[j].x * r, v[j].y * r), cvtpk_(v[j].z * r, v[j].w * r)};
        ((u32x2_t*)(pb + (size_t)m * 256))[lane] = (u32x2_t){cvtpk_(pv.x, pv.y), cvtpk_(pv.z, pv.w)};
    }
}
constexpr size_t WS_CS = 51 * MiB;
__device__ __forceinline__ void st_rope(const P& p, size_t gt, size_t ngt) {
    float* cs = WSP(float, WS_CS);
    for (size_t i = gt; i < (size_t)M_ * 48; i += ngt) { const int m = (int)(i / 48), f = (int)(i % 48);
        const float posf = (float)p.pos[m]; float sv, cv;
        if (f < 16) { float rev = posf * exp2f(-13.287712379549449f * (float)f * (1.f / 16.f)) * 0.15915494309189535f; rev -= floorf(rev); sv = __builtin_amdgcn_sinf(rev); cv = __builtin_amdgcn_cosf(rev);
            cs[(size_t)m * 96 + f] = cv; cs[(size_t)m * 96 + 16 + f] = sv; }
        else { const int g = f - 16; float rev = posf * exp2f(-13.287712379549449f * (float)g * (1.f / 32.f)) * 0.15915494309189535f; rev -= floorf(rev); sv = __builtin_amdgcn_sinf(rev); cv = __builtin_amdgcn_cosf(rev);
            cs[(size_t)m * 96 + 32 + g] = cv; cs[(size_t)m * 96 + 64 + g] = sv; } }
}
constexpr int VT_PITCH = 72;
typedef float f32x2_t __attribute__((ext_vector_type(2)));
struct P8 { f32x2_t p[4]; };
__device__ __forceinline__ P8 cvp8(const u32x4_t w) { P8 r; r.p[0] = (f32x2_t){bflo(w.x), bfhi(w.x)}; r.p[1] = (f32x2_t){bflo(w.y), bfhi(w.y)}; r.p[2] = (f32x2_t){bflo(w.z), bfhi(w.z)}; r.p[3] = (f32x2_t){bflo(w.w), bfhi(w.w)}; return r; }
__device__ __forceinline__ P8 ldp8(const float* ptr) { const f32x4_t a = *(const f32x4_t*)ptr, b = *(const f32x4_t*)(ptr + 4); P8 r; r.p[0] = (f32x2_t){a.x, a.y}; r.p[1] = (f32x2_t){a.z, a.w}; r.p[2] = (f32x2_t){b.x, b.y}; r.p[3] = (f32x2_t){b.z, b.w}; return r; }
__device__ __forceinline__ P8 f4p8(const f32x4_t a, const f32x4_t b) { P8 r; r.p[0] = (f32x2_t){a.x, a.y}; r.p[1] = (f32x2_t){a.z, a.w}; r.p[2] = (f32x2_t){b.x, b.y}; r.p[3] = (f32x2_t){b.z, b.w}; return r; }
__device__ __forceinline__ void stp8(bf16_t* ptr, const P8& x) { u32x4_t w; w.x = cvtpk_(x.p[0].x, x.p[0].y); w.y = cvtpk_(x.p[1].x, x.p[1].y); w.z = cvtpk_(x.p[2].x, x.p[2].y); w.w = cvtpk_(x.p[3].x, x.p[3].y); *(u32x4_t*)ptr = w; }
__device__ __forceinline__ float ssqp(const P8& x) { f32x2_t a = x.p[0] * x.p[0]; a = x.p[1] * x.p[1] + a; a = x.p[2] * x.p[2] + a; a = x.p[3] * x.p[3] + a; return a.x + a.y; }
template <int CTRL> __device__ __forceinline__ float dppf(float v) { return __uint_as_float((unsigned)__builtin_amdgcn_update_dpp(0, (int)__float_as_uint(v), CTRL, 0xF, 0xF, true)); }
__device__ __forceinline__ float sum8_dpp(float v) { v += dppf<0x141>(v); v += dppf<0xB1>(v); v += dppf<0x4E>(v); return v; }
__device__ __forceinline__ float sum16_dpp(float v) { v += dppf<0x140>(v); return sum8_dpp(v); }
__device__ __forceinline__ float wave_sum_dpp(float v) { v = sum16_dpp(v);
    return __uint_as_float((unsigned)__builtin_amdgcn_readlane((int)__float_as_uint(v), 0)) + __uint_as_float((unsigned)__builtin_amdgcn_readlane((int)__float_as_uint(v), 16))
         + __uint_as_float((unsigned)__builtin_amdgcn_readlane((int)__float_as_uint(v), 32)) + __uint_as_float((unsigned)__builtin_amdgcn_readlane((int)__float_as_uint(v), 48)); }
template <int GL, int PX>
__device__ __forceinline__ void norm_rope(P8& x, bool valid, float pre, float inv_n, const P8& g, const P8& c, const P8& s) {
    float ss = valid ? pre * pre * ssqp(x) : 0.f;
    ss = (GL == 16) ? sum16_dpp(ss) : sum8_dpp(ss);
    const float r = pre * __builtin_amdgcn_rsqf(ss * inv_n + EPS);
    const f32x2_t rr = {r, r};
#pragma unroll
    for (int j = 0; j < 4; ++j) { x.p[j] *= rr * g.p[j];
        f32x2_t o;
        o.x = (PX == 2) ? dppf<0x4E>(x.p[j].x) : dppf<0x1B>(dppf<0x141>(x.p[j].x)); o.y = (PX == 2) ? dppf<0x4E>(x.p[j].y) : dppf<0x1B>(dppf<0x141>(x.p[j].y));
        x.p[j] = x.p[j] * c.p[j] + o * s.p[j]; }
}
__device__ __forceinline__ void st_attn_prep(const P& p, int wg, int nwg, int wave, int lane, bf16_t* lds) {
    const bf16_t* z = WSP(bf16_t, WS_Z); const bf16_t* qmr = WSP(bf16_t, WS_QMR); const bf16_t* kvr = WSP(bf16_t, WS_KVR); const float* cs = WSP(float, WS_CS);
    bf16_t* QM = WSP(bf16_t, WS_QM); bf16_t* KM = WSP(bf16_t, WS_KM); bf16_t* VTM = WSP(bf16_t, WS_VTM);
    bf16_t* QS = WSP(bf16_t, WS_QS); bf16_t* KS = WSP(bf16_t, WS_KS); bf16_t* VTS = WSP(bf16_t, WS_VTS);
    const float sc_m = 0.10206207261596575f * LOG2E;
    const float sc_s = 0.125f * LOG2E;
    const int c16 = lane & 15, h16 = lane >> 4, c8 = lane & 7, h8 = lane >> 3;
    const bool v12 = c16 < 12, rotm = (c16 >= 8) && v12;
    P8 gqm = ldp8(p.g_qn_mla + 8 * (v12 ? c16 : 0)), gqs = ldp8(p.g_qn_swa + 8 * c8);
    const P8 gkm = ldp8(p.g_kn_mla + 8 * (v12 ? c16 : 0)), gks = ldp8(p.g_kn_swa + 8 * c8);
#pragma unroll
    for (int j = 0; j < 4; ++j) { gqm.p[j] *= (f32x2_t){sc_m, sc_m}; gqs.p[j] *= (f32x2_t){sc_s, sc_s}; }
    const unsigned sgm = (c16 >= 10) ? 0u : 0x80000000u, sgs = (c8 >= 4) ? 0u : 0x80000000u;
    for (int tile = wg; tile < M_ / 64; tile += nwg) {
        __syncthreads();
        struct Raw { u32x4_t zq, zkv, qa, qb, ka, kb, vm, qs, ksv; f32x4_t cm0, cm1, sm0, sm1, cw0, cw1, sw0, sw1; };
        auto load_raw = [&](int m) { Raw r; const bf16_t* zr = z + (size_t)m * NZ; const bf16_t* qr = qmr + (size_t)m * 768; const bf16_t* kr = kvr + (size_t)m * 1024;
            r.zq = *(const u32x4_t*)(zr + ZQ + 8 * (lane < 48 ? lane : 0)); r.zkv = *(const u32x4_t*)(zr + ZCKV + 8 * (lane & 31));
            r.qa = *(const u32x4_t*)(qr + h16 * 96 + 8 * (c16 < 12 ? c16 : 0)); r.qb = *(const u32x4_t*)(qr + (4 + h16) * 96 + 8 * (c16 < 12 ? c16 : 0));
            r.ka = (c16 < 8) ? *(const u32x4_t*)(kr + h16 * 128 + 8 * c16) : *(const u32x4_t*)(zr + ZKR + 8 * (c16 & 3));
            r.kb = (c16 < 8) ? *(const u32x4_t*)(kr + (4 + h16) * 128 + 8 * c16) : *(const u32x4_t*)(zr + ZKR + 8 * (c16 & 3));
            r.vm = *(const u32x4_t*)(kr + h8 * 128 + 64 + 8 * c8); r.qs = *(const u32x4_t*)(zr + ZQS + 8 * lane); r.ksv = *(const u32x4_t*)(zr + ZKS + 8 * (lane & 31));
            const float* csr = cs + (size_t)m * 96; const float* cm = csr + 8 * (c16 & 1); const float* cw = csr + 32 + 8 * (c8 & 3);
            r.cm0 = *(const f32x4_t*)cm; r.cm1 = *(const f32x4_t*)(cm + 4); r.sm0 = *(const f32x4_t*)(cm + 16); r.sm1 = *(const f32x4_t*)(cm + 20);
            r.cw0 = *(const f32x4_t*)cw; r.cw1 = *(const f32x4_t*)(cw + 4); r.sw0 = *(const f32x4_t*)(cw + 32); r.sw1 = *(const f32x4_t*)(cw + 36);
            return r; };
        Raw nx = load_raw(tile * 64 + wave * 8);
        for (int tt = 0; tt < 8; ++tt) {
            const int tl = wave * 8 + tt, m = tile * 64 + tl, b = m / S_, s = m % S_;
            const int tls = tl ^ (8 * ((lane >> 1) & 7));
            const Raw cu = nx;
            if (tt < 7) nx = load_raw(m + 1);
            const P8 zq = cvp8(cu.zq), zkv = cvp8(cu.zkv); P8 qa = cvp8(cu.qa), qb = cvp8(cu.qb), ka = cvp8(cu.ka), kb = cvp8(cu.kb), vm = cvp8(cu.vm), qs = cvp8(cu.qs), ks = cvp8(cu.ksv);
            const float rq = __builtin_amdgcn_rsqf(wave_sum_dpp(lane < 48 ? ssqp(zq) : 0.f) * (1.f / 384.f) + EPS);
            const float rkv = __builtin_amdgcn_rsqf(wave_sum_dpp(lane < 32 ? ssqp(zkv) : 0.f) * (1.f / 256.f) + EPS);
            P8 cM = f4p8(cu.cm0, cu.cm1), sM = f4p8(cu.sm0, cu.sm1), cW = f4p8(cu.cw0, cu.cw1), sW = f4p8(cu.sw0, cu.sw1);
#pragma unroll
            for (int j = 0; j < 4; ++j) {
                cM.p[j].x = rotm ? cM.p[j].x : 1.f; cM.p[j].y = rotm ? cM.p[j].y : 1.f;
                sM.p[j].x = rotm ? __uint_as_float(__float_as_uint(sM.p[j].x) ^ sgm) : 0.f; sM.p[j].y = rotm ? __uint_as_float(__float_as_uint(sM.p[j].y) ^ sgm) : 0.f;
                sW.p[j].x = __uint_as_float(__float_as_uint(sW.p[j].x) ^ sgs); sW.p[j].y = __uint_as_float(__float_as_uint(sW.p[j].y) ^ sgs); }
            const float kpre = (c16 < 8) ? rkv : 1.f;
            norm_rope<16, 2>(qa, v12, rq, 1.f / 96.f, gqm, cM, sM);
            norm_rope<16, 2>(qb, v12, rq, 1.f / 96.f, gqm, cM, sM);
            norm_rope<16, 2>(ka, v12, kpre, 1.f / 96.f, gkm, cM, sM);
            norm_rope<16, 2>(kb, v12, kpre, 1.f / 96.f, gkm, cM, sM);
            if (v12) { stp8(QM + ((size_t)(b * 8 + h16) * S_ + s) * 96 + 8 * c16, qa); stp8(QM + ((size_t)(b * 8 + 4 + h16) * S_ + s) * 96 + 8 * c16, qb);
                       stp8(KM + ((size_t)(b * 8 + h16) * S_ + s) * 96 + 8 * c16, ka); stp8(KM + ((size_t)(b * 8 + 4 + h16) * S_ + s) * 96 + 8 * c16, kb); }
            { const f32x2_t rv = {rkv, rkv};
#pragma unroll
              for (int j = 0; j < 4; ++j) { const f32x2_t t = vm.p[j] * rv; const unsigned w = cvtpk_(t.x, t.y);
                  lds[(h8 * 64 + 8 * c8 + 2 * j) * VT_PITCH + tls] = (bf16_t)(w & 0xffffu); lds[(h8 * 64 + 8 * c8 + 2 * j + 1) * VT_PITCH + tls] = (bf16_t)(w >> 16); } }
            norm_rope<8, 4>(qs, true, 1.f, 1.f / 64.f, gqs, cW, sW);
            stp8(QS + ((size_t)(b * 8 + h8) * S_ + s) * 64 + 8 * c8, qs);
            norm_rope<8, 4>(ks, lane < 16, 1.f, 1.f / 64.f, gks, cW, sW);
            if (lane < 16) stp8(KS + ((size_t)(b * 2 + h8) * S_ + s) * 64 + 8 * c8, ks);
            else if (lane < 32) { const unsigned wv[4] = {cu.ksv.x, cu.ksv.y, cu.ksv.z, cu.ksv.w};
#pragma unroll
                for (int j = 0; j < 4; ++j) { lds[(512 + (h8 - 2) * 64 + 8 * c8 + 2 * j) * VT_PITCH + tls] = (bf16_t)(wv[j] & 0xffffu); lds[(512 + (h8 - 2) * 64 + 8 * c8 + 2 * j + 1) * VT_PITCH + tls] = (bf16_t)(wv[j] >> 16); } }
        }
        __syncthreads();
        const int b = (tile * 64) / S_, s0 = (tile * 64) % S_;
        int ln = lane; asm volatile("" : "+v"(ln));
        for (int r0 = wave * 8; r0 < 640; r0 += 64) { const int r = r0 + (ln >> 3), t8 = (ln & 7) * 8;
            const u32x4_t v = *(const u32x4_t*)(lds + r * VT_PITCH + (t8 ^ (8 * ((r >> 4) & 7))));
            if (r < 512) *(u32x4_t*)(VTM + ((size_t)(b * 8 + (r >> 6)) * 64 + (r & 63)) * S_ + s0 + t8) = v;
            else { const int rr = r - 512; *(u32x4_t*)(VTS + ((size_t)(b * 2 + (rr >> 6)) * 64 + (rr & 63)) * S_ + s0 + t8) = v; } }
    }
}

#define LAS __attribute__((address_space(3)))
#define XB_TMO      128
#define XB_XCNT(j)  (256  + 64 * (j))
#define XB_XSUB(j)  (1280 + 64 * (j))
#define XB_XGEN(j)  (2304 + 64 * (j))
#define XB_TOP      3328
#define XB_TOPGEN   3392
#define XCD_BAR_WORDS 3456
#define XB_SPIN_CAP (1u << 18)
__device__ __forceinline__ unsigned xb_ld(unsigned* p)              { return __hip_atomic_load(p, __ATOMIC_RELAXED, __HIP_MEMORY_SCOPE_AGENT); }
__device__ __forceinline__ unsigned xb_add(unsigned* p, unsigned v) { return __hip_atomic_fetch_add(p, v, __ATOMIC_RELAXED, __HIP_MEMORY_SCOPE_AGENT); }
__device__ __forceinline__ unsigned xb_xcc_id() { return (unsigned)__builtin_amdgcn_s_getreg((3 << 11) | 20) & 0xFu; }
#define XB_SPIN(cond, bar) do { unsigned _sp = 0; while (cond) { __builtin_amdgcn_s_sleep(1); \
    if ((++_sp & 255u) == 0u) { if (xb_ld(&(bar)[XB_TMO])) break; if (_sp > XB_SPIN_CAP) { atomicAdd(&(bar)[XB_TMO], 1u); break; } } } } while (0)
struct XcdBarrier { unsigned* bar; unsigned x; volatile LAS unsigned* st; int wv; };
__device__ __forceinline__ XcdBarrier xcd_barrier_post(unsigned* bar, volatile LAS unsigned* st, int wv) {
    XcdBarrier b; b.bar = bar; b.x = xb_xcc_id(); b.st = st; b.wv = wv;
    if (tid_of(wv) == 0) (void)xb_add(&bar[XB_XCNT(b.x)], 1u);
    return b;
}
__device__ __forceinline__ void xcd_barrier_complete(unsigned* bar, unsigned x, unsigned& nloc, unsigned& nx) {
    const unsigned G = gridDim.x * gridDim.y * gridDim.z;
    unsigned sum, cnt, mine, sp = 0u;
    for (;;) {
        sum = 0u; cnt = 0u; mine = 0u;
#pragma unroll
        for (unsigned j = 0; j < 16; ++j) { const unsigned c = xb_ld(&bar[XB_XCNT(j)]); sum += c; cnt += (c > 0u) ? 1u : 0u; mine = (j == x) ? c : mine; }
        if (sum == G) break;
        __builtin_amdgcn_s_sleep(1);
        if ((++sp & 255u) == 0u) { if (xb_ld(&bar[XB_TMO])) break; if (sp > XB_SPIN_CAP) { atomicAdd(&bar[XB_TMO], 1u); break; } }
    }
    nloc = mine > 0u ? mine : 1u; nx = cnt > 0u ? cnt : 1u;
}
__device__ __forceinline__ void xcd_barrier(const XcdBarrier& b) {
    asm volatile("s_waitcnt vmcnt(0)" ::: "memory");
    __syncthreads();
    if (tid_of(b.wv) == 0) {
        unsigned* bar = b.bar;
        __builtin_amdgcn_s_waitcnt(0);
        unsigned nloc = b.st[0], nx = b.st[1];
        if (nloc == 0u) { xcd_barrier_complete(bar, b.x, nloc, nx); b.st[0] = nloc; b.st[1] = nx; }
        const unsigned old = xb_add(&bar[XB_XSUB(b.x)], 1u);
        const unsigned gen = old / nloc;
        if (old + 1u == (gen + 1u) * nloc) {
            __builtin_amdgcn_fence(__ATOMIC_RELEASE, "agent");
            asm volatile("s_waitcnt vmcnt(0)" ::: "memory");
            const unsigned og = xb_add(&bar[XB_TOP], 1u);
            const unsigned tg = og / nx;
            if (og + 1u == (tg + 1u) * nx) xb_add(&bar[XB_TOPGEN], 1u);
            else XB_SPIN(xb_ld(&bar[XB_TOPGEN]) == tg, bar);
            __builtin_amdgcn_fence(__ATOMIC_ACQUIRE, "agent");
            xb_add(&bar[XB_XGEN(b.x)], 1u);
            asm volatile("s_waitcnt vmcnt(0)" ::: "memory");
        } else {
            XB_SPIN(xb_ld(&bar[XB_XGEN(b.x)]) == gen, bar);
            __builtin_amdgcn_fence(__ATOMIC_ACQUIRE, "agent");
            asm volatile("s_waitcnt vmcnt(0)" ::: "memory");
        }
    }
    __syncthreads();
}
constexpr int CW_BAR = 4096;

namespace pg8 {
typedef short bf16x8 __attribute__((ext_vector_type(8)));
typedef float f32x4 __attribute__((ext_vector_type(4)));
typedef unsigned u32x4 __attribute__((ext_vector_type(4)));
typedef unsigned u32x2 __attribute__((ext_vector_type(2)));
constexpr int GTBL_OFF = 128 * 1024;
constexpr int BM = 256, BK = 64, HALF = 128, HTB = HALF * BK * 2, STAGE_BYTES = 8 * HTB, NXCD = 8, WGM = 8;
__host__ __device__ __forceinline__ int lds_byte(int r, int c) { const int st = (r >> 4) * 2 + (c >> 5), rr = r & 15, cc = c & 31, ob = rr * 64 + cc * 2; return st * 1024 + (ob ^ (((ob >> 9) & 1) << 5)); }
__host__ __device__ __forceinline__ void stage_rc(int b, int& R, int& C) { const int st = b / 1024, sb = b % 1024, swz = sb ^ (((sb >> 9) & 1) << 5); R = (st >> 1) * 16 + swz / 64; C = (st & 1) * 32 + (swz % 64) / 2; }
__host__ __device__ __forceinline__ int perm32(int rho) { const int n = rho >> 4, i = rho & 15; return 8 * (i >> 2) + 4 * n + (i & 3); }
__device__ __forceinline__ unsigned cvt_pk_bf16(float lo, float hi) { unsigned r; asm volatile("v_cvt_pk_bf16_f32 %0, %1, %2" : "=v"(r) : "v"(lo), "v"(hi)); return r; }

struct Unit { int pm, pn; const char* Ab; const char* Bb; int aux; };

struct DenseSched {
    const char* A; const char* Bt; size_t astep, bstep;
    int nM, nN, nwg, G, c;
    __device__ __forceinline__ void init(const void* A_, int lda, const void* Bt_, int ldb, int M, int N, int G_, int c_) {
        A = (const char*)A_; Bt = (const char*)Bt_; astep = (size_t)BM * lda * 2; bstep = (size_t)BM * ldb * 2; nM = M / BM; nN = N / BM; nwg = nM * nN; G = G_; c = c_; }
    __device__ __forceinline__ bool next(int i, Unit& u) const {
        const int L = i * G + c; if (L >= nwg) return false;
        int wgid = L; { const int q = nwg / NXCD, r = nwg % NXCD, xcd = wgid % NXCD, off = wgid / NXCD; wgid = (xcd < r ? xcd * (q + 1) : r * (q + 1) + (xcd - r) * q) + off; }
        const int nig = WGM * nN, gid = wgid / nig, fm = gid * WGM, gsz = (nM - fm) < WGM ? (nM - fm) : WGM;
        u.pm = fm + ((wgid % nig) % gsz); u.pn = (wgid % nig) / gsz; u.Ab = A + (size_t)u.pm * astep; u.Bb = Bt + (size_t)u.pn * bstep; u.aux = 0; return true;
    }
    __device__ __forceinline__ int row(const Unit&, int) const { return 0; }
    __device__ __forceinline__ const int* rowtab(const Unit&) const { return nullptr; }
};

typedef int i32x4 __attribute__((ext_vector_type(4)));
typedef int i32x8 __attribute__((ext_vector_type(8)));
template <class Epi, class Sched, bool GATHER, bool F8 = false>
__device__ __forceinline__ void gemm_phase(LAS unsigned char* lds, const int wv, const int K, const int lda, const int ldb, const Sched& S, const Epi& E) {
    int tid = tid_of(wv); asm volatile("" : "+v"(tid));
    const int wid = __builtin_amdgcn_readfirstlane(tid >> 6), lane = tid & 63, wr = wid >> 2, wc = wid & 3, fr = lane & 15, fq = lane >> 4;
    int nt = K / BK; if constexpr (F8) asm volatile("" : "+s"(nt));
    unsigned voffB[2];
#pragma unroll
    for (int i = 0; i < 2; ++i) { int R, C; stage_rc(tid * 16 + i * 8192, R, C);
        const int Rb = Epi::PERM2 ? (64 * (R >> 5) + 16 * ((R & 15) >> 2) + 4 * ((R >> 4) & 1) + (R & 3)) : Epi::PERM ? ((R & ~31) + perm32(R & 31)) : R;
        voffB[i] = (unsigned)(Rb * ldb + C) * 2u; }
    const size_t kstep = (size_t)(BK * 2);
    const size_t hstepB = Epi::PERM2 ? (size_t)8 * ldb * 2 : (size_t)HALF * ldb * 2;
    const size_t hstepA = GATHER ? 0 : (size_t)HALF * lda * 2;
    const unsigned ldsw = (unsigned)wid * 1024u;
    const int aoff = lds_byte(wr * 64 + fr, fq * 8), boff = lds_byte(wc * 32 + fr, fq * 8);
#define PG8_SA(b, h) (((b) * 2 + (h)) * HTB)
#define PG8_SB(b, h) ((4 + (b) * 2 + (h)) * HTB)
#define PG8_STAGE(bufoff, gbase, v0, v1) do { const char* gb_ = (const char*)(gbase); asm volatile("" : "+s"(gb_));     \
        __builtin_amdgcn_global_load_lds((const unsigned*)(gb_ + (v0)), (LAS unsigned*)(lds + (bufoff) + ldsw), 16, 0, 0); \
        __builtin_amdgcn_global_load_lds((const unsigned*)(gb_ + (v1)), (LAS unsigned*)(lds + (bufoff) + ldsw + 8192), 16, 0, 0); } while (0)
#define PG8_STAGEB(bufoff, gbase) PG8_STAGE(bufoff, gbase, voffB[0], voffB[1])
#define PG8_LDA(dst, b, h) do { _Pragma("unroll") for (int m = 0; m < 4; ++m) _Pragma("unroll") for (int k = 0; k < 2; ++k) dst[m][k] = *(const LAS bf16x8*)(lds + PG8_SA(b, h) + aoff + m * 2048 + k * 1024); } while (0)
#define PG8_LDB(dst, b, h) do { _Pragma("unroll") for (int n = 0; n < 2; ++n) _Pragma("unroll") for (int k = 0; k < 2; ++k) dst[n][k] = *(const LAS bf16x8*)(lds + PG8_SB(b, h) + boff + n * 2048 + k * 1024); } while (0)
#define PG8_CAT(x) __builtin_shufflevector(__builtin_bit_cast(i32x4, (x)[0]), __builtin_bit_cast(i32x4, (x)[1]), 0, 1, 2, 3, 4, 5, 6, 7)
#define PG8_MMA(ai, bj, At, Bt) do { __builtin_amdgcn_s_setprio(1); \
        if constexpr (F8) { _Pragma("unroll") for (int m = 0; m < 4; ++m) _Pragma("unroll") for (int n = 0; n < 2; ++n) \
            acc[ai][bj][m][n] = __builtin_amdgcn_mfma_scale_f32_16x16x128_f8f6f4(PG8_CAT(Bt[n]), PG8_CAT(At[m]), acc[ai][bj][m][n], 0, 0, 0, 0, 0, 0); } \
        else { _Pragma("unroll") for (int m = 0; m < 4; ++m) _Pragma("unroll") for (int n = 0; n < 2; ++n) _Pragma("unroll") for (int k = 0; k < 2; ++k) \
            acc[ai][bj][m][n] = __builtin_amdgcn_mfma_f32_16x16x32_bf16(Bt[n][k], At[m][k], acc[ai][bj][m][n], 0, 0, 0); } \
        __builtin_amdgcn_s_setprio(0); } while (0)
#define PG8_WAIT_V(n) asm volatile("s_waitcnt vmcnt(" #n ")" ::: "memory")
#define PG8_WAIT_L(n) asm volatile("s_waitcnt lgkmcnt(" #n ")" ::: "memory")
#define PG8_BAR __builtin_amdgcn_s_barrier()
#define PG8_SCHED __builtin_amdgcn_sched_barrier(0)
    unsigned vc00, vc01, gtb = 0, gcb = 0;
    { int t_ = tid; asm volatile("" : "+v"(t_)); int R0_, C0_, R1_, C1_; stage_rc(t_ * 16, R0_, C0_); stage_rc(t_ * 16 + 8192, R1_, C1_);
      vc00 = (unsigned)(R0_ * lda + C0_) * 2u; vc01 = (unsigned)(R1_ * lda + C1_) * 2u; gtb = (unsigned)R0_ * 4u; gcb = (unsigned)C0_ * 2u; }
    const unsigned rowb = (unsigned)lda * 2u;
#define PG8_STAGEA(bufoff, gbase, half, tpar) do { if constexpr (GATHER) { \
        const LAS int* tp_ = (const LAS int*)(lds + GTBL_OFF + (tpar) * 1024 + (half) * 512 + gtb); const unsigned ra_ = (unsigned)tp_[0], rb_ = (unsigned)tp_[64]; \
        PG8_STAGE(bufoff, gbase, ra_ * rowb + gcb, rb_ * rowb + gcb); } else PG8_STAGE(bufoff, gbase, vc00, vc01); } while (0)
#define PG8_TBLDMA(U, tpar) do { const char* tb_ = (const char*)(S.rowtab(U) + (wid & 3) * 64); asm volatile("" : "+s"(tb_)); \
        __builtin_amdgcn_global_load_lds((const unsigned*)(tb_ + (unsigned)(tid_of(wv) & 63) * 4u), (LAS unsigned*)(lds + GTBL_OFF + (tpar) * 1024 + (wid & 3) * 256), 4, 0, 0); } while (0)
    Unit cur, nxt; int ui = 0;
    if (!S.next(0, cur)) return;
    if constexpr (GATHER) { PG8_TBLDMA(cur, 0); asm volatile("s_waitcnt vmcnt(0)" ::: "memory"); __builtin_amdgcn_s_barrier(); }
    f32x4 acc[2][2][4][2];
#pragma unroll
    for (int a = 0; a < 2; ++a)
#pragma unroll
        for (int b = 0; b < 2; ++b)
#pragma unroll
            for (int m = 0; m < 4; ++m)
#pragma unroll
                for (int n = 0; n < 2; ++n) acc[a][b][m][n] = (f32x4){0.f, 0.f, 0.f, 0.f};
    bf16x8 At[4][2], B0[2][2], B1[2][2];
    const char* cA = cur.Ab; const char* cB = cur.Bb;
    PG8_STAGEB(PG8_SB(0, 0), cB); PG8_STAGEB(PG8_SB(0, 1), cB + hstepB); PG8_STAGEA(PG8_SA(0, 0), cA, 0, 0); PG8_STAGEA(PG8_SA(0, 1), cA + hstepA, 1, 0);
    if (wr == 1) PG8_BAR;
    PG8_WAIT_V(2); PG8_BAR;
    PG8_STAGEB(PG8_SB(1, 0), cB + kstep); PG8_STAGEA(PG8_SA(1, 0), cA + kstep, 0, 0); PG8_STAGEB(PG8_SB(1, 1), cB + hstepB + kstep);
    PG8_WAIT_V(6); PG8_BAR;
    for (;;) {
        const bool has_next = S.next(ui + 1, nxt);
        const char* nA = has_next ? nxt.Ab : cA; const char* nB = has_next ? nxt.Bb : cB;
        const int cpar = ui & 1, npar = has_next ? (cpar ^ 1) : cpar;
        if constexpr (GATHER) { if (has_next) PG8_TBLDMA(nxt, npar); }
        for (int t = 0; t < nt; t += 2) {
            const bool last = (t == nt - 2);
            const char* a1 = cA + (size_t)(t + 1) * kstep;
            const char* a2 = last ? nA : cA + (size_t)(t + 2) * kstep; const char* b2 = last ? nB : cB + (size_t)(t + 2) * kstep;
            const char* a3 = a2 + kstep; const char* b3 = b2 + kstep;
            const int wpar = last ? npar : cpar;
            PG8_LDB(B0, 0, 0); PG8_LDB(B1, 0, 1); PG8_SCHED; PG8_LDA(At, 0, 0); PG8_STAGEA(PG8_SA(1, 1), a1 + hstepA, 1, cpar);
            PG8_WAIT_V(8); PG8_WAIT_L(0); PG8_BAR; PG8_MMA(0, 0, At, B0); PG8_MMA(0, 1, At, B1); PG8_BAR; PG8_SCHED;
            PG8_LDA(At, 0, 1); PG8_STAGEB(PG8_SB(0, 0), b2); PG8_STAGEB(PG8_SB(0, 1), b2 + hstepB); PG8_STAGEA(PG8_SA(0, 0), a2, 0, wpar);
            PG8_WAIT_V(8); PG8_WAIT_L(0); PG8_BAR; PG8_MMA(1, 0, At, B0); PG8_MMA(1, 1, At, B1); PG8_BAR; PG8_SCHED;
            PG8_LDB(B0, 1, 0); PG8_LDB(B1, 1, 1); PG8_SCHED; PG8_LDA(At, 1, 0); PG8_STAGEA(PG8_SA(0, 1), a2 + hstepA, 1, wpar);
            PG8_WAIT_V(8); PG8_WAIT_L(0); PG8_BAR; PG8_MMA(0, 0, At, B0); PG8_MMA(0, 1, At, B1); PG8_BAR; PG8_SCHED;
            PG8_LDA(At, 1, 1); PG8_STAGEB(PG8_SB(1, 0), b3); PG8_STAGEB(PG8_SB(1, 1), b3 + hstepB); PG8_STAGEA(PG8_SA(1, 0), a3, 0, wpar);
            PG8_WAIT_V(8); PG8_WAIT_L(0); PG8_BAR; PG8_MMA(1, 0, At, B0); PG8_MMA(1, 1, At, B1); PG8_BAR; PG8_SCHED;
        }
        if (wr == 0) PG8_BAR;
        { const int le = tid_of(wv) & 63; E(acc, cur, wr, wc, le & 15, le >> 4); }
        if (!has_next) break;
#pragma unroll
        for (int a = 0; a < 2; ++a)
#pragma unroll
            for (int b = 0; b < 2; ++b)
#pragma unroll
                for (int m = 0; m < 4; ++m)
#pragma unroll
                    for (int n = 0; n < 2; ++n) acc[a][b][m][n] = (f32x4){0.f, 0.f, 0.f, 0.f};
        cur = nxt; cA = nA; cB = nB; ++ui;
        if (wr == 1) PG8_BAR;
    }
    PG8_WAIT_V(0);
    PG8_BAR;
#undef PG8_SA
#undef PG8_SB
#undef PG8_STAGE
#undef PG8_STAGEB
#undef PG8_LDA
#undef PG8_LDB
#undef PG8_MMA
#undef PG8_CAT
#undef PG8_WAIT_V
#undef PG8_WAIT_L
#undef PG8_BAR
#undef PG8_SCHED
#undef PG8_STAGEA
#undef PG8_TBLDMA
}

constexpr float HID_SC = 16.f, WDN_SC = 64.f, XN_SC = 8.f, WGU_SC = 128.f;
enum { EP_Z = 0, EP_BF16 = 1, EP_MG1 = 2, EP_MG2 = 3, EP_RES = 4, EP_HID = 5, EP_DOWN = 6, EP_PLE = 7 };
__device__ __forceinline__ float bfl(unsigned w) { return __uint_as_float(w << 16); }
__device__ __forceinline__ float bfh(unsigned w) { return __uint_as_float(w & 0xffff0000u); }
__device__ __forceinline__ float sigm(float v) { return __builtin_amdgcn_rcpf(1.f + __expf(-v)); }
template <int MODE> struct Epi {
    static constexpr bool PERM = !(MODE == EP_RES || MODE == EP_PLE), PERM2 = (MODE == EP_DOWN);
    bf16_t* O; int ldc;
    const bf16_t* aux; int ldaux;
    const float* fin; float* fout; const float* fin2; bf16_t* O2;
    __device__ __forceinline__ void operator()(const f32x4 (&acc)[2][2][4][2], const Unit& u, int wr, int wc, int fr, int fq) const {
        const int row0 = u.pm * BM + wr * 64 + fr;
        if constexpr (MODE == EP_RES) {
            const int col0 = u.pn * BM + wc * 32 + 4 * fq;
            f32x4 xc[4], xn[4];
#pragma unroll
            for (int q = 0; q < 4; ++q) xc[q] = *(const f32x4*)(fin + (size_t)row0 * D_ + col0 + (q >> 1) * HALF + (q & 1) * 16);
#pragma unroll
            for (int g = 0; g < 8; ++g) { const size_t r = (size_t)(row0 + (g >> 2) * HALF + (g & 3) * 16);
                if (g < 7) { const size_t r1 = (size_t)(row0 + ((g + 1) >> 2) * HALF + ((g + 1) & 3) * 16);
#pragma unroll
                    for (int q = 0; q < 4; ++q) xn[q] = *(const f32x4*)(fin + r1 * D_ + col0 + (q >> 1) * HALF + (q & 1) * 16); }
                asm volatile("" ::: "memory");
#pragma unroll
                for (int q = 0; q < 4; ++q) { const f32x4 o = xc[q] + acc[g >> 2][q >> 1][g & 3][q & 1]; *(f32x4*)(fout + r * D_ + col0 + (q >> 1) * HALF + (q & 1) * 16) = o; }
                asm volatile("" ::: "memory");
#pragma unroll
                for (int q = 0; q < 4; ++q) xc[q] = xn[q]; }
        } else if constexpr (MODE == EP_PLE) {
            const int col0 = u.pn * BM + wc * 32 + 4 * fq;
            constexpr float qs = 1.f / (XN_SC * WGU_SC);
            f32x4 bv[4]; u32x2 pc[4], hc[4], pn_[4], hn[4]; float ic, in_ = 0.f;
#pragma unroll
            for (int q = 0; q < 4; ++q) { const int c = col0 + (q >> 1) * HALF + (q & 1) * 16; bv[q] = *(const f32x4*)(fin + c);
                pc[q] = *(const u32x2*)(aux + (size_t)row0 * ldaux + c); hc[q] = *(const u32x2*)(O + (size_t)row0 * D_ + c); }
            ic = fin2[row0];
#pragma unroll
            for (int g = 0; g < 8; ++g) { const size_t r = (size_t)(row0 + (g >> 2) * HALF + (g & 3) * 16);
                if (g < 7) { const size_t r1 = (size_t)(row0 + ((g + 1) >> 2) * HALF + ((g + 1) & 3) * 16);
#pragma unroll
                    for (int q = 0; q < 4; ++q) { const int c = col0 + (q >> 1) * HALF + (q & 1) * 16; pn_[q] = *(const u32x2*)(aux + r1 * ldaux + c); hn[q] = *(const u32x2*)(O + r1 * D_ + c); }
                    in_ = fin2[r1]; }
                asm volatile("" ::: "memory");
#pragma unroll
                for (int q = 0; q < 4; ++q) { const int c = col0 + (q >> 1) * HALF + (q & 1) * 16; const f32x4 a = acc[g >> 2][q >> 1][g & 3][q & 1]; const u32x2 pw = pc[q], hw = hc[q]; f32x4 o;
                    o[0] = bfl(hw.x) * ic + sigm(a[0] * qs + bv[q][0]) * bfl(pw.x); o[1] = bfh(hw.x) * ic + sigm(a[1] * qs + bv[q][1]) * bfh(pw.x);
                    o[2] = bfl(hw.y) * ic + sigm(a[2] * qs + bv[q][2]) * bfl(pw.y); o[3] = bfh(hw.y) * ic + sigm(a[3] * qs + bv[q][3]) * bfh(pw.y);
                    *(f32x4*)(fout + r * D_ + c) = o; }
                asm volatile("" ::: "memory");
#pragma unroll
                for (int q = 0; q < 4; ++q) { pc[q] = pn_[q]; hc[q] = hn[q]; }
                ic = in_; }
        } else if constexpr (MODE == EP_DOWN) {
            unsigned char* Y8 = (unsigned char*)O; const int col0 = u.pn * BM + wc * 64 + 16 * fq;
#pragma unroll
            for (int ai = 0; ai < 2; ++ai)
#pragma unroll
                for (int m = 0; m < 4; ++m) { const size_t r = (size_t)(row0 + ai * HALF + m * 16); u32x4 w;
#pragma unroll
                    for (int bj = 0; bj < 2; ++bj)
#pragma unroll
                        for (int n = 0; n < 2; ++n) { f32x4 a = acc[ai][bj][m][n] * (16.f / (HID_SC * WDN_SC)); int d = 0;
#pragma unroll
                            for (int j = 0; j < 4; ++j) a[j] = __builtin_amdgcn_fmed3f(a[j], -448.f, 448.f);
                            d = __builtin_amdgcn_cvt_pk_fp8_f32(a[0], a[1], d, false); d = __builtin_amdgcn_cvt_pk_fp8_f32(a[2], a[3], d, true); w[2 * bj + n] = (unsigned)d; }
                    *(u32x4*)(Y8 + r * 1024 + col0) = w; }
        } else if constexpr (MODE == EP_HID) {
            const int col0 = u.pn * HALF + wc * 32 + 8 * fq;
#pragma unroll
            for (int ai = 0; ai < 2; ++ai)
#pragma unroll
                for (int m = 0; m < 4; ++m) { const size_t r = (size_t)(row0 + ai * HALF + m * 16); const float w = fin[r]; constexpr float rs = 1.f / (XN_SC * WGU_SC);
                    const f32x4 g0 = acc[ai][0][m][0] * rs, g1 = acc[ai][0][m][1] * rs, u0 = acc[ai][1][m][0] * rs, u1 = acc[ai][1][m][1] * rs;
                    float h[8];
#pragma unroll
                    for (int j = 0; j < 4; ++j) { h[j] = g0[j] * sigm(g0[j]) * u0[j] * w; h[4 + j] = g1[j] * sigm(g1[j]) * u1[j] * w; }
#pragma unroll
                    for (int j = 0; j < 8; ++j) h[j] = __builtin_amdgcn_fmed3f(h[j] * HID_SC, -448.f, 448.f);
                    int d0 = 0, d1 = 0;
                    d0 = __builtin_amdgcn_cvt_pk_fp8_f32(h[0], h[1], d0, false); d0 = __builtin_amdgcn_cvt_pk_fp8_f32(h[2], h[3], d0, true);
                    d1 = __builtin_amdgcn_cvt_pk_fp8_f32(h[4], h[5], d1, false); d1 = __builtin_amdgcn_cvt_pk_fp8_f32(h[6], h[7], d1, true);
                    *(u32x2*)((unsigned char*)O + r * ldc + col0) = (u32x2){(unsigned)d0, (unsigned)d1}; }
        } else if constexpr (MODE == EP_MG1 || MODE == EP_MG2) {
            const int col0 = u.pn * BM + wc * 32 + 8 * fq;
            u32x4 gc[2], gn[2], oc[2], on[2];
#pragma unroll
            for (int bj = 0; bj < 2; ++bj) { gc[bj] = *(const u32x4*)(aux + (size_t)row0 * ldaux + col0 + bj * HALF); if constexpr (MODE == EP_MG2) oc[bj] = *(const u32x4*)(O + (size_t)row0 * ldc + col0 + bj * HALF); }
#pragma unroll
            for (int g = 0; g < 8; ++g) { const size_t r = (size_t)(row0 + (g >> 2) * HALF + (g & 3) * 16);
                if (g < 7) { const size_t r1 = (size_t)(row0 + ((g + 1) >> 2) * HALF + ((g + 1) & 3) * 16);
#pragma unroll
                    for (int bj = 0; bj < 2; ++bj) { gn[bj] = *(const u32x4*)(aux + r1 * ldaux + col0 + bj * HALF); if constexpr (MODE == EP_MG2) on[bj] = *(const u32x4*)(O + r1 * ldc + col0 + bj * HALF); } }
                asm volatile("" ::: "memory");
#pragma unroll
                for (int bj = 0; bj < 2; ++bj) { const int c = col0 + bj * HALF; f32x4 v0 = acc[g >> 2][bj][g & 3][0], v1 = acc[g >> 2][bj][g & 3][1]; const u32x4 gw = gc[bj];
                    v0[0] *= bfl(gw.x); v0[1] *= bfh(gw.x); v0[2] *= bfl(gw.y); v0[3] *= bfh(gw.y); v1[0] *= bfl(gw.z); v1[1] *= bfh(gw.z); v1[2] *= bfl(gw.w); v1[3] *= bfh(gw.w);
                    if constexpr (MODE == EP_MG2) { const u32x4 ow = oc[bj];
                        v0[0] += bfl(ow.x); v0[1] += bfh(ow.x); v0[2] += bfl(ow.y); v0[3] += bfh(ow.y); v1[0] += bfl(ow.z); v1[1] += bfh(ow.z); v1[2] += bfl(ow.w); v1[3] += bfh(ow.w); }
                    u32x4 w; w.x = cvt_pk_bf16(v0[0], v0[1]); w.y = cvt_pk_bf16(v0[2], v0[3]); w.z = cvt_pk_bf16(v1[0], v1[1]); w.w = cvt_pk_bf16(v1[2], v1[3]);
                    *(u32x4*)(O + r * ldc + c) = w; }
                asm volatile("" ::: "memory");
#pragma unroll
                for (int bj = 0; bj < 2; ++bj) { gc[bj] = gn[bj]; if constexpr (MODE == EP_MG2) oc[bj] = on[bj]; } }
        } else {
            const int col0 = u.pn * BM + wc * 32 + 8 * fq;
            const bool act = (MODE == EP_Z) && (u.pn >= ZGA / BM);
#pragma unroll
            for (int ai = 0; ai < 2; ++ai)
#pragma unroll
                for (int m = 0; m < 4; ++m) { const size_t r = (size_t)(row0 + ai * HALF + m * 16);
#pragma unroll
                    for (int bj = 0; bj < 2; ++bj) { const int c = col0 + bj * HALF; f32x4 v0 = acc[ai][bj][m][0], v1 = acc[ai][bj][m][1];
                        if constexpr (MODE == EP_Z) { if (act) { const f32x4 b0 = *(const f32x4*)(fin + c - ZGA), b1 = *(const f32x4*)(fin + c - ZGA + 4);
#pragma unroll
                            for (int j = 0; j < 4; ++j) { v0[j] = sigm(v0[j] + b0[j]); v1[j] = sigm(v1[j] + b1[j]); } } }
                        if constexpr (MODE == EP_MG1 || MODE == EP_MG2) { const u32x4 gw = *(const u32x4*)(aux + r * ldaux + c);
                            v0[0] *= bfl(gw.x); v0[1] *= bfh(gw.x); v0[2] *= bfl(gw.y); v0[3] *= bfh(gw.y); v1[0] *= bfl(gw.z); v1[1] *= bfh(gw.z); v1[2] *= bfl(gw.w); v1[3] *= bfh(gw.w); }
                        if constexpr (MODE == EP_MG2) { const u32x4 ow = *(const u32x4*)(O + r * ldc + c);
                            v0[0] += bfl(ow.x); v0[1] += bfh(ow.x); v0[2] += bfl(ow.y); v0[3] += bfh(ow.y); v1[0] += bfl(ow.z); v1[1] += bfh(ow.z); v1[2] += bfl(ow.w); v1[3] += bfh(ow.w); }
                        { u32x4 w; w.x = cvt_pk_bf16(v0[0], v0[1]); w.y = cvt_pk_bf16(v0[2], v0[3]); w.z = cvt_pk_bf16(v1[0], v1[1]); w.w = cvt_pk_bf16(v1[2], v1[3]);
                            *(u32x4*)(O + r * ldc + c) = w; } }
                    if constexpr (MODE == EP_MG1 || MODE == EP_MG2) asm volatile("" ::: "memory"); }
        }
    }
};
}

__device__ __forceinline__ unsigned pk2(float lo, float hi) { return (unsigned)f2bf(lo) | ((unsigned)f2bf(hi) << 16); }
__device__ __forceinline__ int zdst(int c) {
    if (c < 384) return c;
    if (c < 640) return ZCKV + (c - 384);
    if (c < 672) return ZKR + (c - 640);
    if (c < 1184) return ZQS + (c - 672);
    if (c < 1312) return ZKS + (c - 1184);
    if (c < 1440) return ZVS + (c - 1312);
    if (c < 2464) return ZGA + (c - 1440);
    return ZGB + (c - 2464);
}
__device__ __forceinline__ int gudst(int j) { const int half = j >> 8, jj = j & 255; return ((jj >> 7) << 8) + (half << 7) + (jj & 127); }
struct ConvJob { const float* src; const float* gp; bf16_t* dst; int K, N; float sc; };
template <int K, int N, int MAP>
__device__ __forceinline__ ConvJob conv_mk(const float* W, const float* g, bf16_t* WT, int item) {
    constexpr int nblk = N / 32; const int kb = item / nblk, nb = item % nblk, k0 = 64 * kb, n0 = 32 * nb;
    const int d0 = (MAP == 1) ? zdst(n0) : (MAP == 2) ? gudst(n0) : n0;
    return ConvJob{W + (size_t)k0 * N + n0, g ? g + k0 : nullptr, WT + (size_t)d0 * K + k0, K, N, 0.f};
}
template <int K, int N, int MAP>
__device__ __forceinline__ ConvJob conv_mk8(const float* W, const float* g, unsigned char* WT, int item, float sc) {
    constexpr int nblk = N / 32; const int kb = item / nblk, nb = item % nblk, k0 = 64 * kb, n0 = 32 * nb;
    const int d0 = (MAP == 2) ? gudst(n0) : n0;
    return ConvJob{W + (size_t)k0 * N + n0, g ? g + k0 : nullptr, (bf16_t*)(WT + (size_t)d0 * K + k0), K, N, sc};
}
__device__ __forceinline__ void conv_load(const ConvJob& j, int lane, f32x4_t (&v)[8]) {
    const int kq = lane >> 3, n4 = (lane & 7) * 4; const float* sp = j.src + (size_t)kq * j.N + n4;
#pragma unroll
    for (int i = 0; i < 8; ++i) v[i] = *(const f32x4_t*)(sp + (size_t)(8 * i) * j.N);
}
__device__ __forceinline__ void conv_finish(const ConvJob& j, int lane, const f32x4_t (&v)[8], LAS float* scr) {
    const int kq = lane >> 3, n4 = (lane & 7) * 4;
    const bool f8 = j.sc > 0.f; const float scl = f8 ? j.sc : 1.f;
#pragma unroll
    for (int i = 0; i < 8; ++i) { const int kk = kq + 8 * i; const float gg = (j.gp ? j.gp[kk] : 1.f) * scl; LAS float* d = scr + kk * 33 + n4;
        d[0] = v[i].x * gg; d[1] = v[i].y * gg; d[2] = v[i].z * gg; d[3] = v[i].w * gg; }
    asm volatile("s_waitcnt lgkmcnt(0)" ::: "memory");
    const int c = lane & 7;
    if (f8) {
#pragma unroll
        for (int q = 0; q < 4; ++q) { const int n = (lane >> 3) + 8 * q; const LAS float* sp = scr + (8 * c) * 33 + n; float t[8];
#pragma unroll
            for (int i = 0; i < 8; ++i) t[i] = __builtin_amdgcn_fmed3f(sp[i * 33], -448.f, 448.f);
            int d0 = 0, d1 = 0;
            d0 = __builtin_amdgcn_cvt_pk_fp8_f32(t[0], t[1], d0, false); d0 = __builtin_amdgcn_cvt_pk_fp8_f32(t[2], t[3], d0, true);
            d1 = __builtin_amdgcn_cvt_pk_fp8_f32(t[4], t[5], d1, false); d1 = __builtin_amdgcn_cvt_pk_fp8_f32(t[6], t[7], d1, true);
            *(pg8::u32x2*)((unsigned char*)j.dst + (size_t)n * j.K + 8 * c) = (pg8::u32x2){(unsigned)d0, (unsigned)d1}; }
    } else {
#pragma unroll
        for (int q = 0; q < 4; ++q) { const int n = (lane >> 3) + 8 * q; const LAS float* sp = scr + (8 * c) * 33 + n;
            pg8::u32x4 o; o.x = pk2(sp[0 * 33], sp[1 * 33]); o.y = pk2(sp[2 * 33], sp[3 * 33]); o.z = pk2(sp[4 * 33], sp[5 * 33]); o.w = pk2(sp[6 * 33], sp[7 * 33]);
            *(pg8::u32x4*)(j.dst + (size_t)n * j.K + 8 * c) = o; }
    }
    asm volatile("s_waitcnt lgkmcnt(0)" ::: "memory");
}
__device__ __forceinline__ ConvJob conv_job(const P& p, int it) {
    constexpr int I0 = 16 * 109, I1 = 6 * 24, I2 = 4 * 32, I3 = 8 * 32, I4 = 8 * 32, I5 = 16 * 32, I6 = 16 * 32, I7 = 4 * 32, I8 = 16 * 16, I9 = 4 * 32, IGU = 16 * 16, IDN = 4 * 32;
    int r = it;
    if (r < I0) return conv_mk<1024, INW, 1>(p.w_in, p.g_mix, WSP(bf16_t, WS_WIN), r); r -= I0;
    if (r < I1) return conv_mk<384, 768, 0>(p.w_uq, p.g_cq, WSP(bf16_t, WS_WUQ), r); r -= I1;
    if (r < I2) return conv_mk<256, 1024, 0>(p.w_ukv, p.g_ckv, WSP(bf16_t, WS_WUKV), r); r -= I2;
    if (r < I7) return conv_mk<256, 1024, 0>(p.w_ple_proj, nullptr, WSP(bf16_t, WS_WPP), r); r -= I7;
    if (r < I3) return conv_mk<512, 1024, 0>(p.w_br_mla, nullptr, WSP(bf16_t, WS_WBRM), r); r -= I3;
    if (r < I4) return conv_mk<512, 1024, 0>(p.w_br_swa, nullptr, WSP(bf16_t, WS_WBRS), r); r -= I4;
    if (r < I5) return conv_mk<1024, 1024, 0>(p.w_out, nullptr, WSP(bf16_t, WS_WOUT), r); r -= I5;
    if (r < I6) return conv_mk8<1024, 1024, 0>(p.w_ple_gate, p.g_ple, WSP(unsigned char, WS_WPG), r, pg8::WGU_SC); r -= I6;
    if (r < I8) return conv_mk8<1024, 512, 2>(p.w_sh_gu, p.g_moe, WSP(unsigned char, WS_WGU) + (size_t)NE * 512 * 1024, r, pg8::WGU_SC); r -= I8;
    if (r < I9) return conv_mk8<256, 1024, 0>(p.w_sh_down, nullptr, WSP(unsigned char, WS_WDN) + (size_t)NE * 1024 * 256, r, pg8::WDN_SC); r -= I9;
    if (r < 64 * IGU) { const int e = r / IGU; return conv_mk8<1024, 512, 2>(p.w_exp_gu + (size_t)e * 1024 * 512, p.g_moe, WSP(unsigned char, WS_WGU) + (size_t)e * 512 * 1024, r % IGU, pg8::WGU_SC); } r -= 64 * IGU;
    { const int e = r / IDN; return conv_mk8<256, 1024, 0>(p.w_exp_down + (size_t)e * 256 * 1024, nullptr, WSP(unsigned char, WS_WDN) + (size_t)e * 1024 * 256, r % IDN, pg8::WDN_SC); }
}
constexpr int CONV_EARLY = 16 * 109 + 6 * 24 + 4 * 32 + 4 * 32;
constexpr int CONV_NITEMS = 16 * 109 + 6 * 24 + 4 * 32 + 8 * 32 + 8 * 32 + 16 * 32 + 16 * 32 + 4 * 32 + 16 * 16 + 4 * 32 + 64 * 256 + 64 * 128;
__device__ __forceinline__ void st_wconv(const P& p, int gw, int ngw, int lane, LAS float* scr) {
    constexpr int NITEMS = CONV_EARLY;
    if (gw < NITEMS) {
        ConvJob cur = conv_job(p, gw); f32x4_t v[8], w[8]; conv_load(cur, lane, v);
        for (int it = gw; it < NITEMS; it += ngw) {
            const bool more = it + ngw < NITEMS; ConvJob nx = cur;
            if (more) { nx = conv_job(p, it + ngw); conv_load(nx, lane, w); }
            conv_finish(cur, lane, v, scr);
            if (more) { cur = nx;
#pragma unroll
                for (int i = 0; i < 8; ++i) v[i] = w[i]; }
        }
    }
    { unsigned* zp = (unsigned*)(WSP(bf16_t, WS_WIN) + (size_t)416 * 1024); const int n = 96 * 1024 / 2;
      for (int i = gw * 64 + lane; i < n; i += ngw * 64) zp[i] = 0u; }
}
__device__ __forceinline__ void fs_g1(const P& p, LAS unsigned char* lds, const int wv) {
    pg8::DenseSched S; S.init(WSP(bf16_t, WS_HB), D_, WSP(bf16_t, WS_WIN), D_, M_, NZ, gridDim.x, blockIdx.x);
    pg8::Epi<pg8::EP_Z> E{WSP(bf16_t, WS_Z), NZ, nullptr, 0, p.b_gate, nullptr};
    pg8::gemm_phase<pg8::Epi<pg8::EP_Z>, pg8::DenseSched, false>(lds, wv, D_, D_, D_, S, E);
}

struct MoeSched {
    const char* A; const char* Bt; size_t astep, bstep, estep; const LAS int* tile_e; const int* ltok; int T, NPN, nwg, G, c; bool gather;
    __device__ __forceinline__ void init(const void* A_, int lda, const void* Bt_, int ldb, int ncols_e, const LAS int* tile_e_, const int* ltok_, int T_, bool gather_, int G_, int c_) {
        A = (const char*)A_; Bt = (const char*)Bt_; astep = (size_t)256 * lda * 2; bstep = (size_t)256 * ldb * 2; estep = (size_t)ncols_e * ldb * 2; tile_e = tile_e_; ltok = ltok_;
        T = T_; NPN = ncols_e / 256; nwg = (T + M_ / 256) * NPN; G = G_; c = c_; gather = gather_; }
    __device__ __forceinline__ bool next(int i, pg8::Unit& u) const {
        const int L = i * G + c; if (L >= nwg) return false;
        int wgid = L; { const int q = nwg / 8, r = nwg % 8, xcd = wgid % 8, off = wgid / 8; wgid = (xcd < r ? xcd * (q + 1) : r * (q + 1) + (xcd - r) * q) + off; }
        const int j = wgid / NPN; u.pn = wgid % NPN;
        int e; if (j < T) { u.pm = j; e = __builtin_amdgcn_readfirstlane(tile_e[j]); } else { u.pm = NSLOT / 256 + (j - T); e = NE; }
        u.Ab = gather ? A : A + (size_t)u.pm * astep; u.Bb = Bt + (size_t)e * estep + (size_t)u.pn * bstep; u.aux = e; return true;
    }
    __device__ __forceinline__ int row(const pg8::Unit& u, int r) const { return ltok[u.pm * 256 + r]; }
    __device__ __forceinline__ const int* rowtab(const pg8::Unit& u) const { return ltok + u.pm * 256; }
};
constexpr size_t WS_TILEE = 5 * MiB;
constexpr int NT = 512;
constexpr int TILEE_LDS = 136 * 1024;
__device__ __forceinline__ void fs_g23(const P& p, LAS unsigned char* lds, const int wv) {
    { pg8::DenseSched S; S.init(WSP(bf16_t, WS_Z) + ZQ, NZ, WSP(bf16_t, WS_WUQ), 384, M_, 768, gridDim.x, blockIdx.x);
      pg8::Epi<pg8::EP_BF16> E{WSP(bf16_t, WS_QMR), 768, nullptr, 0, nullptr, nullptr};
      pg8::gemm_phase<pg8::Epi<pg8::EP_BF16>, pg8::DenseSched, false>(lds, wv, 384, NZ, 384, S, E); }
    { pg8::DenseSched S; S.init(WSP(bf16_t, WS_Z) + ZCKV, NZ, WSP(bf16_t, WS_WUKV), 256, M_, 1024, gridDim.x, blockIdx.x);
      pg8::Epi<pg8::EP_BF16> E{WSP(bf16_t, WS_KVR), 1024, nullptr, 0, nullptr, nullptr};
      pg8::gemm_phase<pg8::Epi<pg8::EP_BF16>, pg8::DenseSched, false>(lds, wv, 256, NZ, 256, S, E); }
}
__device__ __forceinline__ void fs_merge(const P& p, LAS unsigned char* lds, const int wv) {
    { pg8::DenseSched S; S.init(WSP(bf16_t, WS_OM), 512, WSP(bf16_t, WS_WBRM), 512, M_, D_, gridDim.x, blockIdx.x);
      pg8::Epi<pg8::EP_MG1> E{WSP(bf16_t, WS_MG), D_, WSP(bf16_t, WS_Z) + ZGA, NZ, nullptr, nullptr};
      pg8::gemm_phase<pg8::Epi<pg8::EP_MG1>, pg8::DenseSched, false>(lds, wv, 512, 512, 512, S, E); }
    { pg8::DenseSched S; S.init(WSP(bf16_t, WS_OW), 512, WSP(bf16_t, WS_WBRS), 512, M_, D_, gridDim.x, blockIdx.x);
      pg8::Epi<pg8::EP_MG2> E{WSP(bf16_t, WS_MG), D_, WSP(bf16_t, WS_Z) + ZGB, NZ, nullptr, nullptr};
      pg8::gemm_phase<pg8::Epi<pg8::EP_MG2>, pg8::DenseSched, false>(lds, wv, 512, 512, 512, S, E); }
}
__device__ __forceinline__ void fs_out(const P& p, LAS unsigned char* lds, const int wv) {
    pg8::DenseSched S; S.init(WSP(bf16_t, WS_MG), D_, WSP(bf16_t, WS_WOUT), D_, M_, D_, gridDim.x, blockIdx.x);
    pg8::Epi<pg8::EP_RES> E{nullptr, 0, nullptr, 0, p.x, p.out, nullptr, nullptr};
    pg8::gemm_phase<pg8::Epi<pg8::EP_RES>, pg8::DenseSched, false>(lds, wv, D_, D_, D_, S, E);
}
__device__ __forceinline__ void fs_gu(const P& p, LAS unsigned char* lds, const int wv) {
    const int T = __builtin_amdgcn_readfirstlane((int)(WSP(unsigned, WS_CTL)[CW_BASE + NE] / 256u));
    LAS int* te = (LAS int*)(lds + TILEE_LDS);
    for (int i = tid_of(wv); i < NSLOT / 256; i += NT) te[i] = WSP(int, WS_TILEE)[i];
    __syncthreads();
    MoeSched S; S.init(WSP(bf16_t, WS_H2), D_ / 2, WSP(bf16_t, WS_WGU), D_ / 2, 512, te, WSP(int, WS_LTOK), T, true, gridDim.x, blockIdx.x);
    pg8::Epi<pg8::EP_HID> E{WSP(bf16_t, WS_HID), EFF, nullptr, 0, WSP(float, WS_LW), nullptr, WSP(float, WS_LR), nullptr};
    pg8::gemm_phase<pg8::Epi<pg8::EP_HID>, MoeSched, true, true>(lds, wv, D_ / 2, D_ / 2, D_ / 2, S, E);
}
__device__ __forceinline__ void fs_down(const P& p, LAS unsigned char* lds, const int wv) {
    const int T = __builtin_amdgcn_readfirstlane((int)(WSP(unsigned, WS_CTL)[CW_BASE + NE] / 256u));
    LAS int* te = (LAS int*)(lds + TILEE_LDS);
    for (int i = tid_of(wv); i < NSLOT / 256; i += NT) te[i] = WSP(int, WS_TILEE)[i];
    __syncthreads();
    MoeSched S; S.init(WSP(bf16_t, WS_HID), EFF / 2, WSP(bf16_t, WS_WDN), EFF / 2, 1024, te, WSP(int, WS_LTOK), T, false, gridDim.x, blockIdx.x);
    pg8::Epi<pg8::EP_DOWN> E{WSP(bf16_t, WS_Y), D_, nullptr, 0, nullptr, p.out};
    pg8::gemm_phase<pg8::Epi<pg8::EP_DOWN>, MoeSched, false, true>(lds, wv, EFF / 2, EFF / 2, EFF / 2, S, E);
}
__device__ __forceinline__ void fs_pp(const P& p, LAS unsigned char* lds, const int wv) {
    const int G = (int)gridDim.x, half = G / 2, c = (int)blockIdx.x - half;
    if (c < 0) return;
    pg8::DenseSched S; S.init(WSP(bf16_t, WS_PB), 256, WSP(bf16_t, WS_WPP), 256, M_, D_, G - half, c);
    pg8::Epi<pg8::EP_BF16> E{WSP(bf16_t, WS_PP), D_, nullptr, 0, nullptr, nullptr};
    pg8::gemm_phase<pg8::Epi<pg8::EP_BF16>, pg8::DenseSched, false>(lds, wv, 256, 256, 256, S, E);
}
__device__ __forceinline__ void fs_ple(const P& p, LAS unsigned char* lds, const int wv) {
    pg8::DenseSched S; S.init(WSP(bf16_t, WS_H3F8), D_ / 2, WSP(bf16_t, WS_WPG), D_ / 2, M_, D_, gridDim.x, blockIdx.x);
    pg8::Epi<pg8::EP_PLE> E{WSP(bf16_t, WS_H3), D_, WSP(bf16_t, WS_PP), D_, p.b_ple, p.out, WSP(float, WS_INV3), nullptr};
    pg8::gemm_phase<pg8::Epi<pg8::EP_PLE>, pg8::DenseSched, false, true>(lds, wv, D_ / 2, D_ / 2, D_ / 2, S, E);
}
namespace fa {
typedef short bf16x8 __attribute__((ext_vector_type(8)));
typedef short s16x4 __attribute__((ext_vector_type(4)));
typedef float f32x16 __attribute__((ext_vector_type(16)));
typedef unsigned u32x4 __attribute__((ext_vector_type(4)));
typedef unsigned u32x2 __attribute__((ext_vector_type(2)));
__device__ __forceinline__ unsigned cvtpk(float lo, float hi) { unsigned r; asm volatile("v_cvt_pk_bf16_f32 %0, %1, %2" : "=v"(r) : "v"(lo), "v"(hi)); return r; }
__device__ __forceinline__ int crow(int r, int hi) { return (r & 3) + 8 * (r >> 2) + 4 * hi; }

struct BgConv { int item, step, ngw; bool loaded; ConvJob job; f32x4_t v[8]; };
__device__ __forceinline__ void conv_finish_(const ConvJob& j, int lane, const f32x4_t (&v)[8], LAS float* scr) { conv_finish(j, lane, v, scr); }
__device__ __forceinline__ void bg_tick(const P& p, BgConv& g, int lane, LAS float* scr) {
    if (g.loaded) { conv_finish(g.job, lane, g.v, scr); g.loaded = false; g.item += g.ngw; }
    else if (g.item < CONV_NITEMS && (g.step & 3) == 0) { g.job = conv_job(p, g.item); conv_load(g.job, lane, g.v); g.loaded = true; }
    ++g.step;
}
template <int DK, bool SWA>
__device__ __forceinline__ void attn_unit(const P& p, LAS unsigned char* lds, const int wv, const int b, const int h, const int qb, const float gmax, BgConv& bg) {
    constexpr int PK = DK * 2 + 16, PV = 136, KBYTES = 64 * PK, BUF = KBYTES + 64 * PV, KS = DK / 16, CPR = DK / 8;
    int tid = tid_of(wv); asm volatile("" : "+v"(tid));
    const int lane = tid & 63, wave = wv, r32 = lane & 31, hi = lane >> 5;
    const int q0w = qb * 256 + wave * 32;
    const bf16_t* Qg = (SWA ? WSP(bf16_t, WS_QS) : WSP(bf16_t, WS_QM)) + ((size_t)(b * 8 + h) * S_ + q0w + r32) * DK;
    const int kvh = SWA ? (b * 2 + h / 4) : (b * 8 + h);
    const bf16_t* Kg = (SWA ? WSP(bf16_t, WS_KS) : WSP(bf16_t, WS_KM)) + (size_t)kvh * S_ * DK;
    const bf16_t* Vg = (SWA ? WSP(bf16_t, WS_VTS) : WSP(bf16_t, WS_VTM)) + (size_t)kvh * 64 * S_;
    bf16x8 qf[KS];
#pragma unroll
    for (int s = 0; s < KS; ++s) qf[s] = *(const bf16x8*)(Qg + 16 * s + 8 * hi);
    int t0 = 0, t1 = S_ / 64;
    if (SWA) { const int kmin = max(0, qb * 256 - 128), kmax = min(S_ - 1, qb * 256 + 255 + 128); t0 = kmin / 64; t1 = kmax / 64 + 1; }
    const int wk0 = q0w - 128, wk1 = q0w + 31 + 128;
    const int qpos = q0w + r32;
    const int kc0 = tid, kc1 = 512 + tid;
    const bool k1on = (64 * CPR > 512) && (tid < 64 * CPR - 512);
    const unsigned kd0 = (unsigned)((kc0 / CPR) * PK + (kc0 % CPR) * 16), kd1 = (unsigned)((kc1 / CPR) * PK + (kc1 % CPR) * 16);
    const int vd = tid >> 3, vp = tid & 7;
    const unsigned vdst = (unsigned)(KBYTES + vd * PV + vp * 16);
    u32x4 ak0, ak1 = {0u, 0u, 0u, 0u}, av, bk0, bk1 = {0u, 0u, 0u, 0u}, bv;
#define FA_LOAD(K0, K1, V, t) do { const int k0_ = (t) * 64; K0 = *(const u32x4*)(Kg + (size_t)k0_ * DK + kc0 * 8); if (k1on) K1 = *(const u32x4*)(Kg + (size_t)k0_ * DK + kc1 * 8); \
        V = *(const u32x4*)(Vg + (size_t)vd * S_ + k0_ + vp * 8); } while (0)
#define FA_WRITE(K0, K1, V, bufo) do { *(LAS u32x4*)(lds + (bufo) + kd0) = K0; if (k1on) *(LAS u32x4*)(lds + (bufo) + kd1) = K1; \
        *(LAS u32x2*)(lds + (bufo) + vdst) = (u32x2){V.x, V.y}; *(LAS u32x2*)(lds + (bufo) + vdst + 8) = (u32x2){V.z, V.w}; } while (0)
    float l_run; f32x16 o0, o1; bf16x8 qx;
#pragma unroll
    for (int r = 0; r < 16; ++r) { o0[r] = 0.f; o1[r] = 0.f; }
    { float q2 = 0.f;
#pragma unroll
      for (int s = 0; s < KS; ++s)
#pragma unroll
          for (int j = 0; j < 8; ++j) { const float x = __uint_as_float((unsigned)(unsigned short)qf[s][j] << 16); q2 += x * x; }
      { auto ra = __builtin_amdgcn_permlane32_swap(__float_as_uint(q2), __float_as_uint(q2), false, false); q2 = __uint_as_float(ra[0]) + __uint_as_float(ra[1]); }
      float m = fminf(sqrtf(q2) * 1.01f * gmax * sqrtf((float)DK), 60.f);
      const float sk = SWA ? p.sink[h] * LOG2E : 0.f;
      if (SWA) m = fmaxf(m, fminf(sk, 60.f));
      const bf16_t hm = f2bf(-m);
      l_run = (SWA && hi == 0) ? exp2f(sk + bf2f(hm)) : 0.f;
      qx = (bf16x8){(short)(hi == 0 ? hm : 0), 0, 0, 0, 0, 0, 0, 0}; }
    if (tid < 64) { const u32x4 one = {0x00003F80u, 0u, 0u, 0u}; *(LAS u32x4*)(lds + tid * PK + DK * 2) = one; *(LAS u32x4*)(lds + BUF + tid * PK + DK * 2) = one; }
    FA_LOAD(ak0, ak1, av, t0); FA_WRITE(ak0, ak1, av, 0);
    if (t0 + 1 < t1) FA_LOAD(ak0, ak1, av, t0 + 1);
    __syncthreads();
    auto tile = [&](const int bufo, const int k0) __attribute__((always_inline)) {
        const bool active = !SWA || !(k0 + 63 < wk0 || k0 > wk1);
        if (active) {
            f32x16 s0, s1;
            { const bf16x8 ka = *(const LAS bf16x8*)(lds + bufo + r32 * PK + DK * 2 + 16 * hi);
              const bf16x8 kb = *(const LAS bf16x8*)(lds + bufo + (32 + r32) * PK + DK * 2 + 16 * hi);
              const f32x16 z = {0.f, 0.f, 0.f, 0.f, 0.f, 0.f, 0.f, 0.f, 0.f, 0.f, 0.f, 0.f, 0.f, 0.f, 0.f, 0.f};
              s0 = __builtin_amdgcn_mfma_f32_32x32x16_bf16(ka, qx, z, 0, 0, 0); s1 = __builtin_amdgcn_mfma_f32_32x32x16_bf16(kb, qx, z, 0, 0, 0); }
#pragma unroll
            for (int s = 0; s < KS; ++s) {
                const bf16x8 ka = *(const LAS bf16x8*)(lds + bufo + r32 * PK + 32 * s + 16 * hi);
                const bf16x8 kb = *(const LAS bf16x8*)(lds + bufo + (32 + r32) * PK + 32 * s + 16 * hi);
                s0 = __builtin_amdgcn_mfma_f32_32x32x16_bf16(ka, qf[s], s0, 0, 0, 0);
                s1 = __builtin_amdgcn_mfma_f32_32x32x16_bf16(kb, qf[s], s1, 0, 0, 0);
            }
            if (SWA && (k0 < q0w + 31 - 128 || k0 + 63 > q0w + 128)) {
#pragma unroll
                for (int r = 0; r < 16; ++r) { const int d0 = k0 + crow(r, hi) - qpos, d1 = d0 + 32;
                    if (d0 > 128 || d0 < -128) s0[r] = -1e30f; if (d1 > 128 || d1 < -128) s1[r] = -1e30f; }
            }
            s16x4 va0[4], va1[4], vc0[4], vc1[4];
#pragma unroll
            for (int i = 0; i < 4; ++i) { const unsigned vo = (unsigned)(bufo + KBYTES + r32 * PV + (32 * (i >> 1) + 16 * (i & 1) + 4 * hi) * 2);
                va0[i] = *(const LAS s16x4*)(lds + vo); va1[i] = *(const LAS s16x4*)(lds + vo + 16); vc0[i] = *(const LAS s16x4*)(lds + vo + 32 * PV); vc1[i] = *(const LAS s16x4*)(lds + vo + 32 * PV + 16); }
            __builtin_amdgcn_sched_barrier(0);
            float ls = 0.f;
#pragma unroll
            for (int r = 0; r < 16; ++r) { s0[r] = __builtin_amdgcn_exp2f(s0[r]); s1[r] = __builtin_amdgcn_exp2f(s1[r]); ls += s0[r] + s1[r]; }
            l_run += ls;
#pragma unroll
            for (int i = 0; i < 4; ++i) {
                u32x4 pw;
                if (i < 2) { pw.x = cvtpk(s0[8 * i + 0], s0[8 * i + 1]); pw.y = cvtpk(s0[8 * i + 2], s0[8 * i + 3]); pw.z = cvtpk(s0[8 * i + 4], s0[8 * i + 5]); pw.w = cvtpk(s0[8 * i + 6], s0[8 * i + 7]); }
                else { const int s2 = i - 2; pw.x = cvtpk(s1[8 * s2 + 0], s1[8 * s2 + 1]); pw.y = cvtpk(s1[8 * s2 + 2], s1[8 * s2 + 3]); pw.z = cvtpk(s1[8 * s2 + 4], s1[8 * s2 + 5]); pw.w = cvtpk(s1[8 * s2 + 6], s1[8 * s2 + 7]); }
                const bf16x8 pf = __builtin_bit_cast(bf16x8, pw);
                const bf16x8 va = (bf16x8){va0[i][0], va0[i][1], va0[i][2], va0[i][3], va1[i][0], va1[i][1], va1[i][2], va1[i][3]};
                const bf16x8 vc = (bf16x8){vc0[i][0], vc0[i][1], vc0[i][2], vc0[i][3], vc1[i][0], vc1[i][1], vc1[i][2], vc1[i][3]};
                o0 = __builtin_amdgcn_mfma_f32_32x32x16_bf16(va, pf, o0, 0, 0, 0);
                o1 = __builtin_amdgcn_mfma_f32_32x32x16_bf16(vc, pf, o1, 0, 0, 0);
            }
        }
    };
    LAS float* bgscr = (LAS float*)(lds + 2 * BUF + 1024) + wave * (64 * 33);
    for (int t = t0; t < t1; t += 2) {
        if (t + 2 < t1) FA_LOAD(bk0, bk1, bv, t + 2);
        tile(0, t * 64);
        if (t + 1 < t1) FA_WRITE(ak0, ak1, av, BUF);
        bg_tick(p, bg, lane, bgscr);
        __syncthreads();
        if (t + 1 < t1) {
            if (t + 3 < t1) FA_LOAD(ak0, ak1, av, t + 3);
            tile(BUF, (t + 1) * 64);
            if (t + 2 < t1) FA_WRITE(bk0, bk1, bv, 0);
            bg_tick(p, bg, lane, bgscr);
            __syncthreads();
        }
    }
#undef FA_LOAD
#undef FA_WRITE
    float lt; { auto rl = __builtin_amdgcn_permlane32_swap(__float_as_uint(l_run), __float_as_uint(l_run), false, false); lt = __uint_as_float(rl[0]) + __uint_as_float(rl[1]); } const float il = 1.f / lt;
    bf16_t* Og = (SWA ? WSP(bf16_t, WS_OW) : WSP(bf16_t, WS_OM)) + (size_t)(b * S_ + qpos) * 512 + h * 64;
#pragma unroll
    for (int g = 0; g < 4; ++g) {
        u32x2 w0, w1;
        w0.x = cvtpk(o0[4 * g + 0] * il, o0[4 * g + 1] * il); w0.y = cvtpk(o0[4 * g + 2] * il, o0[4 * g + 3] * il);
        w1.x = cvtpk(o1[4 * g + 0] * il, o1[4 * g + 1] * il); w1.y = cvtpk(o1[4 * g + 2] * il, o1[4 * g + 3] * il);
        *(u32x2*)(Og + 8 * g + 4 * hi) = w0; *(u32x2*)(Og + 32 + 8 * g + 4 * hi) = w1;
    }
}
}
__device__ __forceinline__ void fs_attn(const P& p, LAS unsigned char* lds, const int wv) {
    const int G = gridDim.x, bx = blockIdx.x; const int vcu = (G % 8 == 0) ? (bx % 8) * (G / 8) + bx / 8 : bx;
    float gm, gs;
    { const int l = tid_of(0); float a = (l < 96) ? fabsf(p.g_kn_mla[l]) : 0.f; if (l + 64 < 96) a = fmaxf(a, fabsf(p.g_kn_mla[l + 64])); float c = (l < 64) ? fabsf(p.g_kn_swa[l]) : 0.f;
      a = wave_max(a); c = wave_max(c); gm = __uint_as_float(__builtin_amdgcn_readfirstlane(__float_as_uint(a))); gs = __uint_as_float(__builtin_amdgcn_readfirstlane(__float_as_uint(c))); }
    fa::BgConv bg; bg.item = CONV_EARLY + bx * (NT / 64) + wv; bg.step = 0; bg.ngw = G * (NT / 64); bg.loaded = false;
    for (int U = vcu; U < 512; U += G) { const int bh = U >> 3, qb = U & 7; fa::attn_unit<96, false>(p, lds, wv, bh >> 3, bh & 7, qb, gm, bg); }
    for (int U = vcu; U < 512; U += G) { const int bh = U >> 3, qb = U & 7; fa::attn_unit<64, true>(p, lds, wv, bh >> 3, bh & 7, qb, gs, bg); }
    { const int lane = tid_of(0); LAS float* scr = (LAS float*)(lds + wv * 16384);
      if (bg.loaded) { fa::conv_finish_(bg.job, lane, bg.v, scr); bg.item += bg.ngw; }
      for (; bg.item < CONV_NITEMS; bg.item += bg.ngw) { bg.job = conv_job(p, bg.item); conv_load(bg.job, lane, bg.v); fa::conv_finish_(bg.job, lane, bg.v, scr); } }
}

__device__ __forceinline__ void st_wrconv(const P& p, size_t gt, size_t ngt) {
    bf16_t* wrh = WSP(bf16_t, WS_WRH); bf16_t* wrl = WSP(bf16_t, WS_WRL);
    for (size_t i = gt; i < (size_t)NE * D_; i += ngt) { const int e = (int)(i >> 10), k = (int)(i & 1023);
        const float v = p.g_moe[k] * p.w_router[(size_t)k * NE + e]; const bf16_t h = f2bf(v); wrh[i] = h; wrl[i] = f2bf(v - bf2f(h)); }
}
__device__ __forceinline__ void st_route(const P& p, int wg, int nwg, int wave, int lane, LAS unsigned char* lds, int cnt_off = 0) {
    typedef short bf16x8 __attribute__((ext_vector_type(8))); typedef float f32x16 __attribute__((ext_vector_type(16)));
    const int r32 = lane & 31, hi = lane >> 5;
    LAS float* part = (LAS float*)lds; LAS float* ssq = (LAS float*)(lds + 131072);
    const bf16_t* WRH = WSP(bf16_t, WS_WRH); const bf16_t* WRL = WSP(bf16_t, WS_WRL);
    int* tope = WSP(int, WS_TOPE); float* topw = WSP(float, WS_TOPW); int* topls = WSP(int, WS_TOPLS); float* rstd2 = WSP(float, WS_RSTD2);
    unsigned char* h2f8 = WSP(unsigned char, WS_H2);
    int* wcnt = WSP(int, WS_WCNT) + cnt_off; int* tcnt = WSP(int, WS_TCNT) + (cnt_off ? 16384 : 0);
    LAS int* cntl = (LAS int*)(lds + 131072 + 2048);
    for (int tile = wg; tile < M_ / 64; tile += nwg) {
        f32x16 acc[2][2];
#pragma unroll
        for (int a = 0; a < 2; ++a)
#pragma unroll
            for (int b = 0; b < 2; ++b)
#pragma unroll
                for (int r = 0; r < 16; ++r) acc[a][b][r] = 0.f;
        float sq[2] = {0.f, 0.f};
        const float* xb = p.out + (size_t)(tile * 64 + r32) * D_ + wave * 128 + 8 * hi;
        const bf16_t* whb = WRH + (size_t)r32 * D_ + wave * 128 + 8 * hi; const bf16_t* wlb = WRL + (size_t)r32 * D_ + wave * 128 + 8 * hi;
#pragma unroll 2
        for (int s = 0; s < 8; ++s) {
            bf16x8 xh[2], xl[2], wh[2], wl[2];
#pragma unroll
            for (int tb = 0; tb < 2; ++tb) {
                const float* xp = xb + (size_t)(32 * tb) * D_ + 16 * s; const f32x4_t a = *(const f32x4_t*)xp, b = *(const f32x4_t*)(xp + 4);
                sq[tb] += (a.x * a.x + a.y * a.y) + (a.z * a.z + a.w * a.w) + (b.x * b.x + b.y * b.y) + (b.z * b.z + b.w * b.w);
                u32x4_t h, l;
                h.x = cvtpk_(a.x, a.y); h.y = cvtpk_(a.z, a.w); h.z = cvtpk_(b.x, b.y); h.w = cvtpk_(b.z, b.w);
                l.x = cvtpk_(a.x - bflo(h.x), a.y - bfhi(h.x)); l.y = cvtpk_(a.z - bflo(h.y), a.w - bfhi(h.y));
                l.z = cvtpk_(b.x - bflo(h.z), b.y - bfhi(h.z)); l.w = cvtpk_(b.z - bflo(h.w), b.w - bfhi(h.w));
                xh[tb] = __builtin_bit_cast(bf16x8, h); xl[tb] = __builtin_bit_cast(bf16x8, l);
            }
#pragma unroll
            for (int eb = 0; eb < 2; ++eb) { wh[eb] = *(const bf16x8*)(whb + (size_t)(32 * eb) * D_ + 16 * s); wl[eb] = *(const bf16x8*)(wlb + (size_t)(32 * eb) * D_ + 16 * s); }
#pragma unroll
            for (int tb = 0; tb < 2; ++tb)
#pragma unroll
                for (int eb = 0; eb < 2; ++eb) {
                    acc[tb][eb] = __builtin_amdgcn_mfma_f32_32x32x16_bf16(xh[tb], wh[eb], acc[tb][eb], 0, 0, 0);
                    acc[tb][eb] = __builtin_amdgcn_mfma_f32_32x32x16_bf16(xh[tb], wl[eb], acc[tb][eb], 0, 0, 0);
                    acc[tb][eb] = __builtin_amdgcn_mfma_f32_32x32x16_bf16(xl[tb], wh[eb], acc[tb][eb], 0, 0, 0);
                }
        }
#pragma unroll
        for (int tb = 0; tb < 2; ++tb) {
#pragma unroll
            for (int eb = 0; eb < 2; ++eb)
#pragma unroll
                for (int r = 0; r < 16; ++r) part[(wave * 64 + 32 * tb + (r & 3) + 8 * (r >> 2) + 4 * hi) * 64 + 32 * eb + r32] = acc[tb][eb][r];
            const float st = sq[tb] + __shfl_xor(sq[tb], 32);
            if (hi == 0) ssq[wave * 64 + 32 * tb + r32] = st;
        }
        __syncthreads();
        int cw = 0;
        for (int tt = 0; tt < 8; ++tt) {
            const int tok = wave * 8 + tt, m = tile * 64 + tok;
            const float* xr = p.out + (size_t)m * D_ + lane * 16;
            const f32x4_t x0 = *(const f32x4_t*)xr, x1v = *(const f32x4_t*)(xr + 4), x2v = *(const f32x4_t*)(xr + 8), x3v = *(const f32x4_t*)(xr + 12);
            float lg = 0.f, ss = 0.f;
#pragma unroll
            for (int w = 0; w < 8; ++w) { lg += part[(w * 64 + tok) * 64 + lane]; ss += ssq[w * 64 + tok]; }
            const float rstd = 1.f / sqrtf(ss * (1.f / D_) + EPS);
            const float score = sigmoidf_(lg * rstd); const float sel = score + p.router_bias[lane];
            float m1 = sel;
            m1 = fmaxf(m1, __shfl_xor(m1, 1)); m1 = fmaxf(m1, __shfl_xor(m1, 2)); m1 = fmaxf(m1, __shfl_xor(m1, 4));
            const unsigned long long eqm = __ballot(sel == m1);
            const int g = lane >> 3; const unsigned gm = (unsigned)((eqm >> (g * 8)) & 0xffull);
            const int first = __ffs((int)gm) - 1;
            float v2 = ((lane & 7) == first) ? -3.0e38f : sel;
            v2 = fmaxf(v2, __shfl_xor(v2, 1)); v2 = fmaxf(v2, __shfl_xor(v2, 2)); v2 = fmaxf(v2, __shfl_xor(v2, 4));
            const float gs = m1 + v2;
            int grank = 0;
#pragma unroll
            for (int j = 0; j < 8; ++j) { const float o = __shfl(gs, j * 8); grank += (o > gs || (o == gs && j < g)) ? 1 : 0; }
            const float msel = (grank < 4) ? sel : -1e30f;
            int rank = 0;
#pragma unroll
            for (int j = 0; j < 64; ++j) { const float o = __uint_as_float((unsigned)__builtin_amdgcn_readlane((int)__float_as_uint(msel), j)); rank += (o > msel) ? 1 : 0; }
            { const bool ch = rank < TOPK; const int nch = __builtin_popcountll(__ballot(ch)); const float sr = wave_sum_dpp(ch ? (float)rank : 0.f);
              if (nch != TOPK || sr != 28.f) { rank = 0;
                  for (int j = 0; j < 64; ++j) { const float o = __uint_as_float((unsigned)__builtin_amdgcn_readlane((int)__float_as_uint(msel), j)); rank += (o > msel || (o == msel && j < lane)) ? 1 : 0; } } }
            const bool chosen = rank < TOPK;
            const float wsum = wave_sum(chosen ? score : 0.f);
            if (chosen) { tope[m * TOPK + rank] = lane; topw[m * TOPK + rank] = score / wsum * 2.5f; topls[m * TOPK + rank] = cw; ++cw; }
            if (lane == 0) rstd2[m] = rstd;
            { const float q = rstd * pg8::XN_SC; u32x4_t w; int d;
              d = 0; d = __builtin_amdgcn_cvt_pk_fp8_f32(x0.x * q, x0.y * q, d, false); d = __builtin_amdgcn_cvt_pk_fp8_f32(x0.z * q, x0.w * q, d, true); w.x = (unsigned)d;
              d = 0; d = __builtin_amdgcn_cvt_pk_fp8_f32(x1v.x * q, x1v.y * q, d, false); d = __builtin_amdgcn_cvt_pk_fp8_f32(x1v.z * q, x1v.w * q, d, true); w.y = (unsigned)d;
              d = 0; d = __builtin_amdgcn_cvt_pk_fp8_f32(x2v.x * q, x2v.y * q, d, false); d = __builtin_amdgcn_cvt_pk_fp8_f32(x2v.z * q, x2v.w * q, d, true); w.z = (unsigned)d;
              d = 0; d = __builtin_amdgcn_cvt_pk_fp8_f32(x3v.x * q, x3v.y * q, d, false); d = __builtin_amdgcn_cvt_pk_fp8_f32(x3v.z * q, x3v.w * q, d, true); w.w = (unsigned)d;
              *(u32x4_t*)(h2f8 + (size_t)m * D_ + lane * 16) = w; }
        }
        wcnt[(tile * 8 + wave) * NE + lane] = cw; cntl[wave * 64 + lane] = cw;
        __syncthreads();
        if (wave == 0) { int t = 0;
#pragma unroll
            for (int w = 0; w < 8; ++w) t += cntl[w * 64 + lane];
            tcnt[tile * NE + lane] = t; }
    }
}
__device__ __forceinline__ void st_lists(const P& p, size_t gt, size_t ngt, int tid, int wg, int nwg, LAS unsigned* L) {
    const int* wcnt = WSP(int, WS_WCNT); const int* tcnt = WSP(int, WS_TCNT); unsigned* basew = WSP(unsigned, WS_CTL) + CW_BASE;
    const int* tope = WSP(int, WS_TOPE); const float* topw = WSP(float, WS_TOPW); const int* topls = WSP(int, WS_TOPLS); const float* rstd2 = WSP(float, WS_RSTD2);
    int* pos = WSP(int, WS_POS); int* ltok = WSP(int, WS_LTOK); float* lw = WSP(float, WS_LW); float* lr = WSP(float, WS_LR); int* tile_e = WSP(int, 5 * MiB);
    const int w8 = tid >> 6, e = tid & 63;
    for (int tile = wg; tile < M_ / 64; tile += nwg) {
        __syncthreads();
        { int tot = 0, pre = 0;
#pragma unroll
          for (int i = w8; i < 256; i += 8) { const int v = tcnt[i * NE + e]; tot += v; pre += (i < tile) ? v : 0; }
          L[tid] = (unsigned)tot; L[512 + tid] = (unsigned)pre; }
        __syncthreads();
        if (tid < 64) { unsigned tot = 0, pre = 0;
#pragma unroll
            for (int w = 0; w < 8; ++w) { tot += L[w * 64 + tid]; pre += L[512 + w * 64 + tid]; }
            const unsigned pc = (tot + 255u) & ~255u; unsigned v = pc;
#pragma unroll
            for (int o = 1; o < 64; o <<= 1) { const unsigned t = __shfl_up(v, o); if (tid >= o) v += t; }
            L[1024 + tid] = v - pc; L[1088 + tid] = tot; if (tid == 63) L[1152] = v;
            unsigned run = v - pc + pre;
#pragma unroll
            for (int w = 0; w < 8; ++w) { L[1216 + w * 64 + tid] = run; run += (unsigned)wcnt[(tile * 8 + w) * NE + tid]; } }
        __syncthreads();
        { const int i = tile * 512 + tid; const int ex = tope[i], tok = i >> 3, w = (tok & 63) >> 3;
          const int slot = (int)L[1216 + w * 64 + ex] + topls[i];
          pos[i] = slot; ltok[slot] = tok; lw[slot] = topw[i]; lr[slot] = rstd2[tok]; }
    }
    for (size_t i = gt; i < (size_t)NE * 256; i += ngt) {
        const int ex = (int)(i / 256), j = (int)(i % 256); const unsigned base = L[1024 + ex], n = L[1088 + ex], np = (n + 255u) & ~255u;
        if (n + j < np) { ltok[base + n + j] = 0; lw[base + n + j] = 0.f; lr[base + n + j] = 0.f; }
    }
    if (gt < 64) basew[gt] = L[1024 + gt];
    if (gt == 64) basew[NE] = L[1152];
    for (size_t i = gt; i < (size_t)(NSLOT / 256); i += ngt) { int ex = -1;
        for (int q = 0; q < NE; ++q) { const unsigned b0 = L[1024 + q], b1 = b0 + ((L[1088 + q] + 255u) & ~255u); if ((unsigned)i * 256u >= b0 && (unsigned)i * 256u < b1) ex = q; }
        tile_e[i] = ex; }
    for (size_t i = gt; i < (size_t)M_; i += ngt) { ltok[NSLOT + i] = (int)i; lw[NSLOT + i] = 1.f; lr[NSLOT + i] = rstd2[i]; }
}
__device__ __forceinline__ void st_combine(const P& p, int gw, int ngw, int lane, bool dry = false) {
    typedef float f32x2_t __attribute__((ext_vector_type(2)));
    const int* pos = WSP(int, WS_POS); const unsigned char* Y8 = WSP(unsigned char, WS_Y); bf16_t* h3 = WSP(bf16_t, WS_H3);
    for (int m = gw; m < M_; m += ngw) {
        f32x4_t* xr = (f32x4_t*)(p.out + (size_t)m * D_) + 4 * lane; f32x4_t v[4];
        int ps[TOPK];
#pragma unroll
        for (int k = 0; k < TOPK; ++k) ps[k] = __builtin_amdgcn_readfirstlane(pos[m * TOPK + k]);
#pragma unroll
        for (int j = 0; j < 4; ++j) v[j] = xr[j];
        u32x4_t y[TOPK + 1];
#pragma unroll
        for (int k = 0; k < TOPK + 1; ++k) y[k] = ((const u32x4_t*)(Y8 + (size_t)(k < TOPK ? ps[k] : NSLOT + m) * 1024))[lane];
        f32x4_t acc[4];
#pragma unroll
        for (int j = 0; j < 4; ++j) acc[j] = (f32x4_t){0.f, 0.f, 0.f, 0.f};
#pragma unroll
        for (int k = 0; k < TOPK + 1; ++k)
#pragma unroll
            for (int j = 0; j < 4; ++j) { const int w = (int)y[k][j]; const f32x2_t lo = __builtin_amdgcn_cvt_pk_f32_fp8(w, false), hi = __builtin_amdgcn_cvt_pk_f32_fp8(w, true);
                acc[j].x += lo.x; acc[j].y += lo.y; acc[j].z += hi.x; acc[j].w += hi.y; }
        float s = 0.f;
#pragma unroll
        for (int j = 0; j < 4; ++j) { v[j] = v[j] + acc[j] * (1.f / 16.f); s += (v[j].x * v[j].x + v[j].y * v[j].y) + (v[j].z * v[j].z + v[j].w * v[j].w); }
        s = wave_sum(s); const float rr = sqrtf(s * (1.f / D_) + EPS), r = 1.f / rr;
        if (lane == 0 && !dry) WSP(float, WS_INV3)[m] = rr;
        u32x4_t* o = (u32x4_t*)(h3 + (size_t)m * D_) + 2 * lane;
        o[0] = (u32x4_t){cvtpk_(v[0].x * r, v[0].y * r), cvtpk_(v[0].z * r, v[0].w * r), cvtpk_(v[1].x * r, v[1].y * r), cvtpk_(v[1].z * r, v[1].w * r)};
        o[1] = (u32x4_t){cvtpk_(v[2].x * r, v[2].y * r), cvtpk_(v[2].z * r, v[2].w * r), cvtpk_(v[3].x * r, v[3].y * r), cvtpk_(v[3].z * r, v[3].w * r)};
        { const float q = r * 8.f; u32x4_t w;
#pragma unroll
          for (int j = 0; j < 4; ++j) { int d = 0; d = __builtin_amdgcn_cvt_pk_fp8_f32(v[j].x * q, v[j].y * q, d, false); d = __builtin_amdgcn_cvt_pk_fp8_f32(v[j].z * q, v[j].w * q, d, true); w[j] = (unsigned)d; }
          ((u32x4_t*)(WSP(unsigned char, WS_H3F8) + (size_t)m * D_))[lane] = w; }
    }
}

#ifndef FAST_MASK
#define FAST_MASK 0xffff
#endif
constexpr int LDS_DYN = 144 * 1024;
constexpr int MISC_OFF = 132 * 1024;
constexpr int N_STAGES = 13;
__global__ void __launch_bounds__(NT) k_fwd(P p) {
    extern __shared__ __attribute__((aligned(16))) unsigned char lds[];
    const int wave_s = __builtin_amdgcn_readfirstlane((int)threadIdx.x >> 6);
    const int tid0 = tid_of(wave_s);
    volatile LAS unsigned* misc = (volatile LAS unsigned*)((LAS unsigned char*)lds + MISC_OFF);
    if (tid0 < 16) misc[tid0] = 0u;
    __syncthreads();
    XcdBarrier bar = xcd_barrier_post(WSP(unsigned, WS_CTL) + CW_BAR, misc, wave_s);
    const int lo = p.st_lo, hi = p.st_hi;
#ifdef TIME_STAGE
    unsigned long long* stamps = (unsigned long long*)(p.ws + 5 * MiB + 65536);
    if (blockIdx.x == 0 && tid_of(wave_s) == 0) stamps[0] = __builtin_amdgcn_s_memrealtime();
#define STAMP(k) do { if (blockIdx.x == 0 && tid_of(wave_s) == 0) stamps[(k) + 1] = __builtin_amdgcn_s_memrealtime(); } while (0)
#else
#define STAMP(k) do {} while (0)
#endif
#ifndef DUP_STAGE
#define DUP_STAGE -1
#endif
#ifndef DUP_N
#define DUP_N 1
#endif
#if DUP_STAGE == 0
#define DUPCALL (st_prep(p, gw, ngw, lane), st_rope(p, gt, ngt), st_wrconv(p, gt, ngt), st_wconv(p, gw, ngw, lane, (LAS float*)((LAS unsigned char*)lds + wave * 16384)))
#elif DUP_STAGE == 1
#define DUPCALL fs_g1(p, (LAS unsigned char*)lds, wave_s)
#elif DUP_STAGE == 2
#define DUPCALL fs_g23(p, (LAS unsigned char*)lds, wave_s)
#elif DUP_STAGE == 3
#define DUPCALL st_attn_prep(p, wg, nwg, wave, lane, (bf16_t*)lds)
#elif DUP_STAGE == 4
#define DUPCALL fs_attn(p, (LAS unsigned char*)lds, wave_s)
#elif DUP_STAGE == 5
#define DUPCALL fs_merge(p, (LAS unsigned char*)lds, wave_s)
#elif DUP_STAGE == 6
#define DUPCALL fs_out(p, (LAS unsigned char*)lds, wave_s)
#elif DUP_STAGE == 7
#define DUPCALL st_route(p, wg, nwg, wave, lane, (LAS unsigned char*)lds, 2048)
#elif DUP_STAGE == 8
#define DUPCALL st_lists(p, gt, ngt, tid, wg, nwg, (LAS unsigned*)((LAS unsigned char*)lds))
#elif DUP_STAGE == 9
#define DUPCALL fs_gu(p, (LAS unsigned char*)lds, wave_s)
#elif DUP_STAGE == 11
#define DUPCALL st_combine(p, gw, ngw, lane, true)
#else
#define DUPCALL
#endif
#define RUN(k, call) if (lo <= (k) && (k) < hi) { { int tid = tid_of(wave_s); asm volatile("" : "+v"(tid)); const int lane = tid & 63, wave = tid >> 6; const int wg = blockIdx.x, nwg = gridDim.x; \
        const int gw = wg * (NT / 64) + wave, ngw = nwg * (NT / 64); const size_t gt = (size_t)wg * NT + tid, ngt = (size_t)nwg * NT; \
        (void)lane; (void)wave; (void)wg; (void)nwg; (void)gw; (void)ngw; (void)gt; (void)ngt; \
        if ((k) == DUP_STAGE) { for (int d_ = 0; d_ < DUP_N; ++d_) { DUPCALL; xcd_barrier(bar); } } call; } if ((k) + 1 < hi) xcd_barrier(bar); STAMP(k); }
    RUN(0, (st_prep(p, gw, ngw, lane), st_rope(p, gt, ngt), st_wrconv(p, gt, ngt), st_wconv(p, gw, ngw, lane, (LAS float*)((LAS unsigned char*)lds + wave * 16384))))
    RUN(1, (fs_g1(p, (LAS unsigned char*)lds, wave_s), fs_pp(p, (LAS unsigned char*)lds, wave_s)))
    RUN(2, fs_g23(p, (LAS unsigned char*)lds, wave_s))
    RUN(3, st_attn_prep(p, wg, nwg, wave, lane, (bf16_t*)lds))
    RUN(4, fs_attn(p, (LAS unsigned char*)lds, wave_s))
    RUN(5, fs_merge(p, (LAS unsigned char*)lds, wave_s))
    RUN(6, fs_out(p, (LAS unsigned char*)lds, wave_s))
    RUN(7, st_route(p, wg, nwg, wave, lane, (LAS unsigned char*)lds))
    RUN(8, st_lists(p, gt, ngt, tid, wg, nwg, (LAS unsigned*)((LAS unsigned char*)lds)))
    RUN(9, fs_gu(p, (LAS unsigned char*)lds, wave_s))
    RUN(10, fs_down(p, (LAS unsigned char*)lds, wave_s))
    RUN(11, st_combine(p, gw, ngw, lane))
    RUN(12, fs_ple(p, (LAS unsigned char*)lds, wave_s))
#undef RUN
#ifdef TIME_STAGE
    xcd_barrier(bar);
    if (tid_of(wave_s) == 0) { const unsigned long long d = __hip_atomic_load(&stamps[TIME_STAGE + 1], __ATOMIC_RELAXED, __HIP_MEMORY_SCOPE_AGENT) - __hip_atomic_load(&stamps[TIME_STAGE], __ATOMIC_RELAXED, __HIP_MEMORY_SCOPE_AGENT);
        const unsigned long long t0 = __builtin_amdgcn_s_memrealtime(); while (__builtin_amdgcn_s_memrealtime() - t0 < 4ull * d) __builtin_amdgcn_s_sleep(8); }
    __syncthreads();
#endif
}

extern "C" void kernel_launch(void* const* d_in, const int* in_sizes, int n_in, void* d_out, int out_size, void* d_ws, size_t ws_size, hipStream_t stream) {
    if (n_in != 29 || ws_size < WS_END) { fprintf(stderr, "kernel_launch: unexpected n_in %d or ws_size %zu\n", n_in, ws_size); return; }
    P p{};
    p.x = (const float*)d_in[0]; p.p = (const float*)d_in[1]; p.pos = (const int*)d_in[2];
#define IN_(name, i) p.name = (const float*)d_in[i]
    IN_(g_mix, 3); IN_(w_in, 4); IN_(b_gate, 5); IN_(g_cq, 6); IN_(w_uq, 7); IN_(g_ckv, 8); IN_(w_ukv, 9); IN_(g_qn_mla, 10); IN_(g_kn_mla, 11);
    IN_(g_qn_swa, 12); IN_(g_kn_swa, 13); IN_(sink, 14); IN_(w_br_mla, 15); IN_(w_br_swa, 16); IN_(w_out, 17); IN_(g_moe, 18); IN_(w_router, 19);
    IN_(router_bias, 20); IN_(w_exp_gu, 21); IN_(w_exp_down, 22); IN_(w_sh_gu, 23); IN_(w_sh_down, 24); IN_(g_ple, 25); IN_(w_ple_gate, 26); IN_(b_ple, 27); IN_(w_ple_proj, 28);
#undef IN_
    p.out = (float*)d_out; p.ws = (unsigned char*)d_ws;
    static int grid = 0;
    if (grid == 0) {
        int dev = 0, cus = 0, per_cu = 0;
        (void)hipGetDevice(&dev); (void)hipDeviceGetAttribute(&cus, hipDeviceAttributeMultiprocessorCount, dev);
        (void)hipFuncSetAttribute((const void*)k_fwd, hipFuncAttributeMaxDynamicSharedMemorySize, LDS_DYN);
        (void)hipOccupancyMaxActiveBlocksPerMultiprocessor(&per_cu, (const void*)k_fwd, NT, LDS_DYN);
        (void)hipGetLastError();
        if (per_cu < 1) { fprintf(stderr, "kernel_launch: occupancy query says %d blocks per CU\n", per_cu); grid = -1; return; }
        grid = cus;
    }
    if (grid < 0) return;
    (void)hipMemsetAsync((char*)d_ws + WS_CTL, 0, CTL_BYTES, stream);
    p.st_lo = 0; p.st_hi = N_STAGES;
    void* args[] = {&p};
    hipError_t e = hipLaunchCooperativeKernel((const void*)k_fwd, dim3(grid), dim3(NT), args, LDS_DYN, stream);
    if (e != hipSuccess) fprintf(stderr, "cooperative launch failed: %s (grid %d)\n", hipGetErrorString(e), grid);
}
```
